# Optimizing an MI355X kernel written in HIP

```python
import jax
import jax.numpy as jnp
from jax import lax
import numpy as np

D_MODEL = 1024
BATCH = 4
SEQ = 8192
DEPTH = 2

HEAD_DIM = 64
ROPE_THETA = 10000.0
NORM_EPS = 1e-6
QUERY_BLOCK = 128
N_MEM = 256

SWA_HEADS = 8
SWA_KV_HEADS = 2
SWA_WINDOW = 128

NSA_HEADS = 8
NSA_KV_GROUPS = 2
NSA_CMP_BLOCK = 32
NSA_CMP_STRIDE = 16
NSA_SEL_BLOCK = 64
NSA_N_SEL = 16
NSA_WINDOW = 512
NSA_FORCE_BONUS = 1e4

MLA_HEADS = 8
MLA_Q_RANK = 384
MLA_KV_RANK = 256
MLA_NOPE_DIM = 64
MLA_ROPE_DIM = 32
MLA_V_DIM = 64

XATTN_HEADS = 4
XATTN_HEAD_DIM = 128

D_FF = -(-8 * D_MODEL // (3 * 256)) * 256

N_BRANCH = 3
IN_SPLITS = (
    SWA_HEADS * HEAD_DIM, SWA_KV_HEADS * HEAD_DIM, SWA_KV_HEADS * HEAD_DIM,
    NSA_HEADS * HEAD_DIM,
    NSA_KV_GROUPS * HEAD_DIM, NSA_KV_GROUPS * HEAD_DIM,
    NSA_KV_GROUPS * HEAD_DIM, NSA_KV_GROUPS * HEAD_DIM,
    NSA_KV_GROUPS * HEAD_DIM, NSA_KV_GROUPS * HEAD_DIM,
    NSA_HEADS * 3,
    MLA_Q_RANK, MLA_KV_RANK, MLA_ROPE_DIM,
    N_BRANCH * D_MODEL,
)
D_IN = sum(IN_SPLITS)

kernel_name = 'hybrid_swa_nsa_mla_block'


def rmsnorm(x, g):
    x32 = x.astype(jnp.float32)
    y = x32 * lax.rsqrt(jnp.mean(x32 * x32, axis=-1, keepdims=True) + NORM_EPS)
    return (y * g.astype(jnp.float32)).astype(x.dtype)


def rope(x, pos):
    half = x.shape[-1] // 2
    inv_freq = ROPE_THETA ** (-jnp.arange(half, dtype=jnp.float32) / half)
    ang = pos.astype(jnp.float32)[..., None] * inv_freq
    cos, sin = jnp.cos(ang)[:, :, None, :], jnp.sin(ang)[:, :, None, :]
    x1, x2 = jnp.split(x.astype(jnp.float32), 2, axis=-1)
    return jnp.concatenate([x1 * cos - x2 * sin, x2 * cos + x1 * sin], axis=-1).astype(x.dtype)


def masked_probs(s, mask, sink=None):
    s = jnp.where(mask, s, -jnp.inf)
    m = jnp.max(s, axis=-1, keepdims=True)
    if sink is not None:
        m = jnp.maximum(m, sink)
    m = jnp.where(jnp.isfinite(m), m, 0.0)
    e = jnp.exp(s - m)
    denom = jnp.sum(e, axis=-1, keepdims=True)
    if sink is not None:
        denom = denom + jnp.exp(sink - m)
    return e / jnp.where(denom > 0, denom, 1.0)


def slice_seq(x, start, size):
    return lax.dynamic_slice_in_dim(x, start, size, axis=1)


def pad_front(x, n):
    return jnp.pad(x, ((0, 0), (n, 0), (0, 0), (0, 0)))


def blocked_map(fn, seq_len):
    out = lax.map(fn, jnp.arange(seq_len // QUERY_BLOCK) * QUERY_BLOCK)
    out = jnp.moveaxis(out, 0, 1)
    return out.reshape(out.shape[0], seq_len, *out.shape[3:])


def window_block(q, k_pad, v_pad, qs, window, sink=None):
    B, _, H, d = q.shape
    G = k_pad.shape[2]
    R = H // G
    L = window + QUERY_BLOCK
    qb = slice_seq(q, qs, QUERY_BLOCK).reshape(B, QUERY_BLOCK, G, R, d)
    kb = slice_seq(k_pad, qs, L)
    vb = slice_seq(v_pad, qs, L)
    t = qs + jnp.arange(QUERY_BLOCK)[:, None]
    kpos = qs - window + jnp.arange(L)[None, :]
    mask = (kpos <= t) & (kpos > t - window) & (kpos >= 0)
    s = jnp.einsum('bqgrd,bkgd->bgrqk', qb, kb).astype(jnp.float32) * (d ** -0.5)
    p = masked_probs(s, mask, sink)
    o = jnp.einsum('bgrqk,bkgd->bqgrd', p.astype(vb.dtype), vb)
    return o.reshape(B, QUERY_BLOCK, H, d)


def swa_mixer(q, k, v, pos, sinks):
    B, S, _ = q.shape
    q = rope(q.reshape(B, S, SWA_HEADS, HEAD_DIM), pos)
    k = pad_front(rope(k.reshape(B, S, SWA_KV_HEADS, HEAD_DIM), pos), SWA_WINDOW)
    v = pad_front(v.reshape(B, S, SWA_KV_HEADS, HEAD_DIM), SWA_WINDOW)
    sink = sinks.astype(jnp.float32).reshape(1, SWA_KV_HEADS, SWA_HEADS // SWA_KV_HEADS, 1, 1)
    o = blocked_map(lambda qs: window_block(q, k, v, qs, SWA_WINDOW, sink), S)
    return o.reshape(B, S, SWA_HEADS * HEAD_DIM)


def nsa_compress(k, pe, w1, w2):
    B, S, G, d = k.shape
    n_cmp = (S - NSA_CMP_BLOCK) // NSA_CMP_STRIDE + 1
    idx = np.arange(n_cmp)[:, None] * NSA_CMP_STRIDE + np.arange(NSA_CMP_BLOCK)[None, :]
    blk = k[:, idx] + pe[None, None, :, None, :]
    blk = jnp.swapaxes(blk, 2, 3).reshape(B, n_cmp, G, NSA_CMP_BLOCK * d)
    return jax.nn.silu(blk @ w1) @ w2


def nsa_mixer(q, kc, vc, ks, vs, kw, vw, g_logits, pos, pe_k, pe_v, wk1, wk2, wv1, wv2):
    B, S, _ = q.shape
    H, G, d = NSA_HEADS, NSA_KV_GROUPS, HEAD_DIM
    R = H // G
    shp = (B, S, G, d)
    q = q.reshape(B, S, H, d)
    q_rot = rope(q, pos)
    k_cmp = nsa_compress(kc.reshape(shp), pe_k, wk1, wk2)
    v_cmp = nsa_compress(vc.reshape(shp), pe_v, wv1, wv2)
    n_cmp = k_cmp.shape[1]
    cmp_start = np.arange(n_cmp) * NSA_CMP_STRIDE
    cmp_end = jnp.asarray(cmp_start + NSA_CMP_BLOCK - 1)
    n_slc = S // NSA_SEL_BLOCK
    sel_start = np.arange(n_slc) * NSA_SEL_BLOCK
    cover = (np.minimum(cmp_start[:, None] + NSA_CMP_BLOCK, sel_start[None, :] + NSA_SEL_BLOCK)
             - np.maximum(cmp_start[:, None], sel_start[None, :]))
    cmp_to_sel = jnp.asarray(np.clip(cover, 0, None) / NSA_CMP_STRIDE, dtype=jnp.float32)
    n_sel = min(NSA_N_SEL, n_slc)
    to_blocks = lambda a: jnp.transpose(a.reshape(B, n_slc, NSA_SEL_BLOCK, G, d), (0, 3, 1, 2, 4))
    k_sel_blk = to_blocks(rope(ks.reshape(shp), pos))
    v_sel_blk = to_blocks(vs.reshape(shp))
    k_win = pad_front(rope(kw.reshape(shp), pos), NSA_WINDOW)
    v_win = pad_front(vw.reshape(shp), NSA_WINDOW)
    gate = jax.nn.sigmoid(g_logits.astype(jnp.float32)).reshape(B, S, H, 3)
    gather = jax.vmap(jax.vmap(lambda blocks, ids: blocks[ids]))
    scale = d ** -0.5
    blk_ids = jnp.arange(n_slc)[None, :]
    m_sel = n_sel * NSA_SEL_BLOCK

    def block(qs):
        t = qs + jnp.arange(QUERY_BLOCK)
        qb = slice_seq(q, qs, QUERY_BLOCK).reshape(B, QUERY_BLOCK, G, R, d)
        s = jnp.einsum('bqgrd,bcgd->bgrqc', qb, k_cmp).astype(jnp.float32) * scale
        p_cmp = masked_probs(s, cmp_end[None, :] <= t[:, None])
        o_cmp = jnp.einsum('bgrqc,bcgd->bqgrd', p_cmp.astype(v_cmp.dtype), v_cmp)
        imp = jnp.einsum('bgqc,cj->bgqj', p_cmp.sum(axis=2), cmp_to_sel)
        cur = (t // NSA_SEL_BLOCK)[:, None]
        valid = blk_ids <= cur
        forced = (blk_ids == 0) | (blk_ids == cur) | (blk_ids == cur - 1)
        score = jnp.where(valid, imp + jnp.where(forced, NSA_FORCE_BONUS, 0.0), -jnp.inf)
        top_val, top_idx = lax.top_k(score, n_sel)
        k_g = gather(k_sel_blk, top_idx).reshape(B, G, QUERY_BLOCK, m_sel, d)
        v_g = gather(v_sel_blk, top_idx).reshape(B, G, QUERY_BLOCK, m_sel, d)
        tok = (top_idx[..., None] * NSA_SEL_BLOCK + jnp.arange(NSA_SEL_BLOCK)).reshape(B, G, QUERY_BLOCK, m_sel)
        ok = (tok <= t[:, None]) & jnp.repeat(jnp.isfinite(top_val), NSA_SEL_BLOCK, axis=-1)
        qrb = slice_seq(q_rot, qs, QUERY_BLOCK).reshape(B, QUERY_BLOCK, G, R, d)
        s = jnp.einsum('bqgrd,bgqmd->bgrqm', qrb, k_g).astype(jnp.float32) * scale
        p_sel = masked_probs(s, ok[:, :, None])
        o_sel = jnp.einsum('bgrqm,bgqmd->bqgrd', p_sel.astype(v_g.dtype), v_g)
        o_win = window_block(q_rot, k_win, v_win, qs, NSA_WINDOW)
        g = slice_seq(gate, qs, QUERY_BLOCK).astype(q.dtype)
        return (g[..., 0:1] * o_cmp.reshape(B, QUERY_BLOCK, H, d)
                + g[..., 1:2] * o_sel.reshape(B, QUERY_BLOCK, H, d)
                + g[..., 2:3] * o_win)

    return blocked_map(block, S).reshape(B, S, H * d)


def mla_mixer(q_lat, kv_lat, k_rot, pos, q_norm, w_q_b, kv_norm, w_kv_b):
    B, S, _ = q_lat.shape
    H = MLA_HEADS
    q = (rmsnorm(q_lat, q_norm) @ w_q_b).reshape(B, S, H, MLA_NOPE_DIM + MLA_ROPE_DIM)
    q_nope, q_pe = q[..., :MLA_NOPE_DIM], rope(q[..., MLA_NOPE_DIM:], pos)
    kv = (rmsnorm(kv_lat, kv_norm) @ w_kv_b).reshape(B, S, H, MLA_NOPE_DIM + MLA_V_DIM)
    k_nope, v = kv[..., :MLA_NOPE_DIM], kv[..., MLA_NOPE_DIM:]
    k_pe = rope(k_rot[:, :, None, :], pos)[:, :, 0]
    scale = (MLA_NOPE_DIM + MLA_ROPE_DIM) ** -0.5
    kpos = jnp.arange(S)[None, :]

    def block(qs):
        t = qs + jnp.arange(QUERY_BLOCK)[:, None]
        qn = slice_seq(q_nope, qs, QUERY_BLOCK)
        qp = slice_seq(q_pe, qs, QUERY_BLOCK)
        s = (jnp.einsum('bqhd,bkhd->bhqk', qn, k_nope)
             + jnp.einsum('bqhd,bkd->bhqk', qp, k_pe)).astype(jnp.float32) * scale
        p = masked_probs(s, kpos <= t)
        return jnp.einsum('bhqk,bkhd->bqhd', p.astype(v.dtype), v)

    return blocked_map(block, S).reshape(B, S, H * MLA_V_DIM)


def cross_attn(hx, hm, w_q, w_kv, w_o):
    B, S, _ = hx.shape
    M = hm.shape[1]
    q = (hx @ w_q).reshape(B, S, XATTN_HEADS, XATTN_HEAD_DIM)
    kv = (hm @ w_kv).reshape(B, M, 2, XATTN_HEADS, XATTN_HEAD_DIM)
    k, v = kv[:, :, 0], kv[:, :, 1]
    s = jnp.einsum('bshd,bmhd->bhsm', q, k).astype(jnp.float32) * (XATTN_HEAD_DIM ** -0.5)
    p = jax.nn.softmax(s, axis=-1)
    o = jnp.einsum('bhsm,bmhd->bshd', p.astype(v.dtype), v)
    return o.reshape(B, S, XATTN_HEADS * XATTN_HEAD_DIM) @ w_o


def setup_inputs(seed: int = 0) -> dict:
    key = jax.random.key(seed)
    ks = iter(jax.random.split(key, 32))
    f32 = jnp.float32
    L = DEPTH

    def dense(shape, fan_in):
        return jax.random.normal(next(ks), shape, f32) * fan_in ** -0.5

    def gain(shape):
        return 1.0 + 0.1 * jax.random.normal(next(ks), shape, f32)

    x = jax.random.normal(next(ks), (BATCH, SEQ, D_MODEL), f32)
    mem = jax.random.normal(next(ks), (BATCH, N_MEM, D_MODEL), f32)
    positions = (jnp.arange(SEQ, dtype=jnp.int32)[None, :]
                 + jax.random.randint(next(ks), (BATCH, 1), 0, 4096, dtype=jnp.int32))
    cmp_in = NSA_CMP_BLOCK * HEAD_DIM
    return {
        'x': x,
        'mem': mem,
        'positions': positions,
        'norm_mix': gain((L, D_MODEL)),
        'w_in': dense((L, D_MODEL, D_IN), D_MODEL),
        'swa_sinks': jax.random.normal(next(ks), (L, SWA_HEADS), f32),
        'nsa_pe_k': 0.1 * jax.random.normal(next(ks), (L, NSA_CMP_BLOCK, HEAD_DIM), f32),
        'nsa_pe_v': 0.1 * jax.random.normal(next(ks), (L, NSA_CMP_BLOCK, HEAD_DIM), f32),
        'nsa_wk1': dense((L, cmp_in, HEAD_DIM), cmp_in),
        'nsa_wk2': dense((L, HEAD_DIM, HEAD_DIM), HEAD_DIM),
        'nsa_wv1': dense((L, cmp_in, HEAD_DIM), cmp_in),
        'nsa_wv2': dense((L, HEAD_DIM, HEAD_DIM), HEAD_DIM),
        'mla_q_norm': gain((L, MLA_Q_RANK)),
        'mla_w_q_b': dense((L, MLA_Q_RANK, MLA_HEADS * (MLA_NOPE_DIM + MLA_ROPE_DIM)), MLA_Q_RANK),
        'mla_kv_norm': gain((L, MLA_KV_RANK)),
        'mla_w_kv_b': dense((L, MLA_KV_RANK, MLA_HEADS * (MLA_NOPE_DIM + MLA_V_DIM)), MLA_KV_RANK),
        'w_br_a': dense((L, SWA_HEADS * HEAD_DIM, D_MODEL), SWA_HEADS * HEAD_DIM),
        'w_br_b': dense((L, NSA_HEADS * HEAD_DIM, D_MODEL), NSA_HEADS * HEAD_DIM),
        'w_br_c': dense((L, MLA_HEADS * MLA_V_DIM, D_MODEL), MLA_HEADS * MLA_V_DIM),
        'w_out': dense((L, D_MODEL, D_MODEL), D_MODEL),
        'norm_xattn': gain((L, D_MODEL)),
        'norm_mem': gain((L, D_MODEL)),
        'w_xq': dense((L, D_MODEL, XATTN_HEADS * XATTN_HEAD_DIM), D_MODEL),
        'w_xkv': dense((L, D_MODEL, 2 * XATTN_HEADS * XATTN_HEAD_DIM), D_MODEL),
        'w_xo': dense((L, XATTN_HEADS * XATTN_HEAD_DIM, D_MODEL), XATTN_HEADS * XATTN_HEAD_DIM),
        'norm_ffn': gain((L, D_MODEL)),
        'w_gate_up': dense((L, D_MODEL, 2 * D_FF), D_MODEL),
        'w_down': dense((L, D_FF, D_MODEL), D_FF),
        'norm_final': gain((D_MODEL,)),
    }


def reference(x, mem, positions, norm_mix, w_in, swa_sinks, nsa_pe_k, nsa_pe_v, nsa_wk1, nsa_wk2,
              nsa_wv1, nsa_wv2, mla_q_norm, mla_w_q_b, mla_kv_norm, mla_w_kv_b, w_br_a, w_br_b,
              w_br_c, w_out, norm_xattn, norm_mem, w_xq, w_xkv, w_xo, norm_ffn, w_gate_up, w_down,
              norm_final):
    B, S, D = x.shape
    offsets = np.cumsum(IN_SPLITS)[:-1].tolist()
    for l in range(DEPTH):
        h = rmsnorm(x, norm_mix[l])
        (a_q, a_k, a_v, b_q, b_kc, b_vc, b_ks, b_vs, b_kw, b_vw, b_g,
         c_qa, c_kv, c_kr, g_br) = jnp.split(h @ w_in[l], offsets, axis=-1)
        o_a = swa_mixer(a_q, a_k, a_v, positions, swa_sinks[l])
        o_b = nsa_mixer(b_q, b_kc, b_vc, b_ks, b_vs, b_kw, b_vw, b_g, positions,
                        nsa_pe_k[l], nsa_pe_v[l], nsa_wk1[l], nsa_wk2[l], nsa_wv1[l], nsa_wv2[l])
        o_c = mla_mixer(c_qa, c_kv, c_kr, positions, mla_q_norm[l], mla_w_q_b[l],
                        mla_kv_norm[l], mla_w_kv_b[l])
        g = jax.nn.sigmoid(g_br.astype(jnp.float32)).reshape(B, S, N_BRANCH, D).astype(x.dtype)
        merged = (g[:, :, 0] * (o_a @ w_br_a[l])
                  + g[:, :, 1] * (o_b @ w_br_b[l])
                  + g[:, :, 2] * (o_c @ w_br_c[l]))
        x = x + merged @ w_out[l]
        x = x + cross_attn(rmsnorm(x, norm_xattn[l]), rmsnorm(mem, norm_mem[l]),
                           w_xq[l], w_xkv[l], w_xo[l])
        h = rmsnorm(x, norm_ffn[l])
        gate_h, up_h = jnp.split(h @ w_gate_up[l], 2, axis=-1)
        x = x + (jax.nn.silu(gate_h) * up_h) @ w_down[l]
    return rmsnorm(x, norm_final)
```

```cpp
#include <hip/hip_runtime.h>
#include <hip/hip_cooperative_groups.h>
#include <cstdio>
#include <cstdint>
#include <cmath>
#include <cstring>
namespace cg = cooperative_groups;

#define LAS __attribute__((address_space(3)))
typedef unsigned short bf16_t;
typedef short bf16x8 __attribute__((ext_vector_type(8)));
typedef short s16x4 __attribute__((ext_vector_type(4)));
typedef short v4i16_t __attribute__((ext_vector_type(4)));
typedef float f32x4 __attribute__((ext_vector_type(4)));
typedef float f32x2 __attribute__((ext_vector_type(2)));
typedef unsigned u32x4 __attribute__((ext_vector_type(4)));
typedef unsigned u32x2 __attribute__((ext_vector_type(2)));

constexpr int NB = 4, S = 8192, T = NB * S, DM = 1024, DEPTH = 2;
constexpr int DIN = 5816, NPROJ = 2816, NGATE = 3072, DFF = 2816, NGU = 5632;
constexpr int C_AQ = 0, C_AK = 512, C_AV = 640, C_BQ = 768, C_BKC = 1280, C_BVC = 1408, C_BKS = 1536, C_BVS = 1664, C_BKW = 1792, C_BVW = 1920;
constexpr int C_CQA = 2048, C_CKV = 2432, C_CKR = 2688, C_BG = 2720;
constexpr float LOG2E = 1.4426950408889634f;
constexpr float NORM_EPS = 1e-6f;

constexpr size_t MiB = 1u << 20;
constexpr size_t WS_KCMP = 0, WS_VCMP = MiB / 2, WS_MEMKV = 1 * MiB, WS_HM = 3 * MiB;
constexpr size_t WS_SELL = 5 * MiB;
constexpr size_t WS_BAR = 7 * MiB, BAR_BYTES = 16384;
constexpr size_t WS_CS64 = 8 * MiB, WS_CS32 = 16 * MiB;
constexpr size_t WS_W = 20 * MiB;
constexpr size_t WS_RSS = 59 * MiB;
constexpr size_t WS_H = 64 * MiB;
constexpr size_t WS_PROJ = 128 * MiB;
constexpr size_t WS_QM = 304 * MiB;
constexpr size_t WS_KVM = 352 * MiB;
constexpr size_t WS_OC = 416 * MiB;
constexpr size_t WS_QROT = 448 * MiB;
constexpr size_t WS_VST = 480 * MiB;
constexpr size_t WS_KST = 488 * MiB;
constexpr size_t WS_END = 496 * MiB;
constexpr size_t W_IN = 0, W_G = W_IN + (size_t)NPROJ * 1024, W_QB = W_G + (size_t)NGATE * 1024, W_KVB = W_QB + 768 * 384,
                 W_BR = W_KVB + 1024 * 256, W_OUT = W_BR + 3 * 1024 * 512, W_XQ = W_OUT + 1024 * 1024, W_XKV = W_XQ + 512 * 1024,
                 W_XO = W_XKV + 1024 * 1024, W_GU = W_XO + 1024 * 512, W_DOWN = W_GU + (size_t)NGU * 1024, W_K1 = W_DOWN + (size_t)1024 * DFF,
                 W_V1 = W_K1 + 64 * 2048, W_K2 = W_V1 + 64 * 2048, W_V2 = W_K2 + 64 * 64, W_ENDE = W_V2 + 64 * 64;
static_assert(W_ENDE * 2 <= 39 * MiB, "weights fit below the row-statistics buffer");

constexpr int LDS_BYTES = 147456;

typedef __bf16 bf16x2_t __attribute__((ext_vector_type(2)));
__device__ __forceinline__ unsigned cvt_pk_bf16(float lo, float hi) { f32x2 v = {lo, hi}; bf16x2_t b = __builtin_convertvector(v, bf16x2_t); return __builtin_bit_cast(unsigned, b); }
__device__ __forceinline__ float bf2f(unsigned short b) { return __uint_as_float(((unsigned)b) << 16); }
__device__ __forceinline__ float bflo(unsigned w) { return __uint_as_float(w << 16); }
__device__ __forceinline__ float bfhi(unsigned w) { return __uint_as_float(w & 0xffff0000u); }
__device__ __forceinline__ float ex2(float x) { return __builtin_amdgcn_exp2f(x); }
__device__ __forceinline__ float sigmoidf_(float x) { return __builtin_amdgcn_rcpf(1.0f + ex2(-x * LOG2E)); }
__device__ __forceinline__ float wave_sum(float v) {
#pragma unroll
  for (int o = 1; o < 64; o <<= 1) v += __shfl_xor(v, o);
  return v;
}
__device__ __forceinline__ int otid() { int t = threadIdx.x; asm volatile("" : "+v"(t)); return t; }
__device__ __forceinline__ int oidx(int k) { asm volatile("" : "+s"(k)); return k; }
#define LBAR() asm volatile("s_waitcnt lgkmcnt(0)\n\ts_barrier" ::: "memory")
#define LWAIT() asm volatile("s_waitcnt lgkmcnt(0)" ::: "memory")

__device__ __forceinline__ u32x2 pack8_fp8(const float (&a)[4], const float (&b)[4]) {
  int w0 = __builtin_amdgcn_cvt_pk_fp8_f32(a[0], a[1], 0, false); w0 = __builtin_amdgcn_cvt_pk_fp8_f32(a[2], a[3], w0, true);
  int w1 = __builtin_amdgcn_cvt_pk_fp8_f32(b[0], b[1], 0, false); w1 = __builtin_amdgcn_cvt_pk_fp8_f32(b[2], b[3], w1, true);
  return (u32x2){(unsigned)w0, (unsigned)w1};
}
__device__ __forceinline__ long as_long(unsigned lo, unsigned hi) { return (long)(((unsigned long long)hi << 32) | (unsigned long long)lo); }
__device__ __forceinline__ f32x4 mfma16_fp8(long a, long b, f32x4 c) { return __builtin_amdgcn_mfma_f32_16x16x32_fp8_fp8(a, b, c, 0, 0, 0); }

__device__ __forceinline__ float xor32(float v) { const unsigned u = __float_as_uint(v); auto rr = __builtin_amdgcn_permlane32_swap(u, u, false, false); return __uint_as_float((threadIdx.x & 32) ? rr[0] : rr[1]); }
__device__ __forceinline__ float xor16(float v) { const unsigned u = __float_as_uint(v); auto rr = __builtin_amdgcn_permlane16_swap(u, u, false, false); return __uint_as_float((threadIdx.x & 16) ? rr[0] : rr[1]); }
__device__ __forceinline__ float max_x16_x32(float v) { const unsigned u = __float_as_uint(v); auto a = __builtin_amdgcn_permlane16_swap(u, u, false, false); const float w = fmaxf(__uint_as_float(a[0]), __uint_as_float(a[1]));
  const unsigned u2 = __float_as_uint(w); auto b = __builtin_amdgcn_permlane32_swap(u2, u2, false, false); return fmaxf(__uint_as_float(b[0]), __uint_as_float(b[1])); }

namespace pg8 {
constexpr int BM = 256, BK = 64, HALF = 128, HTB = HALF * BK * 2, STAGE_BYTES = 8 * HTB, NXCD = 8, WGM = 8;
__device__ __forceinline__ int lds_byte(int r, int c) { const int st = (r >> 4) * 2 + (c >> 5), rr = r & 15, cc = c & 31, ob = rr * 64 + cc * 2; return st * 1024 + (ob ^ (((ob >> 9) & 1) << 5)); }
__device__ __forceinline__ void stage_rc(int b, int& R, int& C) { const int st = b / 1024, sb = b % 1024, swz = sb ^ (((sb >> 9) & 1) << 5); R = (st >> 1) * 16 + swz / 64; C = (st & 1) * 32 + (swz % 64) / 2; }
__device__ __forceinline__ int perm32(int rho) { const int n = rho >> 4, i = rho & 15; return 8 * (i >> 2) + 4 * n + (i & 3); }
struct Unit { int pm, pn; };
struct Gemm { const bf16_t* A; const bf16_t* Bt; int M, N, K, lda, ldb; };
__device__ __forceinline__ void tile_of(int L, int nM, int nN, Unit& u) {
  const int nwg = nM * nN; int wgid = L;
  { const int q = nwg / NXCD, r = nwg % NXCD, xcd = wgid % NXCD, off = wgid / NXCD; wgid = (xcd < r ? xcd * (q + 1) : r * (q + 1) + (xcd - r) * q) + off; }
  const int nig = WGM * nN, gid = wgid / nig, fm = gid * WGM, gsz = (nM - fm) < WGM ? (nM - fm) : WGM;
  u.pm = fm + ((wgid % nig) % gsz); u.pn = (wgid % nig) / gsz;
}
struct StaticOrder {
  int nM, nN, nwg, G, c;
  __device__ void init(int M, int N, int G_, int c_) { nM = M / BM; nN = N / BM; nwg = nM * nN; G = G_; c = c_; }
  __device__ __forceinline__ bool next(int i, Unit& u) const { const long L = (long)i * G + c; if (L >= nwg) return false; tile_of((int)L, nM, nN, u); return true; }
};
struct MergeOrder {
  int G, c;
  __device__ __forceinline__ bool next(int k, Unit& u) const { const int r = k / 3, i = k - 3 * r; const int L = r * G + c; if (L >= 512) return false; Unit t; tile_of(L, 128, 4, t); u.pm = i * 128 + t.pm; u.pn = i * 4 + t.pn; return true; }
};

template <class Epi, class Sched>
__device__ __forceinline__ void gemm_phase(LAS unsigned char* lds, const Gemm g, const Sched& S, const Epi& E) {
  const int tid = otid(), wid = __builtin_amdgcn_readfirstlane(tid >> 6), lane = tid & 63, wr = wid >> 2, wc = wid & 3, fr = lane & 15, fq = lane >> 4;
  const int K = g.K, nt = K / BK;
  unsigned voffA[2], voffB[2];
#pragma unroll
  for (int i = 0; i < 2; ++i) { int R, C; stage_rc(tid * 16 + i * 8192, R, C); const int Rb = (R & ~31) + perm32(R & 31);
    voffA[i] = (unsigned)(R * g.lda + C) * 2u; voffB[i] = (unsigned)(Rb * g.ldb + C) * 2u; }
  const size_t kstep = (size_t)(BK * 2);
  const size_t hstepA = (size_t)HALF * g.lda * 2, hstepB = (size_t)HALF * g.ldb * 2;
  const size_t tstepA = 2 * hstepA, tstepB = 2 * hstepB;
  const unsigned ldsw = (unsigned)wid * 1024u;
  const int aoff = lds_byte(wr * 64 + fr, fq * 8), boff = lds_byte(wc * 32 + fr, fq * 8);
#define PG8_SA(b, h) (((b) * 2 + (h)) * HTB)
#define PG8_SB(b, h) ((4 + (b) * 2 + (h)) * HTB)
#define PG8_STAGE(bufoff, gbase, voff) do { _Pragma("unroll") for (int _i = 0; _i < 2; ++_i) \
        __builtin_amdgcn_global_load_lds((const unsigned*)((const char*)(gbase) + (voff)[_i]), (LAS unsigned*)(lds + (bufoff) + ldsw + _i * 8192), 16, 0, 0); } while (0)
#define PG8_LDA(dst, b, h) do { _Pragma("unroll") for (int m = 0; m < 4; ++m) _Pragma("unroll") for (int k = 0; k < 2; ++k) dst[m][k] = *(const LAS bf16x8*)(lds + PG8_SA(b, h) + aoff + m * 2048 + k * 1024); } while (0)
#define PG8_LDB(dst, b, h) do { _Pragma("unroll") for (int n = 0; n < 2; ++n) _Pragma("unroll") for (int k = 0; k < 2; ++k) dst[n][k] = *(const LAS bf16x8*)(lds + PG8_SB(b, h) + boff + n * 2048 + k * 1024); } while (0)
#define PG8_MMA(ai, bj, At, Bt) do { __builtin_amdgcn_s_setprio(1); _Pragma("unroll") for (int m = 0; m < 4; ++m) _Pragma("unroll") for (int n = 0; n < 2; ++n) _Pragma("unroll") for (int k = 0; k < 2; ++k) \
        acc[ai][bj][m][n] = __builtin_amdgcn_mfma_f32_16x16x32_bf16(Bt[n][k], At[m][k], acc[ai][bj][m][n], 0, 0, 0); __builtin_amdgcn_s_setprio(0); } while (0)
#define PG8_WAIT_V(n) asm volatile("s_waitcnt vmcnt(" #n ")" ::: "memory")
#define PG8_WAIT_L(n) asm volatile("s_waitcnt lgkmcnt(" #n ")" ::: "memory")
#define PG8_BAR __builtin_amdgcn_s_barrier()
#define PG8_SCHED __builtin_amdgcn_sched_barrier(0)
  Unit cur, nxt; int ui = 0;
  if (!S.next(0, cur)) return;
  f32x4 acc[2][2][4][2];
#pragma unroll
  for (int a = 0; a < 2; ++a)
#pragma unroll
    for (int b = 0; b < 2; ++b)
#pragma unroll
      for (int m = 0; m < 4; ++m)
#pragma unroll
        for (int n = 0; n < 2; ++n) acc[a][b][m][n] = (f32x4){0.f, 0.f, 0.f, 0.f};
  bf16x8 At[4][2], B0[2][2], B1[2][2];
  const char* cA = (const char*)g.A + (size_t)cur.pm * tstepA; const char* cB = (const char*)g.Bt + (size_t)cur.pn * tstepB;
  PG8_STAGE(PG8_SB(0, 0), cB, voffB); PG8_STAGE(PG8_SB(0, 1), cB + hstepB, voffB); PG8_STAGE(PG8_SA(0, 0), cA, voffA); PG8_STAGE(PG8_SA(0, 1), cA + hstepA, voffA);
  if (wr == 1) PG8_BAR;
  PG8_WAIT_V(2); PG8_BAR;
  PG8_STAGE(PG8_SB(1, 0), cB + kstep, voffB); PG8_STAGE(PG8_SA(1, 0), cA + kstep, voffA); PG8_STAGE(PG8_SB(1, 1), cB + hstepB + kstep, voffB);
  PG8_WAIT_V(6); PG8_BAR;
  for (;;) {
    const bool has_next = S.next(ui + 1, nxt);
    const char* nA = has_next ? (const char*)g.A + (size_t)nxt.pm * tstepA : cA; const char* nB = has_next ? (const char*)g.Bt + (size_t)nxt.pn * tstepB : cB;
    for (int t = 0; t < nt; t += 2) {
      const bool last = (t == nt - 2);
      const char* a1 = cA + (size_t)(t + 1) * kstep;
      const char* a2 = last ? nA : cA + (size_t)(t + 2) * kstep; const char* b2 = last ? nB : cB + (size_t)(t + 2) * kstep;
      const char* a3 = a2 + kstep; const char* b3 = b2 + kstep;
      PG8_LDB(B0, 0, 0); PG8_LDB(B1, 0, 1); PG8_SCHED; PG8_LDA(At, 0, 0); PG8_STAGE(PG8_SA(1, 1), a1 + hstepA, voffA);
      PG8_WAIT_V(8); PG8_WAIT_L(0); PG8_BAR; PG8_MMA(0, 0, At, B0); PG8_MMA(0, 1, At, B1); PG8_BAR; PG8_SCHED;
      PG8_LDA(At, 0, 1); PG8_STAGE(PG8_SB(0, 0), b2, voffB); PG8_STAGE(PG8_SB(0, 1), b2 + hstepB, voffB); PG8_STAGE(PG8_SA(0, 0), a2, voffA);
      PG8_WAIT_V(8); PG8_WAIT_L(0); PG8_BAR; PG8_MMA(1, 0, At, B0); PG8_MMA(1, 1, At, B1); PG8_BAR; PG8_SCHED;
      PG8_LDB(B0, 1, 0); PG8_LDB(B1, 1, 1); PG8_SCHED; PG8_LDA(At, 1, 0); PG8_STAGE(PG8_SA(0, 1), a2 + hstepA, voffA);
      PG8_WAIT_V(8); PG8_WAIT_L(0); PG8_BAR; PG8_MMA(0, 0, At, B0); PG8_MMA(0, 1, At, B1); PG8_BAR; PG8_SCHED;
      PG8_LDA(At, 1, 1); PG8_STAGE(PG8_SB(1, 0), b3, voffB); PG8_STAGE(PG8_SB(1, 1), b3 + hstepB, voffB); PG8_STAGE(PG8_SA(1, 0), a3, voffA);
      PG8_WAIT_V(8); PG8_WAIT_L(0); PG8_BAR; PG8_MMA(1, 0, At, B0); PG8_MMA(1, 1, At, B1); PG8_BAR; PG8_SCHED;
    }
    if (wr == 0) PG8_BAR;
    { const int l2 = otid() & 63; E(acc, cur, wr, wc, l2 & 15, l2 >> 4); }
    if (!has_next) break;
#pragma unroll
    for (int a = 0; a < 2; ++a)
#pragma unroll
      for (int b = 0; b < 2; ++b)
#pragma unroll
        for (int m = 0; m < 4; ++m)
#pragma unroll
          for (int n = 0; n < 2; ++n) acc[a][b][m][n] = (f32x4){0.f, 0.f, 0.f, 0.f};
    cur = nxt; cA = nA; cB = nB; ++ui;
    if (wr == 1) PG8_BAR;
  }
  PG8_WAIT_V(0);
  PG8_BAR;
#undef PG8_SA
#undef PG8_SB
#undef PG8_STAGE
#undef PG8_LDA
#undef PG8_LDB
#undef PG8_MMA
#undef PG8_WAIT_V
#undef PG8_WAIT_L
#undef PG8_BAR
#undef PG8_SCHED
}

__device__ __forceinline__ void store8(bf16_t* p, const f32x4& v0, const f32x4& v1) {
  u32x4 w; w.x = cvt_pk_bf16(v0[0], v0[1]); w.y = cvt_pk_bf16(v0[2], v0[3]); w.z = cvt_pk_bf16(v1[0], v1[1]); w.w = cvt_pk_bf16(v1[2], v1[3]); *(u32x4*)p = w;
}
__device__ __forceinline__ void rope8(f32x4& v0, f32x4& v1, const f32x2* cs) {
  const f32x4 a = *(const f32x4*)cs, b = *(const f32x4*)(cs + 2);
  float x1, x2;
  x1 = v0[0]; x2 = v0[1]; v0[0] = x1 * a[0] - x2 * a[1]; v0[1] = x2 * a[0] + x1 * a[1];
  x1 = v0[2]; x2 = v0[3]; v0[2] = x1 * a[2] - x2 * a[3]; v0[3] = x2 * a[2] + x1 * a[3];
  x1 = v1[0]; x2 = v1[1]; v1[0] = x1 * b[0] - x2 * b[1]; v1[1] = x2 * b[0] + x1 * b[1];
  x1 = v1[2]; x2 = v1[3]; v1[2] = x1 * b[2] - x2 * b[3]; v1[3] = x2 * b[2] + x1 * b[3];
}
__device__ __forceinline__ float row_rstd(const float* rss, size_t row) { const f32x4 q = *(const f32x4*)(rss + row * 4); return __builtin_amdgcn_rsqf(((q[0] + q[1]) + (q[2] + q[3])) * (1.f / 1024.f) + NORM_EPS); }
#define EPI_FOR_ROWS for (int ai = 0; ai < 2; ++ai) for (int m = 0; m < 4; ++m)
struct EpiPlain {
  bf16_t* O; int ldc; const float* rss;
  __device__ __forceinline__ void operator()(const f32x4 (&acc)[2][2][4][2], const Unit& u, int wr, int wc, int fr, int fq) const {
#pragma unroll
    for (int ai = 0; ai < 2; ++ai)
#pragma unroll
      for (int m = 0; m < 4; ++m) { const size_t row = (size_t)u.pm * BM + ai * HALF + wr * 64 + m * 16 + fr;
#pragma unroll
        for (int bj = 0; bj < 2; ++bj) { const int col0 = u.pn * BM + bj * HALF + wc * 32 + 8 * fq; const float rs = rss ? row_rstd(rss, row) : 1.0f; store8(O + row * ldc + col0, acc[ai][bj][m][0] * rs, acc[ai][bj][m][1] * rs); } }
  }
};
struct EpiInproj {
  bf16_t* proj; bf16_t* qrot; bf16_t* vst; bf16_t* kst; const f32x2* cs64; const f32x2* cs32; const float* rss;
  __device__ __forceinline__ void operator()(const f32x4 (&acc)[2][2][4][2], const Unit& u, int wr, int wc, int fr, int fq) const {
    constexpr unsigned ROPE_IN = (1u << 0) | (1u << 1) | (1u << 2) | (1u << 3) | (1u << 4) | (1u << 12) | (1u << 14);
    constexpr unsigned ROPE_DUAL = (1u << 6) | (1u << 7) | (1u << 8) | (1u << 9);
#pragma unroll
    for (int ai = 0; ai < 2; ++ai)
#pragma unroll
      for (int m = 0; m < 4; ++m) { const size_t row = (size_t)u.pm * BM + ai * HALF + wr * 64 + m * 16 + fr; const float rs = row_rstd(rss, row);
#pragma unroll
        for (int bj = 0; bj < 2; ++bj) {
          const int seg = 2 * u.pn + bj; const int col0 = u.pn * BM + bj * HALF + wc * 32 + 8 * fq;
          f32x4 v0 = acc[ai][bj][m][0] * rs, v1 = acc[ai][bj][m][1] * rs;
          bf16_t* dst = proj + row * NPROJ + col0;
          if ((ROPE_IN >> seg) & 1u) { rope8(v0, v1, cs64 + row * 32 + ((col0 & 63) >> 1));
            if (seg == 12) {
              const int cc = col0 - C_BKS, gs = cc >> 6, d0 = cc & 63; const int b = (int)(row >> 13), s = (int)(row & 8191), blk = s >> 6, k6 = s & 63;
              const float a4[4] = {v0[0], v0[1], v0[2], v0[3]}, b4[4] = {v1[0], v1[1], v1[2], v1[3]};
              unsigned char* kd = (unsigned char*)kst + ((size_t)(b * 2 + gs) * 128 + blk) * 4096 + (((k6 >> 4) * 16 + (k6 & 15)) * 4 + ((d0 & 31) >> 3)) * 16 + (d0 >> 5) * 8;
              *(u32x2*)kd = pack8_fp8(a4, b4);
            } else store8(dst, v0, v1); }
          else if ((ROPE_DUAL >> seg) & 1u) { store8(dst, v0, v1); rope8(v0, v1, cs64 + row * 32 + ((col0 & 63) >> 1)); store8(qrot + row * 512 + (col0 - C_BQ), v0, v1); }
          else if (seg == 21 && wc == 0) { rope8(v0, v1, cs32 + row * 16 + ((col0 - C_CKR) >> 1)); store8(dst, v0, v1); }
          else {
            store8(dst, v0, v1);
            if (seg == 13) {
              const int cc = col0 - C_BVS, gs = cc >> 6, d0 = cc & 63; const int b = (int)(row >> 13), s = (int)(row & 8191), blk = s >> 6, k6 = s & 63, k5 = k6 & 31;
              const int lgp = (k5 & 15) >> 2, jj = ((k5 >> 4) << 2) | (k5 & 3);
              const float a4[4] = {v0[0], v0[1], v0[2], v0[3]}, b4[4] = {v1[0], v1[1], v1[2], v1[3]};
              const u32x2 q8 = pack8_fp8(a4, b4);
              unsigned char* vd = (unsigned char*)vst + ((size_t)(b * 2 + gs) * 128 + blk) * 4096 + (((d0 >> 4) * 16 + (d0 & 15)) * 4 + lgp) * 16 + (k6 >> 5) * 8 + jj;
              vd[0 * 64] = (unsigned char)(q8.x); vd[1 * 64] = (unsigned char)(q8.x >> 8); vd[2 * 64] = (unsigned char)(q8.x >> 16); vd[3 * 64] = (unsigned char)(q8.x >> 24);
              vd[4 * 64] = (unsigned char)(q8.y); vd[5 * 64] = (unsigned char)(q8.y >> 8); vd[6 * 64] = (unsigned char)(q8.y >> 16); vd[7 * 64] = (unsigned char)(q8.y >> 24);
            }
          }
        } }
  }
};
struct EpiMlaQ {
  bf16_t* O; const f32x2* cs32;
  __device__ __forceinline__ void operator()(const f32x4 (&acc)[2][2][4][2], const Unit& u, int wr, int wc, int fr, int fq) const {
#pragma unroll
    for (int ai = 0; ai < 2; ++ai)
#pragma unroll
      for (int m = 0; m < 4; ++m) { const size_t row = (size_t)u.pm * BM + ai * HALF + wr * 64 + m * 16 + fr;
#pragma unroll
        for (int bj = 0; bj < 2; ++bj) { const int col0 = u.pn * BM + bj * HALF + wc * 32 + 8 * fq; const int o = col0 % 96;
          f32x4 v0 = acc[ai][bj][m][0], v1 = acc[ai][bj][m][1];
          if (o >= 64) rope8(v0, v1, cs32 + row * 16 + ((o - 64) >> 1));
          store8(O + row * 768 + col0, v0, v1); } }
  }
};
struct EpiGates {
  bf16_t* O; const float* rss;
  __device__ __forceinline__ void operator()(const f32x4 (&acc)[2][2][4][2], const Unit& u, int wr, int wc, int fr, int fq) const {
#pragma unroll
    for (int ai = 0; ai < 2; ++ai)
#pragma unroll
      for (int m = 0; m < 4; ++m) { const size_t row = (size_t)u.pm * BM + ai * HALF + wr * 64 + m * 16 + fr; const float rs = row_rstd(rss, row);
#pragma unroll
        for (int bj = 0; bj < 2; ++bj) { const int col0 = u.pn * BM + bj * HALF + wc * 32 + 8 * fq;
          f32x4 v0 = acc[ai][bj][m][0], v1 = acc[ai][bj][m][1];
#pragma unroll
          for (int e = 0; e < 4; ++e) { v0[e] = sigmoidf_(v0[e] * rs); v1[e] = sigmoidf_(v1[e] * rs); }
          store8(O + row * NGATE + col0, v0, v1); } }
  }
};
struct EpiMerge {
  const bf16_t* gates; bf16_t* merged;
  __device__ __forceinline__ void operator()(const f32x4 (&acc)[2][2][4][2], const Unit& u, int wr, int wc, int fr, int fq) const {
    const int br = u.pm >> 7, pm = u.pm & 127, pn = u.pn & 3;
#pragma unroll
    for (int ai = 0; ai < 2; ++ai)
#pragma unroll
      for (int m = 0; m < 4; ++m) { const size_t row = (size_t)pm * BM + ai * HALF + wr * 64 + m * 16 + fr;
#pragma unroll
        for (int bj = 0; bj < 2; ++bj) { const int col0 = pn * BM + bj * HALF + wc * 32 + 8 * fq;
          f32x4 v0 = acc[ai][bj][m][0], v1 = acc[ai][bj][m][1];
          const u32x4 gw = *(const u32x4*)(gates + row * NGATE + br * 1024 + col0);
          v0[0] *= bflo(gw.x); v0[1] *= bfhi(gw.x); v0[2] *= bflo(gw.y); v0[3] *= bfhi(gw.y);
          v1[0] *= bflo(gw.z); v1[1] *= bfhi(gw.z); v1[2] *= bflo(gw.w); v1[3] *= bfhi(gw.w);
          bf16_t* dst = merged + row * 1024 + col0;
          if (br > 0) { const u32x4 pw = *(const u32x4*)dst;
            v0[0] += bflo(pw.x); v0[1] += bfhi(pw.x); v0[2] += bflo(pw.y); v0[3] += bfhi(pw.y);
            v1[0] += bflo(pw.z); v1[1] += bfhi(pw.z); v1[2] += bflo(pw.w); v1[3] += bfhi(pw.w); }
          store8(dst, v0, v1); } }
  }
};
struct EpiResid {
  const float* res; float* out; bf16_t* xb; float* rss; LAS float* xl;
  __device__ __forceinline__ void operator()(const f32x4 (&acc)[2][2][4][2], const Unit& u, int wr, int wc, int fr, int fq) const {
#pragma unroll
    for (int ai = 0; ai < 2; ++ai)
#pragma unroll
      for (int m = 0; m < 4; ++m) { const size_t row = (size_t)u.pm * BM + ai * HALF + wr * 64 + m * 16 + fr; float ss = 0.f;
#pragma unroll
        for (int bj = 0; bj < 2; ++bj) { const int col0 = u.pn * BM + bj * HALF + wc * 32 + 8 * fq; const size_t off = row * 1024 + col0;
          const f32x4 r0 = *(const f32x4*)(res + off) + acc[ai][bj][m][0], r1 = *(const f32x4*)(res + off + 4) + acc[ai][bj][m][1];
          *(f32x4*)(out + off) = r0; *(f32x4*)(out + off + 4) = r1; store8(xb + off, r0, r1);
          ss += (r0[0] * r0[0] + r0[1] * r0[1]) + (r0[2] * r0[2] + r0[3] * r0[3]) + (r1[0] * r1[0] + r1[1] * r1[1]) + (r1[2] * r1[2] + r1[3] * r1[3]); }
        ss += xor16(ss); ss += xor32(ss);
        if (fq == 0) xl[wc * 256 + ai * HALF + wr * 64 + m * 16 + fr] = ss; }
    asm volatile("s_waitcnt lgkmcnt(0)\n\ts_barrier" ::: "memory");
    { const int t2 = otid(); if (t2 < 256) rss[((size_t)u.pm * BM + t2) * 4 + u.pn] = (xl[t2] + xl[256 + t2]) + (xl[512 + t2] + xl[768 + t2]); }
    asm volatile("s_waitcnt lgkmcnt(0)\n\ts_barrier" ::: "memory");
  }
};
struct EpiSwiglu {
  bf16_t* O; const float* rss;
  __device__ __forceinline__ void operator()(const f32x4 (&acc)[2][2][4][2], const Unit& u, int wr, int wc, int fr, int fq) const {
#pragma unroll
    for (int ai = 0; ai < 2; ++ai)
#pragma unroll
      for (int m = 0; m < 4; ++m) { const size_t row = (size_t)u.pm * BM + ai * HALF + wr * 64 + m * 16 + fr; const float rs = row_rstd(rss, row);
#pragma unroll
        for (int bj = 0; bj < 2; ++bj) { const int col0 = u.pn * BM + bj * HALF + wc * 32 + 8 * fq;
          const f32x4 gt = acc[ai][bj][m][0] * rs, up = acc[ai][bj][m][1] * rs; float r[4];
#pragma unroll
          for (int e = 0; e < 4; ++e) r[e] = gt[e] * sigmoidf_(gt[e]) * up[e];
          u32x2 w; w.x = cvt_pk_bf16(r[0], r[1]); w.y = cvt_pk_bf16(r[2], r[3]);
          *(u32x2*)(O + row * DFF + (col0 >> 1)) = w; } }
  }
};
}

__device__ __forceinline__ f32x4 mfma16(bf16x8 a, bf16x8 b, f32x4 c) { return __builtin_amdgcn_mfma_f32_16x16x32_bf16(a, b, c, 0, 0, 0); }
__device__ __forceinline__ s16x4 ds_tr(LAS const unsigned char* p) { return __builtin_bit_cast(s16x4, __builtin_amdgcn_ds_read_tr16_b64_v4i16((LAS v4i16_t*)p)); }
__device__ __forceinline__ bf16x8 pack8(const float (&a)[4], const float (&b)[4]) {
  u32x4 w; w.x = cvt_pk_bf16(a[0], a[1]); w.y = cvt_pk_bf16(a[2], a[3]); w.z = cvt_pk_bf16(b[0], b[1]); w.w = cvt_pk_bf16(b[2], b[3]); return __builtin_bit_cast(bf16x8, w);
}
enum { MODE_NONE = 0, MODE_CAUSAL = 1, MODE_WINDOW = 2, MODE_CMP = 3 };
template <int MODE> __device__ __forceinline__ bool mask_ok(int tq, int kp, int W) {
  if (MODE == MODE_CAUSAL) return kp <= tq;
  if (MODE == MODE_WINDOW) return kp <= tq && kp > tq - W;
  if (MODE == MODE_CMP) return 16 * kp + 31 <= tq;
  return true;
}
template <int NT, int NKK, int NDT, int MODE, bool MASK>
__device__ __forceinline__ void attn_chunk(f32x4 (&o)[NT][NDT], float (&m)[NT], float (&l)[NT], const bf16x8 (&qf)[NT][NKK],
                                           LAS const unsigned char* Kl, int KSTR, LAS const unsigned char* Vl, int VSTR, int kpos0, const int (&tq)[NT], float c, int W, int lane) {
  constexpr int JB = 2;
  const int r = lane & 15, lg = lane >> 4, vq = (lane & 15) >> 2, vp = lane & 3;
#pragma unroll 1
  for (int st = 0; st < 2; ++st) {
#pragma unroll
    for (int jh = 0; jh < NT / JB; ++jh) {
      int oz = 0; if (NT > JB) asm volatile("" : "+v"(oz));
      f32x4 s[JB][2];
      __builtin_amdgcn_s_setprio(1);
#pragma unroll
      for (int t = 0; t < 2; ++t)
#pragma unroll
        for (int kk = 0; kk < NKK; ++kk) {
          const bf16x8 kf = *(LAS const bf16x8*)(Kl + oz + (32 * st + 16 * t + r) * KSTR + (32 * kk + 8 * lg) * 2);
#pragma unroll
          for (int jj = 0; jj < JB; ++jj) s[jj][t] = mfma16(kf, qf[jh * JB + jj][kk], kk == 0 ? (f32x4){0.f, 0.f, 0.f, 0.f} : s[jj][t]);
        }
      __builtin_amdgcn_s_setprio(0);
      bf16x8 pf[JB];
      if (NT > JB) __builtin_amdgcn_sched_barrier(0);
#pragma unroll
      for (int jj = 0; jj < JB; ++jj) {
        const int j = jh * JB + jj;
        float mx = -INFINITY;
#pragma unroll
        for (int t = 0; t < 2; ++t)
#pragma unroll
          for (int i = 0; i < 4; ++i) {
            if (MASK) { const int kp = kpos0 + 32 * st + 16 * t + 4 * lg + i; if (!mask_ok<MODE>(tq[j], kp, W)) s[jj][t][i] = -INFINITY; }
            mx = fmaxf(mx, s[jj][t][i]);
          }
        mx = max_x16_x32(mx);
        if (NT > 2 || __any(mx > m[j] + 8.0f / c)) {
          const float mnew = fmaxf(m[j], mx);
          const float ms2 = (mnew == -INFINITY) ? 0.f : mnew;
          const float alpha = ex2((m[j] - ms2) * c);
          m[j] = mnew; l[j] *= alpha;
#pragma unroll
          for (int dt = 0; dt < NDT; ++dt) o[j][dt] *= alpha;
        }
        const float mc = ((m[j] == -INFINITY) ? 0.f : m[j]) * c;
        float p0[4], p1[4], ps = 0.f;
#pragma unroll
        for (int i = 0; i < 4; ++i) { p0[i] = ex2(s[jj][0][i] * c - mc); p1[i] = ex2(s[jj][1][i] * c - mc); ps += p0[i] + p1[i]; }
        l[j] += ps;
        pf[jj] = pack8(p0, p1);
      }
      if (NT > JB) __builtin_amdgcn_sched_barrier(0);
      __builtin_amdgcn_s_setprio(1);
#pragma unroll
      for (int dt = 0; dt < NDT; ++dt) {
        const s16x4 v0 = ds_tr(Vl + oz + (32 * st + 4 * lg + vq) * VSTR + (16 * dt + 4 * vp) * 2);
        const s16x4 v1 = ds_tr(Vl + oz + (32 * st + 16 + 4 * lg + vq) * VSTR + (16 * dt + 4 * vp) * 2);
        const bf16x8 vf = (bf16x8){v0[0], v0[1], v0[2], v0[3], v1[0], v1[1], v1[2], v1[3]};
#pragma unroll
        for (int jj = 0; jj < JB; ++jj) o[jh * JB + jj][dt] = mfma16(vf, pf[jj], o[jh * JB + jj][dt]);
      }
      __builtin_amdgcn_s_setprio(0);
      if (NT > JB) __builtin_amdgcn_sched_barrier(0);
    }
  }
}

template <int NT, int NKK, int NDT, int MODE, bool MASK>
__device__ __forceinline__ void attn_chunk_wide(f32x4 (&o)[NT][NDT], float (&m)[NT], float (&l)[NT], const bf16x8 (&qf)[NT][NKK],
                                                LAS const unsigned char* Kl, int KSTR, LAS const unsigned char* Vl, int VSTR, int kpos0, const int (&tq)[NT], float c, int W, int lane) {
  const int r = lane & 15, lg = lane >> 4, vq = (lane & 15) >> 2, vp = lane & 3;
  f32x4 s[NT][4];
  __builtin_amdgcn_s_setprio(1);
#pragma unroll
  for (int t = 0; t < 4; ++t)
#pragma unroll
    for (int kk = 0; kk < NKK; ++kk) {
      const bf16x8 kf = *(LAS const bf16x8*)(Kl + (16 * t + r) * KSTR + (32 * kk + 8 * lg) * 2);
#pragma unroll
      for (int j = 0; j < NT; ++j) s[j][t] = mfma16(kf, qf[j][kk], kk == 0 ? (f32x4){0.f, 0.f, 0.f, 0.f} : s[j][t]);
    }
  __builtin_amdgcn_s_setprio(0);
  bf16x8 pf[NT][2];
#pragma unroll
  for (int j = 0; j < NT; ++j) {
    float mx = -INFINITY;
#pragma unroll
    for (int t = 0; t < 4; ++t)
#pragma unroll
      for (int i = 0; i < 4; ++i) {
        if (MASK) { const int kp = kpos0 + 16 * t + 4 * lg + i; if (!mask_ok<MODE>(tq[j], kp, W)) s[j][t][i] = -INFINITY; }
        mx = fmaxf(mx, s[j][t][i]);
      }
    mx = max_x16_x32(mx);
    if (__any(mx > m[j] + 8.0f / c)) {
      const float mnew = fmaxf(m[j], mx);
      const float ms2 = (mnew == -INFINITY) ? 0.f : mnew;
      const float alpha = ex2((m[j] - ms2) * c);
      m[j] = mnew; l[j] *= alpha;
#pragma unroll
      for (int dt = 0; dt < NDT; ++dt) o[j][dt] *= alpha;
    }
    const float mc = ((m[j] == -INFINITY) ? 0.f : m[j]) * c;
    float p[4][4], ps = 0.f;
#pragma unroll
    for (int t = 0; t < 4; ++t)
#pragma unroll
      for (int i = 0; i < 4; ++i) { p[t][i] = ex2(s[j][t][i] * c - mc); ps += p[t][i]; }
    l[j] += ps;
    pf[j][0] = pack8(p[0], p[1]); pf[j][1] = pack8(p[2], p[3]);
  }
  __builtin_amdgcn_s_setprio(1);
#pragma unroll
  for (int st = 0; st < 2; ++st)
#pragma unroll
    for (int dt = 0; dt < NDT; ++dt) {
      const s16x4 v0 = ds_tr(Vl + (32 * st + 4 * lg + vq) * VSTR + (16 * dt + 4 * vp) * 2);
      const s16x4 v1 = ds_tr(Vl + (32 * st + 16 + 4 * lg + vq) * VSTR + (16 * dt + 4 * vp) * 2);
      const bf16x8 vf = (bf16x8){v0[0], v0[1], v0[2], v0[3], v1[0], v1[1], v1[2], v1[3]};
#pragma unroll
      for (int j = 0; j < NT; ++j) o[j][dt] = mfma16(vf, pf[j][st], o[j][dt]);
    }
  __builtin_amdgcn_s_setprio(0);
}

template <int NT, int DQK, int DV, int MODE, int PD, class Src>
__device__ __forceinline__ void attn_block_loop(LAS unsigned char* lds, const Src& src, f32x4 (&o)[NT][DV / 16], float (&m)[NT], float (&l)[NT], const bf16x8 (&qf)[NT][DQK / 32],
                                                const int (&tq)[NT], int kc0, int kc1, int kbase, int tq_min, int tq_max, float c, int W) {
  constexpr int KSTR = DQK * 2 + 16, VSTR = DV * 2 + 32, KB = 64 * KSTR, VB = 64 * VSTR, BUF = KB + VB;
  constexpr int KCH = DQK / 8, VCH = DV / 8, NKI = 64 * KCH, NVI = 64 * VCH, NKR = (NKI + 511) / 512, NVR = (NVI + 511) / 512;
  const int tid = otid(), lane = tid & 63;
  u32x4 kreg[PD][NKR], vreg[PD][NVR];
#define ABL_LOAD(u, kc) do { \
    _Pragma("unroll") for (int rr = 0; rr < NKR; ++rr) { const int idx = tid + 512 * rr; if (idx < NKI) { const int row = idx / KCH, ch = idx % KCH; kreg[u][rr] = *(const u32x4*)src.kaddr((kc) * 64 + row, ch); } } \
    _Pragma("unroll") for (int rr = 0; rr < NVR; ++rr) { const int idx = tid + 512 * rr; if (idx < NVI) { const int row = idx / VCH, ch = idx % VCH; vreg[u][rr] = *(const u32x4*)src.vaddr((kc) * 64 + row, ch); } } } while (0)
#pragma unroll
  for (int u = 0; u < PD; ++u) if (kc0 + u < kc1) ABL_LOAD(u, kc0 + u);
  for (int kcb = kc0; kcb < kc1; kcb += PD) {
#pragma unroll
    for (int u = 0; u < PD; ++u) {
      const int kc = kcb + u;
      if (kc < kc1) {
        LAS unsigned char* buf = lds + ((kc - kc0) & 1) * BUF;
#pragma unroll
        for (int rr = 0; rr < NKR; ++rr) { const int idx = tid + 512 * rr; if (idx < NKI) { const int row = idx / KCH, ch = idx % KCH; *(LAS u32x4*)(buf + row * KSTR + ch * 16) = kreg[u][rr]; } }
#pragma unroll
        for (int rr = 0; rr < NVR; ++rr) { const int idx = tid + 512 * rr; if (idx < NVI) { const int row = idx / VCH, ch = idx % VCH; *(LAS u32x4*)(buf + KB + row * VSTR + ch * 16) = vreg[u][rr]; } }
        if (kc + PD < kc1) ABL_LOAD(u, kc + PD);
        LBAR();
        const int lo = kbase + 64 * kc, hi = lo + 63;
        bool rel = true, full = true;
        if (MODE == MODE_CAUSAL) { rel = lo <= tq_max; full = hi <= tq_min; }
        if (MODE == MODE_WINDOW) { rel = (lo <= tq_max) && (hi > tq_min - W); full = (hi <= tq_min) && (lo > tq_max - W); }
        if (MODE == MODE_CMP) { rel = 16 * lo + 31 <= tq_max; full = 16 * hi + 31 <= tq_min; }
        if (rel) {
          if (NT <= 2) {
            if (full) attn_chunk_wide<NT, DQK / 32, DV / 16, MODE, false>(o, m, l, qf, buf, KSTR, buf + KB, VSTR, lo, tq, c, W, lane);
            else attn_chunk_wide<NT, DQK / 32, DV / 16, MODE, true>(o, m, l, qf, buf, KSTR, buf + KB, VSTR, lo, tq, c, W, lane);
          } else {
            if (full) attn_chunk<NT, DQK / 32, DV / 16, MODE, false>(o, m, l, qf, buf, KSTR, buf + KB, VSTR, lo, tq, c, W, lane);
            else attn_chunk<NT, DQK / 32, DV / 16, MODE, true>(o, m, l, qf, buf, KSTR, buf + KB, VSTR, lo, tq, c, W, lane);
          }
        }
      }
    }
  }
#undef ABL_LOAD
  LBAR();
}
__device__ __forceinline__ float lsum4(float l) { l += xor16(l); l += xor32(l); return l; }
__device__ __forceinline__ void store4(bf16_t* p, const f32x4& v, float sc) { u32x2 w; w.x = cvt_pk_bf16(v[0] * sc, v[1] * sc); w.y = cvt_pk_bf16(v[2] * sc, v[3] * sc); *(u32x2*)p = w; }

struct Params {
  const float* in[29]; float* out; unsigned char* ws; float invf64[32]; float invf32[16]; int pad0, pad1;
};
struct Ctx {
  const float* const* in; unsigned char* ws; float* out; int G, blk;
  __device__ __forceinline__ bf16_t* W() const { return (bf16_t*)(ws + WS_W); }
  __device__ __forceinline__ bf16_t* H() const { return (bf16_t*)(ws + WS_H); }
  __device__ __forceinline__ bf16_t* PROJ() const { return (bf16_t*)(ws + WS_PROJ); }
  __device__ __forceinline__ bf16_t* QM() const { return (bf16_t*)(ws + WS_QM); }
  __device__ __forceinline__ bf16_t* KVM() const { return (bf16_t*)(ws + WS_KVM); }
  __device__ __forceinline__ bf16_t* OA() const { return (bf16_t*)(ws + WS_KVM); }
  __device__ __forceinline__ bf16_t* OC() const { return (bf16_t*)(ws + WS_OC); }
  __device__ __forceinline__ bf16_t* QROT() const { return (bf16_t*)(ws + WS_QROT); }
  __device__ __forceinline__ bf16_t* VST() const { return (bf16_t*)(ws + WS_VST); }
  __device__ __forceinline__ bf16_t* KST() const { return (bf16_t*)(ws + WS_KST); }
  __device__ __forceinline__ bf16_t* KCMP() const { return (bf16_t*)(ws + WS_KCMP); }
  __device__ __forceinline__ bf16_t* VCMP() const { return (bf16_t*)(ws + WS_VCMP); }
  __device__ __forceinline__ bf16_t* MEMKV() const { return (bf16_t*)(ws + WS_MEMKV); }
  __device__ __forceinline__ bf16_t* HM() const { return (bf16_t*)(ws + WS_HM); }
  __device__ __forceinline__ float* RSS() const { return (float*)(ws + WS_RSS); }
  __device__ __forceinline__ unsigned char* SELL() const { return ws + WS_SELL; }
  __device__ __forceinline__ bf16_t* OW() const { return (bf16_t*)(ws + WS_QM); }
  __device__ __forceinline__ f32x2* CS64() const { return (f32x2*)(ws + WS_CS64); }
  __device__ __forceinline__ f32x2* CS32() const { return (f32x2*)(ws + WS_CS32); }
};

struct SrcMla { const bf16_t* kvm; const bf16_t* proj; size_t rowbase; int h;
  __device__ __forceinline__ const bf16_t* kaddr(int krow, int ch) const { return ch < 8 ? kvm + (rowbase + krow) * 1024 + 128 * h + 8 * ch : proj + (rowbase + krow) * NPROJ + C_CKR + 8 * (ch - 8); }
  __device__ __forceinline__ const bf16_t* vaddr(int krow, int ch) const { return kvm + (rowbase + krow) * 1024 + 128 * h + 64 + 8 * ch; } };
__device__ __forceinline__ void mla_unit(LAS unsigned char* lds, const Ctx& X, int b, int h, int qb) {
  const int tid = otid(), lane = tid & 63, w = __builtin_amdgcn_readfirstlane(tid >> 6), cq = lane & 15, lg = lane >> 4;
  const size_t rowbase = (size_t)b * S; const int qw = qb * 256 + 32 * w;
  bf16x8 qf[2][3]; int tq[2]; f32x4 o[2][4]; float m[2], l[2];
#pragma unroll
  for (int j = 0; j < 2; ++j) { tq[j] = qw + 16 * j + cq; m[j] = -INFINITY; l[j] = 0.f;
#pragma unroll
    for (int kk = 0; kk < 3; ++kk) qf[j][kk] = *(const bf16x8*)(X.QM() + (rowbase + tq[j]) * 768 + 96 * h + 32 * kk + 8 * lg);
#pragma unroll
    for (int dt = 0; dt < 4; ++dt) o[j][dt] = (f32x4){0.f, 0.f, 0.f, 0.f}; }
  SrcMla src{X.KVM(), X.PROJ(), rowbase, h};
  const float c = 0.10206207261596577f * LOG2E;
  attn_block_loop<2, 96, 64, MODE_CAUSAL, 3, SrcMla>(lds, src, o, m, l, qf, tq, 0, 4 * (qb + 1), 0, qw, qw + 31, c, 0);
#pragma unroll
  for (int j = 0; j < 2; ++j) { const float lt = lsum4(l[j]); const float inv = lt > 0.f ? 1.0f / lt : 0.f;
#pragma unroll
    for (int dt = 0; dt < 4; ++dt) store4(X.OC() + (rowbase + tq[j]) * 512 + 64 * h + 16 * dt + 4 * lg, o[j][dt], inv); }
}
struct SrcX { const bf16_t* kv; size_t rowbase; int h;
  __device__ __forceinline__ const bf16_t* kaddr(int krow, int ch) const { return kv + (rowbase + krow) * 1024 + 128 * h + 8 * ch; }
  __device__ __forceinline__ const bf16_t* vaddr(int krow, int ch) const { return kv + (rowbase + krow) * 1024 + 512 + 128 * h + 8 * ch; } };
__device__ __forceinline__ void xattn_unit(LAS unsigned char* lds, const Ctx& X, const bf16_t* xq, bf16_t* ox, int b, int h, int qb) {
  const int tid = otid(), lane = tid & 63, w = __builtin_amdgcn_readfirstlane(tid >> 6), cq = lane & 15, lg = lane >> 4;
  const size_t rowbase = (size_t)b * S; const int qw = qb * 256 + 32 * w;
  bf16x8 qf[2][4]; int tq[2]; f32x4 o[2][8]; float m[2], l[2];
#pragma unroll
  for (int j = 0; j < 2; ++j) { tq[j] = qw + 16 * j + cq; m[j] = -INFINITY; l[j] = 0.f;
#pragma unroll
    for (int kk = 0; kk < 4; ++kk) qf[j][kk] = *(const bf16x8*)(xq + (rowbase + tq[j]) * 512 + 128 * h + 32 * kk + 8 * lg);
#pragma unroll
    for (int dt = 0; dt < 8; ++dt) o[j][dt] = (f32x4){0.f, 0.f, 0.f, 0.f}; }
  SrcX src{X.MEMKV(), (size_t)b * 256, h};
  const float c = 0.08838834764831845f * LOG2E;
  attn_block_loop<2, 128, 128, MODE_NONE, 2, SrcX>(lds, src, o, m, l, qf, tq, 0, 4, 0, 0, 0, c, 0);
#pragma unroll
  for (int j = 0; j < 2; ++j) { const float lt = lsum4(l[j]); const float inv = lt > 0.f ? 1.0f / lt : 0.f;
#pragma unroll
    for (int dt = 0; dt < 8; ++dt) store4(ox + (rowbase + tq[j]) * 512 + 128 * h + 16 * dt + 4 * lg, o[j][dt], inv); }
}
struct SrcProj { const bf16_t* proj; size_t rowbase; int kcol, vcol;
  __device__ __forceinline__ const bf16_t* kaddr(int krow, int ch) const { return proj + (rowbase + krow) * NPROJ + kcol + 8 * ch; }
  __device__ __forceinline__ const bf16_t* vaddr(int krow, int ch) const { return proj + (rowbase + krow) * NPROJ + vcol + 8 * ch; } };
__device__ __forceinline__ void swa_unit(LAS unsigned char* lds, const Ctx& X, const float* sinks, int b, int kvh, int qb) {
  const int tid = otid(), lane = tid & 63, w = __builtin_amdgcn_readfirstlane(tid >> 6), cq = lane & 15, lg = lane >> 4;
  const size_t rowbase = (size_t)b * S; const int q0 = qb * 128, qw = q0 + 16 * w;
  bf16x8 qf[4][2]; int tq[4]; f32x4 o[4][4]; float m[4], l[4];
#pragma unroll
  for (int j = 0; j < 4; ++j) { tq[j] = qw + cq; m[j] = sinks[4 * kvh + j] * 8.0f; l[j] = (lg == 0) ? 1.0f : 0.f;
#pragma unroll
    for (int kk = 0; kk < 2; ++kk) qf[j][kk] = *(const bf16x8*)(X.PROJ() + (rowbase + tq[j]) * NPROJ + C_AQ + 64 * (4 * kvh + j) + 32 * kk + 8 * lg);
#pragma unroll
    for (int dt = 0; dt < 4; ++dt) o[j][dt] = (f32x4){0.f, 0.f, 0.f, 0.f}; }
  const int kbase = q0 - 128;
  SrcProj src{X.PROJ(), rowbase + kbase, C_AK + 64 * kvh, C_AV + 64 * kvh};
  const float c = 0.125f * LOG2E;
  attn_block_loop<4, 64, 64, MODE_WINDOW, 2, SrcProj>(lds, src, o, m, l, qf, tq, q0 == 0 ? 2 : 0, 4, kbase, qw, qw + 15, c, 128);
#pragma unroll
  for (int j = 0; j < 4; ++j) { const float lt = lsum4(l[j]); const float inv = lt > 0.f ? 1.0f / lt : 0.f;
#pragma unroll
    for (int dt = 0; dt < 4; ++dt) store4(X.OA() + (rowbase + tq[j]) * 512 + 64 * (4 * kvh + j) + 16 * dt + 4 * lg, o[j][dt], inv); }
}

struct SrcCmp { const bf16_t* k; const bf16_t* v;
  __device__ __forceinline__ const bf16_t* kaddr(int krow, int ch) const { return k + (size_t)krow * 64 + 8 * ch; }
  __device__ __forceinline__ const bf16_t* vaddr(int krow, int ch) const { return v + (size_t)krow * 64 + 8 * ch; } };
constexpr int NSA_BUF = 2 * (64 * 144 + 64 * 160);
constexpr int NSA_IMP = 16 * 132 * 4;
static_assert(NSA_BUF + 8 * NSA_IMP <= LDS_BYTES, "nsa lds");

template <bool MASK>
__device__ __forceinline__ void cmp_imp_chunk(const bf16x8 (&qf)[4][2], LAS const unsigned char* Kl, int kpos0, int tq, const float (&mc)[4], const float (&inv)[4], float c,
                                              float& carry_prev, LAS float* imp_row, int lane) {
  const int r = lane & 15, lg = lane >> 4; const int src = (lane + 48) & 63;
#pragma unroll
  for (int st = 0; st < 2; ++st)
#pragma unroll
    for (int t = 0; t < 2; ++t) {
      f32x4 s[4];
#pragma unroll
      for (int kk = 0; kk < 2; ++kk) { const bf16x8 kf = *(LAS const bf16x8*)(Kl + (32 * st + 16 * t + r) * 144 + (32 * kk + 8 * lg) * 2);
#pragma unroll
        for (int j = 0; j < 4; ++j) s[j] = mfma16(kf, qf[j][kk], kk == 0 ? (f32x4){0.f, 0.f, 0.f, 0.f} : s[j]); }
      float ps[4];
#pragma unroll
      for (int i = 0; i < 4; ++i) { const int kp = kpos0 + 32 * st + 16 * t + 4 * lg + i; float a = 0.f;
#pragma unroll
        for (int j = 0; j < 4; ++j) a += ex2(s[j][i] * c - mc[j]) * inv[j];
        ps[i] = (!MASK || (16 * kp + 31 <= tq)) ? a : 0.f; }
      const float own = 2.0f * (ps[0] + ps[1] + ps[2]) + ps[3];
      const float up_same = __shfl(ps[3], src), up_prev = __shfl(carry_prev, src);
      const float cin = lg > 0 ? up_same : up_prev;
      carry_prev = ps[3];
      imp_row[((kpos0 + 32 * st + 16 * t) >> 2) + lg] = own + cin;
    }
}

__device__ __forceinline__ void nsa_unit(LAS unsigned char* lds, const Ctx& X, bf16_t* OB, int b, int g, int qb) {
  const int tid = otid(), lane = tid & 63, w = __builtin_amdgcn_readfirstlane(tid >> 6);
#define cq ((otid() & 63) & 15)
#define lg ((otid() & 63) >> 4)
  const size_t rowbase = (size_t)b * S; const int q0 = qb * 128, qw = q0 + 16 * w;
#define tqc (qw + cq)
#define myrow (rowbase + (size_t)tqc)
  const float c = 0.125f * LOG2E;
  LAS float* impw = (LAS float*)(lds + NSA_BUF + w * NSA_IMP);
  int tq[4];
#pragma unroll
  for (int j = 0; j < 4; ++j) tq[j] = tqc;
  for (int i = lane; i < 16 * 132; i += 64) impw[i] = 0.f;
#ifndef NSA_NO_A
  {
    bf16x8 qf[4][2]; f32x4 o[4][4]; float m[4], l[4];
#pragma unroll
    for (int j = 0; j < 4; ++j) { m[j] = -INFINITY; l[j] = 0.f;
#pragma unroll
      for (int kk = 0; kk < 2; ++kk) qf[j][kk] = *(const bf16x8*)(X.PROJ() + myrow * NPROJ + C_BQ + 64 * (4 * g + j) + 32 * kk + 8 * lg);
#pragma unroll
      for (int dt = 0; dt < 4; ++dt) o[j][dt] = (f32x4){0.f, 0.f, 0.f, 0.f}; }
    SrcCmp src{X.KCMP() + (size_t)(b * 2 + g) * 512 * 64, X.VCMP() + (size_t)(b * 2 + g) * 512 * 64};
    const int ncb = 8 * qb + 7, nch = (ncb + 63) >> 6;
    attn_block_loop<4, 64, 64, MODE_CMP, 1, SrcCmp>(lds, src, o, m, l, qf, tq, 0, nch, 0, qw, qw + 15, c, 0);
    float mc[4], inv[4];
#pragma unroll
    for (int j = 0; j < 4; ++j) { const float lt = lsum4(l[j]); inv[j] = lt > 0.f ? 1.0f / lt : 0.f; mc[j] = ((m[j] == -INFINITY) ? 0.f : m[j]) * c;
      const float g0 = sigmoidf_(bf2f(X.PROJ()[myrow * NPROJ + C_BG + 3 * (4 * g + j) + 0])); const float sc = inv[j] * g0;
#pragma unroll
      for (int dt = 0; dt < 4; ++dt) store4(OB + myrow * 512 + 64 * (4 * g + j) + 16 * dt + 4 * lg, o[j][dt], sc); }
    {
      constexpr int KB = 64 * 144, BUF = KB + 64 * 160;
      float carry = 0.f;
      u32x4 kreg;
      { const int row = tid >> 3, ch = tid & 7; kreg = *(const u32x4*)src.kaddr(row, ch); }
      for (int kc = 0; kc < nch; ++kc) {
        LAS unsigned char* buf = lds + (kc & 1) * BUF;
        { const int row = tid >> 3, ch = tid & 7; *(LAS u32x4*)(buf + row * 144 + ch * 16) = kreg; if (kc + 1 < nch) kreg = *(const u32x4*)src.kaddr((kc + 1) * 64 + row, ch); }
        LBAR();
        const int lo = 64 * kc, hi = lo + 63;
        const bool rel = 16 * lo + 31 <= qw + 15, full = 16 * hi + 31 <= qw;
        if (rel) { if (full) cmp_imp_chunk<false>(qf, buf, lo, tqc, mc, inv, c, carry, impw + cq * 132, lane);
                   else cmp_imp_chunk<true>(qf, buf, lo, tqc, mc, inv, c, carry, impw + cq * 132, lane); }
      }
      LBAR();
    }
  }
#endif
#ifndef NSA_NO_C
  {
    for (int idx = lane; idx < 16 * 128; idx += 64) { const int q = idx >> 7, j = idx & 127; const int t = qw + q, cur = t >> 6;
      const float v = impw[q * 132 + j]; const bool forced = (j == 0) || (j == cur) || (j == cur - 1);
      impw[q * 132 + j] = (j > cur) ? -INFINITY : v + (forced ? 1e4f : 0.f); }
    LWAIT();
    for (int idx = lane; idx < 16 * 128; idx += 64) { const int qq = idx >> 7, j = idx & 127; const unsigned u = __float_as_uint(impw[qq * 132 + j]);
      const unsigned ok = (u & 0x80000000u) ? ~u : (u | 0x80000000u); ((LAS unsigned*)impw)[qq * 132 + j] = (ok & ~127u) | (unsigned)(127 - j); }
    LWAIT();
    const int q = lane >> 2, part = lane & 3;
    unsigned sj[32];
    LAS const unsigned* keyw = (LAS const unsigned*)impw;
#pragma unroll
    for (int jj = 0; jj < 32; ++jj) sj[jj] = keyw[q * 132 + 32 * part + jj];
    unsigned thr = 0u;
#pragma unroll 1
    for (int bit = 31; bit >= 0; --bit) {
      const unsigned cand = thr | (1u << bit); int cn = 0;
#pragma unroll
      for (int jj = 0; jj < 32; ++jj) cn += (sj[jj] >= cand) ? 1 : 0;
      cn += __shfl_xor(cn, 1); cn += __shfl_xor(cn, 2);
      thr = (cn >= 16) ? cand : thr;
    }
    int mine = 0;
#pragma unroll
    for (int jj = 0; jj < 32; ++jj) mine += (sj[jj] >= thr) ? 1 : 0;
    const int c0 = __shfl(mine, (lane & ~3) + 0), c1 = __shfl(mine, (lane & ~3) + 1), c2 = __shfl(mine, (lane & ~3) + 2);
    int slot = (part > 0 ? c0 : 0) + (part > 1 ? c1 : 0) + (part > 2 ? c2 : 0);
    unsigned char* sell = X.SELL() + ((rowbase + qw + q) * 2 + g) * 16;
#pragma unroll
    for (int jj = 0; jj < 32; ++jj) if (sj[jj] >= thr) { sell[slot] = (unsigned char)((32 * part + jj) | (((sj[jj] & ~127u) == 0x007FFF80u) ? 128 : 0)); ++slot; }
    LWAIT();
  }
#endif
#ifndef NSA_NO_E

  {
    bf16x8 qf[4][2]; f32x4 o[4][4]; float m[4], l[4];
#pragma unroll
    for (int j = 0; j < 4; ++j) { m[j] = -INFINITY; l[j] = 0.f;
#pragma unroll
      for (int kk = 0; kk < 2; ++kk) qf[j][kk] = *(const bf16x8*)(X.QROT() + myrow * 512 + 64 * (4 * g + j) + 32 * kk + 8 * lg);
#pragma unroll
      for (int dt = 0; dt < 4; ++dt) o[j][dt] = (f32x4){0.f, 0.f, 0.f, 0.f}; }
    const int kbase = q0 - 512;
    SrcProj src{X.PROJ(), rowbase + kbase, C_BKW + 64 * g, C_BVW + 64 * g};
    const int kc0 = kbase < 0 ? (-kbase) >> 6 : 0;
    attn_block_loop<4, 64, 64, MODE_WINDOW, 1, SrcProj>(lds, src, o, m, l, qf, tq, kc0, 10, kbase, qw, qw + 15, c, 512);
#pragma unroll
    for (int j = 0; j < 4; ++j) { const float lt = lsum4(l[j]); const float inv = lt > 0.f ? 1.0f / lt : 0.f;
      const float g2 = sigmoidf_(bf2f(X.PROJ()[myrow * NPROJ + C_BG + 3 * (4 * g + j) + 2])); const float sc = inv * g2;
#pragma unroll
      for (int dt = 0; dt < 4; ++dt) store4(X.OW() + myrow * 512 + 64 * (4 * g + j) + 16 * dt + 4 * lg, o[j][dt], sc); }
  }
#endif
  LBAR();
}
#undef cq
#undef lg
#undef tqc
#undef myrow

struct SelFrag { u32x4 kf[4]; u32x4 vf[4]; };
__device__ __forceinline__ void sel_load(SelFrag& F, const bf16_t* kst, const bf16_t* vst, int blk, int cq, int lg) {
  const unsigned char* kp = (const unsigned char*)kst + (size_t)blk * 4096 + (cq * 4 + lg) * 16;
  const unsigned char* vp = (const unsigned char*)vst + (size_t)blk * 4096 + (cq * 4 + lg) * 16;
#pragma unroll
  for (int t4 = 0; t4 < 4; ++t4) F.kf[t4] = *(const u32x4*)(kp + t4 * 1024);
#pragma unroll
  for (int dt = 0; dt < 4; ++dt) F.vf[dt] = *(const u32x4*)(vp + dt * 1024);
}
__device__ __forceinline__ void sel_compute(const SelFrag& F, const long (&qs)[2], f32x4 (&os)[4], float& m, float& l, int blk, int cur, int t, int lg, float c) {
  f32x4 s[4];
#pragma unroll
  for (int t4 = 0; t4 < 4; ++t4) { s[t4] = mfma16_fp8(as_long(F.kf[t4].x, F.kf[t4].y), qs[0], (f32x4){0.f, 0.f, 0.f, 0.f}); s[t4] = mfma16_fp8(as_long(F.kf[t4].z, F.kf[t4].w), qs[1], s[t4]); }
  float mx = -INFINITY;
#pragma unroll
  for (int t4 = 0; t4 < 4; ++t4)
#pragma unroll
    for (int i = 0; i < 4; ++i) { if (blk == cur) { const int key = 64 * blk + 16 * t4 + 4 * lg + i; if (key > t) s[t4][i] = -INFINITY; } mx = fmaxf(mx, s[t4][i]); }
  mx = max_x16_x32(mx);
  if (__any(mx > m + 8.0f / c)) {
    const float mnew = fmaxf(m, mx), ms2 = (mnew == -INFINITY) ? 0.f : mnew, alpha = ex2((m - ms2) * c);
    m = mnew; l *= alpha;
#pragma unroll
    for (int dt = 0; dt < 4; ++dt) os[dt] *= alpha;
  }
  const float mcc = ((m == -INFINITY) ? 0.f : m) * c;
  float p[4][4], ps = 0.f;
#pragma unroll
  for (int t4 = 0; t4 < 4; ++t4)
#pragma unroll
    for (int i = 0; i < 4; ++i) { p[t4][i] = ex2(s[t4][i] * c - mcc); ps += p[t4][i]; }
  l += ps;
  const u32x2 pa = pack8_fp8(p[0], p[1]), pb = pack8_fp8(p[2], p[3]);
  const long pf0 = as_long(pa.x, pa.y), pf1 = as_long(pb.x, pb.y);
#pragma unroll
  for (int dt = 0; dt < 4; ++dt) { os[dt] = mfma16_fp8(as_long(F.vf[dt].x, F.vf[dt].y), pf0, os[dt]); os[dt] = mfma16_fp8(as_long(F.vf[dt].z, F.vf[dt].w), pf1, os[dt]); }
}
__device__ __forceinline__ int sel_slot(const u32x4& sl, int slot) {
  const unsigned wsel = slot < 4 ? sl.x : slot < 8 ? sl.y : slot < 12 ? sl.z : sl.w;
  return __builtin_amdgcn_readfirstlane((int)((wsel >> (8 * (slot & 3))) & 127u));
}
__device__ __forceinline__ void nsa_sel_phase(const Ctx& X, bf16_t* OBp) {
  const int tid = otid(), lane = tid & 63, cq = lane & 15, lg = lane >> 4, hcol = lane & 3;
  const int w = __builtin_amdgcn_readfirstlane(tid >> 6);
  const float c = 0.125f * LOG2E;
  const bool xmap = (X.G % 8) == 0;
  const int npw = xmap ? (X.G / 8) * 8 : X.G * 8;
  const int wi = xmap ? (X.blk / 8) * 8 + w : X.blk * 8 + w;
  const int ntask = xmap ? S : T * 2;
#define SEL_DECODE(kk_, b_, g_, t_) do { if (xmap) { const int pr = X.blk & 7; b_ = pr >> 1; g_ = pr & 1; t_ = (kk_); } else { const int rowi = (kk_) >> 1; g_ = (kk_) & 1; b_ = rowi >> 13; t_ = rowi & 8191; } } while (0)
  int k = wi;
  if (k >= ntask) return;
  SelFrag FA, FB;
  u32x4 sl, sln;
  { int b, g, t; SEL_DECODE(k, b, g, t); sl = *(const u32x4*)(X.SELL() + (((size_t)b * S + t) * 2 + g) * 16); sln = sl;
    sel_load(FA, (const bf16_t*)((const unsigned char*)X.KST() + (size_t)(b * 2 + g) * 128 * 4096), (const bf16_t*)((const unsigned char*)X.VST() + (size_t)(b * 2 + g) * 128 * 4096), sel_slot(sl, 0), cq, lg); }
  for (; k < ntask; k += npw) {
    int b, g, t; SEL_DECODE(k, b, g, t);
    const int cur = t >> 6; const int nv = cur + 1 < 16 ? cur + 1 : 16;
    const size_t rowbase = (size_t)b * S, row = rowbase + t;
    const bf16_t* projk = (const bf16_t*)((const unsigned char*)X.KST() + (size_t)(b * 2 + g) * 128 * 4096);
    const bf16_t* vst = (const bf16_t*)((const unsigned char*)X.VST() + (size_t)(b * 2 + g) * 128 * 4096);
    const int kn = k + npw; int bn = b, gn = g, tn = t;
    if (kn < ntask) { SEL_DECODE(kn, bn, gn, tn); sln = *(const u32x4*)(X.SELL() + (((size_t)bn * S + tn) * 2 + gn) * 16); }
    long qs[2];
#pragma unroll
    for (int kk = 0; kk < 2; ++kk) { const u32x4 qw4 = *(const u32x4*)(X.QROT() + row * 512 + 64 * (4 * g + hcol) + 32 * kk + 8 * lg);
      const float a4[4] = {bflo(qw4.x), bfhi(qw4.x), bflo(qw4.y), bfhi(qw4.y)}, b4[4] = {bflo(qw4.z), bfhi(qw4.z), bflo(qw4.w), bfhi(qw4.w)};
      const u32x2 q8 = pack8_fp8(a4, b4); qs[kk] = as_long(q8.x, q8.y); }
    float m = -INFINITY, l = 0.f; f32x4 os[4];
#pragma unroll
    for (int dt = 0; dt < 4; ++dt) os[dt] = (f32x4){0.f, 0.f, 0.f, 0.f};
    int blkA = sel_slot(sl, 0), blkB = 0;
    for (int sidx = 0; sidx < nv; sidx += 2) {
      const bool hasB = sidx + 1 < nv;
      if (hasB) { blkB = sel_slot(sl, sidx + 1); sel_load(FB, projk, vst, blkB, cq, lg); }
      sel_compute(FA, qs, os, m, l, blkA, cur, t, lg, c);
      if (hasB) {
        if (sidx + 2 < nv) { blkA = sel_slot(sl, sidx + 2); sel_load(FA, projk, vst, blkA, cq, lg); }
        sel_compute(FB, qs, os, m, l, blkB, cur, t, lg, c);
      }
    }
    if (kn < ntask) sel_load(FA, (const bf16_t*)((const unsigned char*)X.KST() + (size_t)(bn * 2 + gn) * 128 * 4096), (const bf16_t*)((const unsigned char*)X.VST() + (size_t)(bn * 2 + gn) * 128 * 4096), sel_slot(sln, 0), cq, lg);
    const float lt = lsum4(l); const float inv = lt > 0.f ? 1.0f / lt : 0.f;
    const float g1 = sigmoidf_(bf2f(X.PROJ()[row * NPROJ + C_BG + 3 * (4 * g + hcol) + 1]));
    if (cq < 4) {
      const float sc = inv * g1;
#pragma unroll
      for (int dt = 0; dt < 4; ++dt) { const size_t off = row * 512 + 64 * (4 * g + cq) + 16 * dt + 4 * lg;
        const u32x2 a = *(const u32x2*)(OBp + off), w2 = *(const u32x2*)(X.OW() + off);
        f32x4 v = os[dt] * sc; v[0] += bflo(a.x) + bflo(w2.x); v[1] += bfhi(a.x) + bfhi(w2.x); v[2] += bflo(a.y) + bflo(w2.y); v[3] += bfhi(a.y) + bfhi(w2.y);
        store4(OBp + off, v, 1.0f); }
    }
    sl = sln;
  }
#undef SEL_DECODE
}

__device__ __forceinline__ void nsa_compress_task(LAS unsigned char* lds, const Ctx& X, const float* pe_k, const float* pe_v, int task) {
  const int tid = otid(), lane = tid & 63, w = __builtin_amdgcn_readfirstlane(tid >> 6), r = lane & 15, lg = lane >> 4;
  const int kind = task >> 8, rem = task & 255, b = rem >> 6, g = (rem >> 5) & 1, c0 = (rem & 31) * 16;
  const float* pe = kind ? pe_v : pe_k; const bf16_t* w1 = X.W() + (kind ? W_V1 : W_K1); const bf16_t* w2 = X.W() + (kind ? W_V2 : W_K2);
  const int col = (kind ? C_BVC : C_BKC) + 64 * g;
  LAS float* red = (LAS float*)lds;
  LAS bf16_t* h1 = (LAS bf16_t*)(lds + 8 * 16 * 64 * 4);
  f32x4 acc[4];
#pragma unroll
  for (int nt = 0; nt < 4; ++nt) acc[nt] = (f32x4){0.f, 0.f, 0.f, 0.f};
  const int cmy = c0 + r;
#pragma unroll 2
  for (int k8 = 0; k8 < 8; ++k8) { const int kk = 8 * w + k8; const int lt = kk >> 1, d = (kk & 1) * 32 + 8 * lg;
    int tok = 16 * cmy + lt; tok = tok > S - 1 ? S - 1 : tok;
    const u32x4 kv = *(const u32x4*)(X.PROJ() + ((size_t)b * S + tok) * NPROJ + col + d);
    const f32x4 pa = *(const f32x4*)(pe + lt * 64 + d), pb = *(const f32x4*)(pe + lt * 64 + d + 4);
    u32x4 aw; aw.x = cvt_pk_bf16(bflo(kv.x) + pa[0], bfhi(kv.x) + pa[1]); aw.y = cvt_pk_bf16(bflo(kv.y) + pa[2], bfhi(kv.y) + pa[3]);
    aw.z = cvt_pk_bf16(bflo(kv.z) + pb[0], bfhi(kv.z) + pb[1]); aw.w = cvt_pk_bf16(bflo(kv.w) + pb[2], bfhi(kv.w) + pb[3]);
    const bf16x8 af = __builtin_bit_cast(bf16x8, aw);
#pragma unroll
    for (int nt = 0; nt < 4; ++nt) { const bf16x8 bfr = *(const bf16x8*)(w1 + (size_t)(16 * nt + r) * 2048 + 32 * kk + 8 * lg); acc[nt] = mfma16(af, bfr, acc[nt]); }
  }
#pragma unroll
  for (int nt = 0; nt < 4; ++nt)
#pragma unroll
    for (int i = 0; i < 4; ++i) red[(w * 16 + 4 * lg + i) * 64 + 16 * nt + r] = acc[nt][i];
  LBAR();
  for (int e = tid; e < 1024; e += 512) { float sacc = 0.f;
#pragma unroll
    for (int ww = 0; ww < 8; ++ww) sacc += red[ww * 1024 + e];
    const float hval = sacc * sigmoidf_(sacc); h1[(e >> 6) * 72 + (e & 63)] = (bf16_t)(cvt_pk_bf16(hval, 0.f) & 0xffffu); }
  LBAR();
  if (w == 0) {
    f32x4 o2[4];
#pragma unroll
    for (int nt = 0; nt < 4; ++nt) o2[nt] = (f32x4){0.f, 0.f, 0.f, 0.f};
#pragma unroll
    for (int kk = 0; kk < 2; ++kk) { const bf16x8 af = *(LAS const bf16x8*)(h1 + r * 72 + 32 * kk + 8 * lg);
#pragma unroll
      for (int nt = 0; nt < 4; ++nt) { const bf16x8 bfr = *(const bf16x8*)(w2 + (16 * nt + r) * 64 + 32 * kk + 8 * lg); o2[nt] = mfma16(af, bfr, o2[nt]); } }
    bf16_t* dst = (kind ? X.VCMP() : X.KCMP()) + ((size_t)(b * 2 + g) * 512 + c0) * 64;
#pragma unroll
    for (int nt = 0; nt < 4; ++nt)
#pragma unroll
      for (int i = 0; i < 4; ++i) dst[(4 * lg + i) * 64 + 16 * nt + r] = (bf16_t)(cvt_pk_bf16(o2[nt][i], 0.f) & 0xffffu);
  }
  LBAR();
}

__device__ __forceinline__ void rms_row_bf16(const float* xrow, const float* gain, bf16_t* orow, int lane) {
  const f32x4* xr = (const f32x4*)xrow + lane; const f32x4* gr = (const f32x4*)gain + lane;
  f32x4 v[4]; float s = 0.f;
#pragma unroll
  for (int j = 0; j < 4; ++j) { v[j] = xr[64 * j]; s += (v[j].x * v[j].x + v[j].y * v[j].y) + (v[j].z * v[j].z + v[j].w * v[j].w); }
  const float rstd = 1.0f / sqrtf(wave_sum(s) * (1.f / 1024.f) + NORM_EPS);
  u32x2* o8 = (u32x2*)orow + lane;
#pragma unroll
  for (int j = 0; j < 4; ++j) { const f32x4 gg = gr[64 * j]; u32x2 wv; wv.x = cvt_pk_bf16(v[j].x * rstd * gg.x, v[j].y * rstd * gg.y); wv.y = cvt_pk_bf16(v[j].z * rstd * gg.z, v[j].w * rstd * gg.w); o8[64 * j] = wv; }
}
__device__ __forceinline__ void rms_phase(const Ctx& X, const float* src, const float* gain, bf16_t* dst, int rows) {
  const int tid_ = otid(); const int lane = tid_ & 63, gw = X.blk * 8 + (tid_ >> 6), NGW = X.G * 8;
  for (int mrow = gw; mrow < rows; mrow += NGW) rms_row_bf16(src + (size_t)mrow * 1024, gain, dst + (size_t)mrow * 1024, lane);
}
__device__ __forceinline__ void xb_prepass(const Ctx& X, const float* src) {
  const int tid_ = otid(); const int lane = tid_ & 63, gw = X.blk * 8 + (tid_ >> 6), NGW = X.G * 8;
  for (int mrow = gw; mrow < T; mrow += NGW) {
    const f32x4* xr = (const f32x4*)(src + (size_t)mrow * 1024) + lane; u32x2* o8 = (u32x2*)(X.H() + (size_t)mrow * 1024) + lane; float sacc = 0.f;
#pragma unroll
    for (int j = 0; j < 4; ++j) { const f32x4 v = xr[64 * j]; sacc += (v.x * v.x + v.y * v.y) + (v.z * v.z + v.w * v.w); u32x2 wv; wv.x = cvt_pk_bf16(v.x, v.y); wv.y = cvt_pk_bf16(v.z, v.w); o8[64 * j] = wv; }
    sacc = wave_sum(sacc);
    if (lane == 0) *(f32x4*)(X.RSS() + (size_t)mrow * 4) = (f32x4){sacc, 0.f, 0.f, 0.f};
  }
}
__device__ __forceinline__ void final_norm_phase(const Ctx& X, const float* gain) {
  const int tid_ = otid(); const int lane = tid_ & 63, gw = X.blk * 8 + (tid_ >> 6), NGW = X.G * 8;
  for (int mrow = gw; mrow < T; mrow += NGW) {
    f32x4* xr = (f32x4*)(X.out + (size_t)mrow * 1024) + lane; const f32x4* gr = (const f32x4*)gain + lane;
    f32x4 v[4]; float s = 0.f;
#pragma unroll
    for (int j = 0; j < 4; ++j) { v[j] = xr[64 * j]; s += (v[j].x * v[j].x + v[j].y * v[j].y) + (v[j].z * v[j].z + v[j].w * v[j].w); }
    const float rstd = 1.0f / sqrtf(wave_sum(s) * (1.f / 1024.f) + NORM_EPS);
#pragma unroll
    for (int j = 0; j < 4; ++j) { const f32x4 gg = gr[64 * j]; xr[64 * j] = (f32x4){v[j].x * rstd * gg.x, v[j].y * rstd * gg.y, v[j].z * rstd * gg.z, v[j].w * rstd * gg.w}; }
  }
}
__device__ __forceinline__ void mla_norm_phase(const Ctx& X, const float* qg, const float* kvg) {
  const int tid_ = otid(); const int lane = tid_ & 63, gw = X.blk * 8 + (tid_ >> 6), NGW = X.G * 8;
  for (int mrow = gw; mrow < T; mrow += NGW) {
    bf16_t* pr = X.PROJ() + (size_t)mrow * NPROJ;
    u32x4 a = (u32x4){0, 0, 0, 0}, bq = (u32x4){0, 0, 0, 0};
    if (lane < 48) a = *(const u32x4*)(pr + C_CQA + 8 * lane);
    if (lane < 32) bq = *(const u32x4*)(pr + C_CKV + 8 * lane);
    float fa[8] = {bflo(a.x), bfhi(a.x), bflo(a.y), bfhi(a.y), bflo(a.z), bfhi(a.z), bflo(a.w), bfhi(a.w)};
    float fb[8] = {bflo(bq.x), bfhi(bq.x), bflo(bq.y), bfhi(bq.y), bflo(bq.z), bfhi(bq.z), bflo(bq.w), bfhi(bq.w)};
    float sa = 0.f, sb = 0.f;
#pragma unroll
    for (int e = 0; e < 8; ++e) { sa += fa[e] * fa[e]; sb += fb[e] * fb[e]; }
    const float ra = 1.0f / sqrtf(wave_sum(sa) * (1.f / 384.f) + NORM_EPS), rb = 1.0f / sqrtf(wave_sum(sb) * (1.f / 256.f) + NORM_EPS);
    if (lane < 48) { const f32x4 g0 = *(const f32x4*)(qg + 8 * lane), g1 = *(const f32x4*)(qg + 8 * lane + 4); u32x4 wv;
      wv.x = cvt_pk_bf16(fa[0] * ra * g0[0], fa[1] * ra * g0[1]); wv.y = cvt_pk_bf16(fa[2] * ra * g0[2], fa[3] * ra * g0[3]);
      wv.z = cvt_pk_bf16(fa[4] * ra * g1[0], fa[5] * ra * g1[1]); wv.w = cvt_pk_bf16(fa[6] * ra * g1[2], fa[7] * ra * g1[3]); *(u32x4*)(pr + C_CQA + 8 * lane) = wv; }
    if (lane < 32) { const f32x4 g0 = *(const f32x4*)(kvg + 8 * lane), g1 = *(const f32x4*)(kvg + 8 * lane + 4); u32x4 wv;
      wv.x = cvt_pk_bf16(fb[0] * rb * g0[0], fb[1] * rb * g0[1]); wv.y = cvt_pk_bf16(fb[2] * rb * g0[2], fb[3] * rb * g0[3]);
      wv.z = cvt_pk_bf16(fb[4] * rb * g1[0], fb[5] * rb * g1[1]); wv.w = cvt_pk_bf16(fb[6] * rb * g1[2], fb[7] * rb * g1[3]); *(u32x4*)(pr + C_CKV + 8 * lane) = wv; }
  }
}

__device__ __forceinline__ void sincos_precise(float a, float& cs, float& sn) {
  const double x = (double)a; const double k = rint(x * 0.63661977236758134308);
  double rr = fma(-k, 1.57079632679489655800e+00, x); rr = fma(-k, 6.12323399573676603587e-17, rr);
  const double r2 = rr * rr;
  double sp = -1.0 / 1307674368000.0; sp = sp * r2 + 1.0 / 6227020800.0; sp = sp * r2 - 1.0 / 39916800.0; sp = sp * r2 + 1.0 / 362880.0; sp = sp * r2 - 1.0 / 5040.0; sp = sp * r2 + 1.0 / 120.0; sp = sp * r2 - 1.0 / 6.0; sp = sp * r2 + 1.0;
  const double sv = sp * rr;
  double cp = 1.0 / 87178291200.0; cp = cp * r2 - 1.0 / 479001600.0; cp = cp * r2 + 1.0 / 3628800.0; cp = cp * r2 - 1.0 / 40320.0; cp = cp * r2 + 1.0 / 720.0; cp = cp * r2 - 1.0 / 24.0; cp = cp * r2 + 0.5; const double cv = 1.0 - cp * r2;
  const int q = ((int)(long long)k) & 3;
  const double c2 = (q == 0) ? cv : (q == 1) ? -sv : (q == 2) ? -cv : sv;
  const double s2 = (q == 0) ? sv : (q == 1) ? cv : (q == 2) ? -sv : -cv;
  cs = (float)c2; sn = (float)s2;
}
__device__ __forceinline__ void tables_phase(const Ctx& X, const Params& P) {
  const int* pos = (const int*)X.in[2];
  const int gt = X.blk * 512 + otid(), NG = X.G * 512;
  for (int idx = gt; idx < T * 48; idx += NG) {
    const int row = idx / 48, i = idx % 48; const float pf = (float)pos[row];
    float cs, sn;
    if (i < 32) { sincos_precise(pf * P.invf64[i], cs, sn); X.CS64()[(size_t)row * 32 + i] = (f32x2){cs, sn}; }
    else { sincos_precise(pf * P.invf32[i - 32], cs, sn); X.CS32()[(size_t)row * 16 + (i - 32)] = (f32x2){cs, sn}; }
  }
}

enum { CM_ID = 0, CM_INPROJ = 1, CM_QB = 2, CM_GU = 3, CM_IL64 = 4 };
__device__ __forceinline__ int colmap(int kind, int n, int off) {
  if (kind == CM_ID) return off + n;
  if (kind == CM_INPROJ) {
    if (n < 2048) { const int sg = n >> 7; const bool il = (sg <= 4) || (sg >= 6 && sg <= 9) || sg == 12 || sg == 14;
      if (!il) return n; const int hb = n & ~63, o = n & 63; return hb + (o >> 1) + 32 * (o & 1); }
    if (n < 2432) return 2072 + (n - 2048);
    if (n < 2688) return 2456 + (n - 2432);
    if (n < 2720) { const int o = n - 2688; return 2712 + (o >> 1) + 16 * (o & 1); }
    if (n < 2744) return 2048 + (n - 2720);
    return -1;
  }
  if (kind == CM_QB) { const int h = n / 96, o = n % 96; if (o < 64) return n; const int oo = o - 64; return 96 * h + 64 + (oo >> 1) + 16 * (oo & 1); }
  if (kind == CM_GU) { const int j = n >> 3, e = n & 7; return e < 4 ? 4 * j + e : DFF + 4 * j + (e - 4); }
    { const int o = n & 63; return (n & ~63) + (o >> 1) + 32 * (o & 1); }
}
struct WDesc { const float* src; int K, pitch, N, kind, off; size_t dst; };
__device__ __forceinline__ void wconv_tile(LAS float* tl, const WDesc& d, bf16_t* Wb, int tile, const float* gain) {
  const int tid = otid(); const int nb = d.N >> 6; const int kb = tile / nb, nbi = tile % nb; const int k0 = kb * 64, n0 = nbi * 64;
  { const int nn = tid & 63; const int sc = colmap(d.kind, n0 + nn, d.off);
#pragma unroll
    for (int rr = 0; rr < 8; ++rr) { const int kk = (tid >> 6) + 8 * rr; tl[kk * 65 + nn] = sc >= 0 ? d.src[(size_t)(k0 + kk) * d.pitch + sc] * (gain ? gain[k0 + kk] : 1.0f) : 0.f; } }
  LBAR();
  { const int kp = tid & 31;
#pragma unroll
    for (int rr = 0; rr < 4; ++rr) { const int nn = (tid >> 5) + 16 * rr; const unsigned wv = cvt_pk_bf16(tl[(2 * kp) * 65 + nn], tl[(2 * kp + 1) * 65 + nn]);
      *(unsigned*)(Wb + d.dst + (size_t)(n0 + nn) * d.K + k0 + 2 * kp) = wv; } }
  LBAR();
}
__device__ __forceinline__ WDesc wdesc(const float* const* in, size_t L, int i) {
  switch (i) {
    case 0: return WDesc{in[4] + L * 1024 * DIN, 1024, DIN, NPROJ, CM_INPROJ, 0, W_IN};
    case 1: return WDesc{in[4] + L * 1024 * DIN, 1024, DIN, NGATE, CM_ID, 2744, W_G};
    case 2: return WDesc{in[13] + L * 384 * 768, 384, 768, 768, CM_QB, 0, W_QB};
    case 3: return WDesc{in[15] + L * 256 * 1024, 256, 1024, 1024, CM_ID, 0, W_KVB};
    case 4: return WDesc{in[16] + L * 512 * 1024, 512, 1024, 1024, CM_ID, 0, W_BR};
    case 5: return WDesc{in[17] + L * 512 * 1024, 512, 1024, 1024, CM_ID, 0, W_BR + 1024 * 512};
    case 6: return WDesc{in[18] + L * 512 * 1024, 512, 1024, 1024, CM_ID, 0, W_BR + 2 * 1024 * 512};
    case 7: return WDesc{in[19] + L * 1024 * 1024, 1024, 1024, 1024, CM_ID, 0, W_OUT};
    case 8: return WDesc{in[22] + L * 1024 * 512, 1024, 512, 512, CM_ID, 0, W_XQ};
    case 9: return WDesc{in[23] + L * 1024 * 1024, 1024, 1024, 1024, CM_ID, 0, W_XKV};
    case 10: return WDesc{in[24] + L * 512 * 1024, 512, 1024, 1024, CM_ID, 0, W_XO};
    case 11: return WDesc{in[26] + L * 1024 * NGU, 1024, NGU, NGU, CM_GU, 0, W_GU};
    case 12: return WDesc{in[27] + L * DFF * 1024, DFF, 1024, 1024, CM_ID, 0, W_DOWN};
    case 13: return WDesc{in[8] + L * 2048 * 64, 2048, 64, 64, CM_ID, 0, W_K1};
    case 14: return WDesc{in[10] + L * 2048 * 64, 2048, 64, 64, CM_ID, 0, W_V1};
    case 15: return WDesc{in[9] + L * 64 * 64, 64, 64, 64, CM_IL64, 0, W_K2};
    default: return WDesc{in[11] + L * 64 * 64, 64, 64, 64, CM_ID, 0, W_V2};
  }
}
__device__ __forceinline__ int wtiles(int i) {
  constexpr int tl[17] = {16 * 44, 16 * 48, 6 * 12, 4 * 16, 8 * 16, 8 * 16, 8 * 16, 16 * 16, 16 * 8, 16 * 16, 8 * 16, 16 * 88, 44 * 16, 32, 32, 1, 1};
  int r = 0;
#pragma unroll
  for (int k = 0; k < 17; ++k) r = (i == k) ? tl[k] : r;
  return r;
}
__device__ __forceinline__ void wconv_phase(LAS unsigned char* lds, const Ctx& X, int layer) {
  constexpr int TOTAL = 16 * 44 + 16 * 48 + 6 * 12 + 4 * 16 + 3 * 8 * 16 + 16 * 16 + 16 * 8 + 16 * 16 + 8 * 16 + 16 * 88 + 44 * 16 + 32 + 32 + 1 + 1;
  for (int t = X.blk; t < TOTAL; t += X.G) {
    int rem = t, mi = 0;
#pragma unroll 1
    for (; mi < 16; ++mi) { const int n = wtiles(mi); if (rem < n) break; rem -= n; }
    const WDesc d = wdesc(X.in, (size_t)layer, mi);
    const int gi = (mi <= 1) ? 3 : (mi == 8) ? 20 : (mi == 11) ? 25 : -1;
    const float* gain = gi >= 0 ? X.in[gi] + (size_t)layer * 1024 : nullptr;
    wconv_tile((LAS float*)lds, d, X.W(), rem, gain);
  }
}

#define RLX_AGENT __ATOMIC_RELAXED, __HIP_MEMORY_SCOPE_AGENT
#define XB_TMO      128
#define XB_XCNT(j)  (256  + 64 * (j))
#define XB_XSUB(j)  (1280 + 64 * (j))
#define XB_XGEN(j)  (2304 + 64 * (j))
#define XB_TOP      3328
#define XB_TOPGEN   3392
#define XCD_BAR_WORDS 3456
#define XB_SPIN_CAP (1u << 18)

__device__ __forceinline__ unsigned xb_ld(unsigned* p)              { return __hip_atomic_load(p, __ATOMIC_RELAXED, __HIP_MEMORY_SCOPE_AGENT); }
__device__ __forceinline__ unsigned xb_add(unsigned* p, unsigned v) { return __hip_atomic_fetch_add(p, v, __ATOMIC_RELAXED, __HIP_MEMORY_SCOPE_AGENT); }
__device__ __forceinline__ unsigned xb_xcc_id() { return (unsigned)__builtin_amdgcn_s_getreg((3 << 11) | 20) & 0xFu; }
#define XB_SPIN(cond, bar) do { unsigned _sp = 0; while (cond) { __builtin_amdgcn_s_sleep(1); \
    if ((++_sp & 255u) == 0u) { if (xb_ld(&(bar)[XB_TMO])) break; if (_sp > XB_SPIN_CAP) { atomicAdd(&(bar)[XB_TMO], 1u); break; } } } } while (0)

struct XcdBarrier {
    unsigned* bar; unsigned x;
    volatile LAS unsigned* st;
};

__device__ __forceinline__ XcdBarrier xcd_barrier_post(unsigned* bar, volatile LAS unsigned* st) {
    XcdBarrier b; b.bar = bar; b.x = xb_xcc_id(); b.st = st;
    if (threadIdx.x == 0) (void)xb_add(&bar[XB_XCNT(b.x)], 1u);
    return b;
}
__device__ __forceinline__ void xcd_barrier_complete(unsigned* bar, unsigned x, unsigned& nloc, unsigned& nx) {
    const unsigned G = gridDim.x * gridDim.y * gridDim.z;
    unsigned sum, cnt, mine, sp = 0u;
    for (;;) {
        sum = 0u; cnt = 0u; mine = 0u;
#pragma unroll
        for (unsigned j = 0; j < 16; ++j) { const unsigned c = xb_ld(&bar[XB_XCNT(j)]); sum += c; cnt += (c > 0u) ? 1u : 0u; mine = (j == x) ? c : mine; }
        if (sum == G) break;
        __builtin_amdgcn_s_sleep(1);
        if ((++sp & 255u) == 0u) { if (xb_ld(&bar[XB_TMO])) break; if (sp > XB_SPIN_CAP) { atomicAdd(&bar[XB_TMO], 1u); break; } }
    }
    nloc = mine > 0u ? mine : 1u; nx = cnt > 0u ? cnt : 1u;
}

__device__ __forceinline__ void xcd_barrier(const XcdBarrier& b) {
    asm volatile("s_waitcnt vmcnt(0)" ::: "memory");
    __syncthreads();
    if (threadIdx.x == 0) {
        unsigned* bar = b.bar;
        __builtin_amdgcn_s_waitcnt(0);
        unsigned nloc = b.st[0], nx = b.st[1];
        if (nloc == 0u) { xcd_barrier_complete(bar, b.x, nloc, nx); b.st[0] = nloc; b.st[1] = nx; }
        const unsigned old = xb_add(&bar[XB_XSUB(b.x)], 1u);
        const unsigned gen = old / nloc;
        if (old + 1u == (gen + 1u) * nloc) {
            __builtin_amdgcn_fence(__ATOMIC_RELEASE, "agent");
            asm volatile("s_waitcnt vmcnt(0)" ::: "memory");
            const unsigned og = xb_add(&bar[XB_TOP], 1u);
            const unsigned tg = og / nx;
            if (og + 1u == (tg + 1u) * nx) xb_add(&bar[XB_TOPGEN], 1u);
            else XB_SPIN(xb_ld(&bar[XB_TOPGEN]) == tg, bar);
            __builtin_amdgcn_fence(__ATOMIC_ACQUIRE, "agent");
            xb_add(&bar[XB_XGEN(b.x)], 1u);
            asm volatile("s_waitcnt vmcnt(0)" ::: "memory");
        } else {
            XB_SPIN(xb_ld(&bar[XB_XGEN(b.x)]) == gen, bar);
            __builtin_amdgcn_fence(__ATOMIC_ACQUIRE, "agent");
            asm volatile("s_waitcnt vmcnt(0)" ::: "memory");
        }
    }
    __syncthreads();
}


__global__ void __launch_bounds__(512, 2) mega(Params P) {
  extern __shared__ __attribute__((aligned(16))) unsigned char lds_raw[];
  LAS unsigned char* lds = (LAS unsigned char*)lds_raw;
  cg::grid_group grid = cg::this_grid();
  if (threadIdx.x < 16) ((LAS unsigned*)(lds + (LDS_BYTES - 64)))[threadIdx.x] = 0u;
  __syncthreads();
  (void)xcd_barrier_post((unsigned*)(P.ws + WS_BAR), (volatile LAS unsigned*)(lds + (LDS_BYTES - 64)));
#define FRESH() Ctx X; { size_t z_ = 0; asm volatile("" : "+s"(z_)); X.ws = P.ws + z_; X.out = (float*)((unsigned char*)P.out + z_); X.in = P.in; X.G = gridDim.x; X.blk = blockIdx.x; }
#define GSYNC() do { XcdBarrier b_; unsigned zo_ = 0; asm volatile("" : "+s"(zo_)); b_.bar = (unsigned*)(P.ws + WS_BAR) + zo_;     b_.x = xb_xcc_id(); b_.st = (volatile LAS unsigned*)(lds + (LDS_BYTES - 64)); xcd_barrier(b_); } while (0)
#define OB (X.OA() + (size_t)T * 512)
#define GATES X.PROJ()
#define MERGED X.H()
#define XQ X.PROJ()
#define OX (X.PROJ() + (size_t)T * 512)
#define FFH X.PROJ()
#define PIN(k) P.in[oidx(k)]

#ifndef SKIP_TABLES
  { FRESH(); tables_phase(X, P); }
#endif
  if (P.pad0 != 0) grid.sync();
#pragma unroll 1
  for (int layer = 0; layer < DEPTH; ++layer) {
    const size_t L = (size_t)layer;
#define xin ((layer == 0) ? PIN(0) : (const float*)X.out)
    { FRESH();
#ifndef SKIP_WCONV
    wconv_phase(lds, X, layer);
#endif
#ifndef SKIP_RMS1
    if (layer == 0) xb_prepass(X, PIN(0));
    rms_phase(X, PIN(1), PIN(21) + L * 1024, X.HM(), NB * 256);
#endif
    }
    GSYNC();
    { FRESH();
#ifndef SKIP_INPROJ
    { pg8::Gemm g{X.H(), X.W() + W_IN, T, NPROJ, 1024, 1024, 1024}; pg8::StaticOrder So; So.init(T, NPROJ, X.G, X.blk);
      pg8::EpiInproj E{X.PROJ(), X.QROT(), X.VST(), X.KST(), X.CS64(), X.CS32(), X.RSS()}; pg8::gemm_phase(lds, g, So, E); }
#endif
#ifndef SKIP_MEMKV
    { pg8::Gemm g{X.HM(), X.W() + W_XKV, 1024, 1024, 1024, 1024, 1024}; pg8::StaticOrder So; So.init(1024, 1024, X.G, (X.blk + X.G / 2) % X.G);
      pg8::EpiPlain E{X.MEMKV(), 1024, nullptr}; pg8::gemm_phase(lds, g, So, E); }
#endif
    }
    GSYNC();
    { FRESH();
#ifndef SKIP_P3
    mla_norm_phase(X, PIN(12) + L * 384, PIN(14) + L * 256);
    for (int t = X.blk; t < 512; t += X.G) nsa_compress_task(lds, X, PIN(6) + L * 2048, PIN(7) + L * 2048, t);
#endif
    }
    GSYNC();
    { FRESH();
#ifndef SKIP_MLAQ
    { pg8::Gemm g{X.PROJ() + C_CQA, X.W() + W_QB, T, 768, 384, NPROJ, 384}; pg8::StaticOrder So; So.init(T, 768, X.G, X.blk);
      pg8::EpiMlaQ E{X.QM(), X.CS32()}; pg8::gemm_phase(lds, g, So, E); }
#endif
#ifndef SKIP_KVUP
    { pg8::Gemm g{X.PROJ() + C_CKV, X.W() + W_KVB, T, 1024, 256, NPROJ, 256}; pg8::StaticOrder So; So.init(T, 1024, X.G, X.blk);
      pg8::EpiPlain E{X.KVM(), 1024, nullptr}; pg8::gemm_phase(lds, g, So, E); }
#endif
    }
    GSYNC();
    { FRESH();
#ifndef SKIP_MLA
    if (X.G == 256) { const int vcu = (X.blk % 8) * 32 + X.blk / 8; const int bh = vcu >> 3, s = vcu & 7;
      for (int i = 0; i < 4; ++i) { const int qb = (i == 0) ? s : (i == 1) ? 15 - s : (i == 2) ? 16 + s : 31 - s; mla_unit(lds, X, bh >> 3, bh & 7, qb); } }
    else { for (int u = X.blk; u < 1024; u += X.G) mla_unit(lds, X, (u >> 5) >> 3, (u >> 5) & 7, 31 - (u & 31)); }
#endif
    }
    GSYNC();
    { FRESH();
#ifndef SKIP_SWA
    for (int u = X.blk; u < 512; u += X.G) swa_unit(lds, X, PIN(5) + L * 8, u >> 7, (u >> 6) & 1, u & 63);
#endif
#ifndef SKIP_NSA
    for (int u = X.blk; u < 512; u += X.G) { const int uu = u & 255; const int qb = (u < 256) ? 63 - (uu >> 3) : (uu >> 3), bg = uu & 7; nsa_unit(lds, X, OB, bg >> 1, bg & 1, qb); }
#endif
    }
    GSYNC();
    { FRESH();
#ifndef SKIP_NSA
    nsa_sel_phase(X, OB);
#endif
    }
    GSYNC();
    { FRESH();
#ifndef SKIP_GATES
    { pg8::Gemm g{X.H(), X.W() + W_G, T, NGATE, 1024, 1024, 1024}; pg8::StaticOrder So; So.init(T, NGATE, X.G, X.blk);
      pg8::EpiGates E{GATES, X.RSS()}; pg8::gemm_phase(lds, g, So, E); }
#endif
    }
    GSYNC();
    { FRESH();
#ifndef SKIP_MERGE
    { pg8::Gemm g{X.OA(), X.W() + W_BR, 3 * T, 3 * 1024, 512, 512, 512}; pg8::MergeOrder So{X.G, X.blk};
      pg8::EpiMerge E{GATES, MERGED}; pg8::gemm_phase(lds, g, So, E); }
#endif
    }
    GSYNC();
    { FRESH();
#ifndef SKIP_RESID
    { pg8::Gemm g{MERGED, X.W() + W_OUT, T, 1024, 1024, 1024, 1024}; pg8::StaticOrder So; So.init(T, 1024, X.G, X.blk);
      pg8::EpiResid E{xin, X.out, X.KVM(), X.RSS(), (LAS float*)(lds + 131072)}; pg8::gemm_phase(lds, g, So, E); }
#endif
    }
    GSYNC();
    { FRESH();
#ifndef SKIP_XQ
    { pg8::Gemm g{X.KVM(), X.W() + W_XQ, T, 512, 1024, 1024, 1024}; pg8::StaticOrder So; So.init(T, 512, X.G, X.blk);
      pg8::EpiPlain E{XQ, 512, X.RSS()}; pg8::gemm_phase(lds, g, So, E); }
#endif
    }
    GSYNC();
    { FRESH();
#ifndef SKIP_XATT
    for (int u = X.blk; u < 512; u += X.G) xattn_unit(lds, X, XQ, OX, u >> 7, (u >> 5) & 3, u & 31);
#endif
    }
    GSYNC();
    { FRESH();
#ifndef SKIP_XO
    { pg8::Gemm g{OX, X.W() + W_XO, T, 1024, 512, 512, 512}; pg8::StaticOrder So; So.init(T, 1024, X.G, X.blk);
      pg8::EpiResid E{X.out, X.out, X.H(), X.RSS(), (LAS float*)(lds + 131072)}; pg8::gemm_phase(lds, g, So, E); }
#endif
    }
    GSYNC();
    { FRESH();
#ifndef SKIP_SWIGLU
    { pg8::Gemm g{X.H(), X.W() + W_GU, T, NGU, 1024, 1024, 1024}; pg8::StaticOrder So; So.init(T, NGU, X.G, X.blk);
      pg8::EpiSwiglu E{FFH, X.RSS()}; pg8::gemm_phase(lds, g, So, E); }
#endif
    }
    GSYNC();
    { FRESH();
#ifndef SKIP_DOWN
    { pg8::Gemm g{FFH, X.W() + W_DOWN, T, 1024, DFF, DFF, DFF}; pg8::StaticOrder So; So.init(T, 1024, X.G, X.blk);
      pg8::EpiResid E{X.out, X.out, X.H(), X.RSS(), (LAS float*)(lds + 131072)}; pg8::gemm_phase(lds, g, So, E); }
#endif
    }
    GSYNC();
  }
#ifndef SKIP_FINAL
  { FRESH(); final_norm_phase(X, PIN(28)); }
#endif
}

extern "C" void kernel_launch(void* const* d_in, const int* in_sizes, int n_in, void* d_out, int out_size, void* d_ws, size_t ws_size, hipStream_t stream) {
  static int grid_blocks = 0;
  if (!grid_blocks) {
    int dev = 0, cus = 0, per_cu = 0;
    (void)hipGetDevice(&dev);
    (void)hipDeviceGetAttribute(&cus, hipDeviceAttributeMultiprocessorCount, dev);
    (void)hipFuncSetAttribute((const void*)mega, hipFuncAttributeMaxDynamicSharedMemorySize, LDS_BYTES);
    (void)hipOccupancyMaxActiveBlocksPerMultiprocessor(&per_cu, (const void*)mega, 512, LDS_BYTES);
    if (per_cu < 1) per_cu = 1;
    if (per_cu > 1) per_cu = 1;
    grid_blocks = cus * per_cu;
    if (ws_size < WS_END || n_in != 29 || out_size != T * DM) fprintf(stderr, "kernel_launch: unexpected sizes: ws %zu (need %zu) n_in %d out %d\n", ws_size, (size_t)WS_END, n_in, out_size);
  }
  Params p;
  memset(&p, 0, sizeof(p));
  for (int i = 0; i < 29; ++i) p.in[i] = (const float*)d_in[i];
  p.out = (float*)d_out; p.ws = (unsigned char*)d_ws;
  for (int i = 0; i < 32; ++i) p.invf64[i] = (float)pow(10000.0, -(double)i / 32.0);
  for (int i = 0; i < 16; ++i) p.invf32[i] = (float)pow(10000.0, -(double)i / 16.0);
  (void)hipMemsetAsync((char*)d_ws + WS_BAR, 0, BAR_BYTES, stream);
  void* args[] = {&p};
  hipError_t e = hipLaunchCooperativeKernel((const void*)mega, dim3(grid_blocks), dim3(512), args, LDS_BYTES, stream);
  if (e != hipSuccess) fprintf(stderr, "cooperative launch failed: %s (grid %d)\n", hipGetErrorString(e), grid_blocks);
}
```

```cpp
#include <hip/hip_runtime.h>
#include <hip/hip_cooperative_groups.h>
#include <cstdio>
#include <cstdint>
#include <cmath>
#include <cstring>
namespace cg = cooperative_groups;

#define LAS __attribute__((address_space(3)))
typedef unsigned short bf16_t;
typedef short bf16x8 __attribute__((ext_vector_type(8)));
typedef short s16x4 __attribute__((ext_vector_type(4)));
typedef short v4i16_t __attribute__((ext_vector_type(4)));
typedef float f32x4 __attribute__((ext_vector_type(4)));
typedef float f32x2 __attribute__((ext_vector_type(2)));
typedef unsigned u32x4 __attribute__((ext_vector_type(4)));
typedef unsigned u32x2 __attribute__((ext_vector_type(2)));

constexpr int NB = 4, S = 8192, T = NB * S, DM = 1024, DEPTH = 2;
constexpr int DIN = 5816, NPROJ = 2816, NGATE = 3072, DFF = 2816, NGU = 5632;
constexpr int C_AQ = 0, C_AK = 512, C_AV = 640, C_BQ = 768, C_BKC = 1280, C_BVC = 1408, C_BKS = 1536, C_BVS = 1664, C_BKW = 1792, C_BVW = 1920;
constexpr int C_CQA = 2048, C_CKV = 2432, C_CKR = 2688, C_BG = 2720;
constexpr float LOG2E = 1.4426950408889634f;
constexpr float NORM_EPS = 1e-6f;

constexpr size_t MiB = 1u << 20;
constexpr size_t WS_KCMP = 0, WS_VCMP = MiB / 2, WS_MEMKV = 1 * MiB, WS_HM = 3 * MiB;
constexpr size_t WS_SELL = 5 * MiB;
constexpr size_t WS_BAR = 7 * MiB, BAR_BYTES = 16384;
constexpr size_t WS_CS64 = 8 * MiB, WS_CS32 = 16 * MiB;
constexpr size_t WS_W = 20 * MiB;
constexpr size_t WS_RSS = 59 * MiB;
constexpr size_t WS_H = 64 * MiB;
constexpr size_t WS_PROJ = 128 * MiB;
constexpr size_t WS_QM = 304 * MiB;
constexpr size_t WS_KVM = 352 * MiB;
constexpr size_t WS_OC = 416 * MiB;
constexpr size_t WS_QROT = 448 * MiB;
constexpr size_t WS_VST = 480 * MiB;
constexpr size_t WS_KST = 488 * MiB;
constexpr size_t WS_END = 496 * MiB;
constexpr size_t W_IN = 0, W_G = W_IN + (size_t)NPROJ * 1024, W_QB = W_G + (size_t)NGATE * 1024, W_KVB = W_QB + 768 * 384,
                 W_BR = W_KVB + 1024 * 256, W_OUT = W_BR + 3 * 1024 * 512, W_XQ = W_OUT + 1024 * 1024, W_XKV = W_XQ + 512 * 1024,
                 W_XO = W_XKV + 1024 * 1024, W_GU = W_XO + 1024 * 512, W_DOWN = W_GU + (size_t)NGU * 1024, W_K1 = W_DOWN + (size_t)1024 * DFF,
                 W_V1 = W_K1 + 64 * 2048, W_K2 = W_V1 + 64 * 2048, W_V2 = W_K2 + 64 * 64, W_ENDE = W_V2 + 64 * 64;
static_assert(W_ENDE * 2 <= 39 * MiB, "weights fit below the row-statistics buffer");

constexpr int LDS_BYTES = 147456;

typedef __bf16 bf16x2_t __attribute__((ext_vector_type(2)));
__device__ __forceinline__ unsigned cvt_pk_bf16(float lo, float hi) { f32x2 v = {lo, hi}; bf16x2_t b = __builtin_convertvector(v, bf16x2_t); return __builtin_bit_cast(unsigned, b); }
__device__ __forceinline__ float bf2f(unsigned short b) { return __uint_as_float(((unsigned)b) << 16); }
__device__ __forceinline__ float bflo(unsigned w) { return __uint_as_float(w << 16); }
__device__ __forceinline__ float bfhi(unsigned w) { return __uint_as_float(w & 0xffff0000u); }
__device__ __forceinline__ float ex2(float x) { return __builtin_amdgcn_exp2f(x); }
__device__ __forceinline__ float sigmoidf_(float x) { return __builtin_amdgcn_rcpf(1.0f + ex2(-x * LOG2E)); }
__device__ __forceinline__ float wave_sum(float v) {
#pragma unroll
  for (int o = 1; o < 64; o <<= 1) v += __shfl_xor(v, o);
  return v;
}
__device__ __forceinline__ int otid() { int t = threadIdx.x; asm volatile("" : "+v"(t)); return t; }
__device__ __forceinline__ int oidx(int k) { asm volatile("" : "+s"(k)); return k; }
#define LBAR() asm volatile("s_waitcnt lgkmcnt(0)\n\ts_barrier" ::: "memory")
#define LWAIT() asm volatile("s_waitcnt lgkmcnt(0)" ::: "memory")

__device__ __forceinline__ u32x2 pack8_fp8(const float (&a)[4], const float (&b)[4]) {
  int w0 = __builtin_amdgcn_cvt_pk_fp8_f32(a[0], a[1], 0, false); w0 = __builtin_amdgcn_cvt_pk_fp8_f32(a[2], a[3], w0, true);
  int w1 = __builtin_amdgcn_cvt_pk_fp8_f32(b[0], b[1], 0, false); w1 = __builtin_amdgcn_cvt_pk_fp8_f32(b[2], b[3], w1, true);
  return (u32x2){(unsigned)w0, (unsigned)w1};
}
__device__ __forceinline__ long as_long(unsigned lo, unsigned hi) { return (long)(((unsigned long long)hi << 32) | (unsigned long long)lo); }
__device__ __forceinline__ f32x4 mfma16_fp8(long a, long b, f32x4 c) { return __builtin_amdgcn_mfma_f32_16x16x32_fp8_fp8(a, b, c, 0, 0, 0); }

__device__ __forceinline__ float xor32(float v) { const unsigned u = __float_as_uint(v); auto rr = __builtin_amdgcn_permlane32_swap(u, u, false, false); return __uint_as_float((threadIdx.x & 32) ? rr[0] : rr[1]); }
__device__ __forceinline__ float xor16(float v) { const unsigned u = __float_as_uint(v); auto rr = __builtin_amdgcn_permlane16_swap(u, u, false, false); return __uint_as_float((threadIdx.x & 16) ? rr[0] : rr[1]); }
__device__ __forceinline__ float max_x16_x32(float v) { const unsigned u = __float_as_uint(v); auto a = __builtin_amdgcn_permlane16_swap(u, u, false, false); const float w = fmaxf(__uint_as_float(a[0]), __uint_as_float(a[1]));
  const unsigned u2 = __float_as_uint(w); auto b = __builtin_amdgcn_permlane32_swap(u2, u2, false, false); return fmaxf(__uint_as_float(b[0]), __uint_as_float(b[1])); }

namespace pg8 {
constexpr int BM = 256, BK = 64, HALF = 128, HTB = HALF * BK * 2, STAGE_BYTES = 8 * HTB, NXCD = 8, WGM = 8;
__device__ __forceinline__ int lds_byte(int r, int c) { const int st = (r >> 4) * 2 + (c >> 5), rr = r & 15, cc = c & 31, ob = rr * 64 + cc * 2; return st * 1024 + (ob ^ (((ob >> 9) & 1) << 5)); }
__device__ __forceinline__ void stage_rc(int b, int& R, int& C) { const int st = b / 1024, sb = b % 1024, swz = sb ^ (((sb >> 9) & 1) << 5); R = (st >> 1) * 16 + swz / 64; C = (st & 1) * 32 + (swz % 64) / 2; }
__device__ __forceinline__ int perm32(int rho) { const int n = rho >> 4, i = rho & 15; return 8 * (i >> 2) + 4 * n + (i & 3); }
struct Unit { int pm, pn; };
struct Gemm { const bf16_t* A; const bf16_t* Bt; int M, N, K, lda, ldb; };
__device__ __forceinline__ void tile_of(int L, int nM, int nN, Unit& u) {
  const int nwg = nM * nN; int wgid = L;
  { const int q = nwg / NXCD, r = nwg % NXCD, xcd = wgid % NXCD, off = wgid / NXCD; wgid = (xcd < r ? xcd * (q + 1) : r * (q + 1) + (xcd - r) * q) + off; }
  const int nig = WGM * nN, gid = wgid / nig, fm = gid * WGM, gsz = (nM - fm) < WGM ? (nM - fm) : WGM;
  u.pm = fm + ((wgid % nig) % gsz); u.pn = (wgid % nig) / gsz;
}
struct StaticOrder {
  int nM, nN, nwg, G, c;
  __device__ void init(int M, int N, int G_, int c_) { nM = M / BM; nN = N / BM; nwg = nM * nN; G = G_; c = c_; }
  __device__ __forceinline__ bool next(int i, Unit& u) const { const long L = (long)i * G + c; if (L >= nwg) return false; tile_of((int)L, nM, nN, u); return true; }
};
struct MergeOrder {
  int G, c;
  __device__ __forceinline__ bool next(int k, Unit& u) const { const int r = k / 3, i = k - 3 * r; const int L = r * G + c; if (L >= 512) return false; Unit t; tile_of(L, 128, 4, t); u.pm = i * 128 + t.pm; u.pn = i * 4 + t.pn; return true; }
};

template <class Epi, class Sched>
__device__ __forceinline__ void gemm_phase(LAS unsigned char* lds, const Gemm g, const Sched& S, const Epi& E) {
  const int tid = otid(), wid = __builtin_amdgcn_readfirstlane(tid >> 6), lane = tid & 63, wr = wid >> 2, wc = wid & 3, fr = lane & 15, fq = lane >> 4;
  const int K = g.K, nt = K / BK;
  unsigned voffA[2], voffB[2];
#pragma unroll
  for (int i = 0; i < 2; ++i) { int R, C; stage_rc(tid * 16 + i * 8192, R, C); const int Rb = (R & ~31) + perm32(R & 31);
    voffA[i] = (unsigned)(R * g.lda + C) * 2u; voffB[i] = (unsigned)(Rb * g.ldb + C) * 2u; }
  const size_t kstep = (size_t)(BK * 2);
  const size_t hstepA = (size_t)HALF * g.lda * 2, hstepB = (size_t)HALF * g.ldb * 2;
  const size_t tstepA = 2 * hstepA, tstepB = 2 * hstepB;
  const unsigned ldsw = (unsigned)wid * 1024u;
  const int aoff = lds_byte(wr * 64 + fr, fq * 8), boff = lds_byte(wc * 32 + fr, fq * 8);
#define PG8_SA(b, h) (((b) * 2 + (h)) * HTB)
#define PG8_SB(b, h) ((4 + (b) * 2 + (h)) * HTB)
#define PG8_STAGE(bufoff, gbase, voff) do { _Pragma("unroll") for (int _i = 0; _i < 2; ++_i) \
        __builtin_amdgcn_global_load_lds((const unsigned*)((const char*)(gbase) + (voff)[_i]), (LAS unsigned*)(lds + (bufoff) + ldsw + _i * 8192), 16, 0, 0); } while (0)
#define PG8_LDA(dst, b, h) do { _Pragma("unroll") for (int m = 0; m < 4; ++m) _Pragma("unroll") for (int k = 0; k < 2; ++k) dst[m][k] = *(const LAS bf16x8*)(lds + PG8_SA(b, h) + aoff + m * 2048 + k * 1024); } while (0)
#define PG8_LDB(dst, b, h) do { _Pragma("unroll") for (int n = 0; n < 2; ++n) _Pragma("unroll") for (int k = 0; k < 2; ++k) dst[n][k] = *(const LAS bf16x8*)(lds + PG8_SB(b, h) + boff + n * 2048 + k * 1024); } while (0)
#define PG8_MMA(ai, bj, At, Bt) do { __builtin_amdgcn_s_setprio(1); _Pragma("unroll") for (int m = 0; m < 4; ++m) _Pragma("unroll") for (int n = 0; n < 2; ++n) _Pragma("unroll") for (int k = 0; k < 2; ++k) \
        acc[ai][bj][m][n] = __builtin_amdgcn_mfma_f32_16x16x32_bf16(Bt[n][k], At[m][k], acc[ai][bj][m][n], 0, 0, 0); __builtin_amdgcn_s_setprio(0); } while (0)
#define PG8_WAIT_V(n) asm volatile("s_waitcnt vmcnt(" #n ")" ::: "memory")
#define PG8_WAIT_L(n) asm volatile("s_waitcnt lgkmcnt(" #n ")" ::: "memory")
#define PG8_BAR __builtin_amdgcn_s_barrier()
#define PG8_SCHED __builtin_amdgcn_sched_barrier(0)
  Unit cur, nxt; int ui = 0;
  if (!S.next(0, cur)) return;
  f32x4 acc[2][2][4][2];
#pragma unroll
  for (int a = 0; a < 2; ++a)
#pragma unroll
    for (int b = 0; b < 2; ++b)
#pragma unroll
      for (int m = 0; m < 4; ++m)
#pragma unroll
        for (int n = 0; n < 2; ++n) acc[a][b][m][n] = (f32x4){0.f, 0.f, 0.f, 0.f};
  bf16x8 At[4][2], B0[2][2], B1[2][2];
  const char* cA = (const char*)g.A + (size_t)cur.pm * tstepA; const char* cB = (const char*)g.Bt + (size_t)cur.pn * tstepB;
  PG8_STAGE(PG8_SB(0, 0), cB, voffB); PG8_STAGE(PG8_SB(0, 1), cB + hstepB, voffB); PG8_STAGE(PG8_SA(0, 0), cA, voffA); PG8_STAGE(PG8_SA(0, 1), cA + hstepA, voffA);
  if (wr == 1) PG8_BAR;
  PG8_WAIT_V(2); PG8_BAR;
  PG8_STAGE(PG8_SB(1, 0), cB + kstep, voffB); PG8_STAGE(PG8_SA(1, 0), cA + kstep, voffA); PG8_STAGE(PG8_SB(1, 1), cB + hstepB + kstep, voffB);
  PG8_WAIT_V(6); PG8_BAR;
  for (;;) {
    const bool has_next = S.next(ui + 1, nxt);
    const char* nA = has_next ? (const char*)g.A + (size_t)nxt.pm * tstepA : cA; const char* nB = has_next ? (const char*)g.Bt + (size_t)nxt.pn * tstepB : cB;
    for (int t = 0; t < nt; t += 2) {
      const bool last = (t == nt - 2);
      const char* a1 = cA + (size_t)(t + 1) * kstep;
      const char* a2 = last ? nA : cA + (size_t)(t + 2) * kstep; const char* b2 = last ? nB : cB + (size_t)(t + 2) * kstep;
      const char* a3 = a2 + kstep; const char* b3 = b2 + kstep;
      PG8_LDB(B0, 0, 0); PG8_LDB(B1, 0, 1); PG8_SCHED; PG8_LDA(At, 0, 0); PG8_STAGE(PG8_SA(1, 1), a1 + hstepA, voffA);
      PG8_WAIT_V(8); PG8_WAIT_L(0); PG8_BAR; PG8_MMA(0, 0, At, B0); PG8_MMA(0, 1, At, B1); PG8_BAR; PG8_SCHED;
      PG8_LDA(At, 0, 1); PG8_STAGE(PG8_SB(0, 0), b2, voffB); PG8_STAGE(PG8_SB(0, 1), b2 + hstepB, voffB); PG8_STAGE(PG8_SA(0, 0), a2, voffA);
      PG8_WAIT_V(8); PG8_WAIT_L(0); PG8_BAR; PG8_MMA(1, 0, At, B0); PG8_MMA(1, 1, At, B1); PG8_BAR; PG8_SCHED;
      PG8_LDB(B0, 1, 0); PG8_LDB(B1, 1, 1); PG8_SCHED; PG8_LDA(At, 1, 0); PG8_STAGE(PG8_SA(0, 1), a2 + hstepA, voffA);
      PG8_WAIT_V(8); PG8_WAIT_L(0); PG8_BAR; PG8_MMA(0, 0, At, B0); PG8_MMA(0, 1, At, B1); PG8_BAR; PG8_SCHED;
      PG8_LDA(At, 1, 1); PG8_STAGE(PG8_SB(1, 0), b3, voffB); PG8_STAGE(PG8_SB(1, 1), b3 + hstepB, voffB); PG8_STAGE(PG8_SA(1, 0), a3, voffA);
      PG8_WAIT_V(8); PG8_WAIT_L(0); PG8_BAR; PG8_MMA(1, 0, At, B0); PG8_MMA(1, 1, At, B1); PG8_BAR; PG8_SCHED;
    }
    if (wr == 0) PG8_BAR;
    { const int l2 = otid() & 63; E(acc, cur, wr, wc, l2 & 15, l2 >> 4); }
    if (!has_next) break;
#pragma unroll
    for (int a = 0; a < 2; ++a)
#pragma unroll
      for (int b = 0; b < 2; ++b)
#pragma unroll
        for (int m = 0; m < 4; ++m)
#pragma unroll
          for (int n = 0; n < 2; ++n) acc[a][b][m][n] = (f32x4){0.f, 0.f, 0.f, 0.f};
    cur = nxt; cA = nA; cB = nB; ++ui;
    if (wr == 1) PG8_BAR;
  }
  PG8_WAIT_V(0);
  PG8_BAR;
#undef PG8_SA
#undef PG8_SB
#undef PG8_STAGE
#undef PG8_LDA
#undef PG8_LDB
#undef PG8_MMA
#undef PG8_WAIT_V
#undef PG8_WAIT_L
#undef PG8_BAR
#undef PG8_SCHED
}

__device__ __forceinline__ void store8(bf16_t* p, const f32x4& v0, const f32x4& v1) {
  u32x4 w; w.x = cvt_pk_bf16(v0[0], v0[1]); w.y = cvt_pk_bf16(v0[2], v0[3]); w.z = cvt_pk_bf16(v1[0], v1[1]); w.w = cvt_pk_bf16(v1[2], v1[3]); *(u32x4*)p = w;
}
__device__ __forceinline__ void rope8(f32x4& v0, f32x4& v1, const f32x2* cs) {
  const f32x4 a = *(const f32x4*)cs, b = *(const f32x4*)(cs + 2);
  float x1, x2;
  x1 = v0[0]; x2 = v0[1]; v0[0] = x1 * a[0] - x2 * a[1]; v0[1] = x2 * a[0] + x1 * a[1];
  x1 = v0[2]; x2 = v0[3]; v0[2] = x1 * a[2] - x2 * a[3]; v0[3] = x2 * a[2] + x1 * a[3];
  x1 = v1[0]; x2 = v1[1]; v1[0] = x1 * b[0] - x2 * b[1]; v1[1] = x2 * b[0] + x1 * b[1];
  x1 = v1[2]; x2 = v1[3]; v1[2] = x1 * b[2] - x2 * b[3]; v1[3] = x2 * b[2] + x1 * b[3];
}
__device__ __forceinline__ float row_rstd(const float* rss, size_t row) { const f32x4 q = *(const f32x4*)(rss + row * 4); return __builtin_amdgcn_rsqf(((q[0] + q[1]) + (q[2] + q[3])) * (1.f / 1024.f) + NORM_EPS); }
#define EPI_FOR_ROWS for (int ai = 0; ai < 2; ++ai) for (int m = 0; m < 4; ++m)
struct EpiPlain {
  bf16_t* O; int ldc; const float* rss;
  __device__ __forceinline__ void operator()(const f32x4 (&acc)[2][2][4][2], const Unit& u, int wr, int wc, int fr, int fq) const {
#pragma unroll
    for (int ai = 0; ai < 2; ++ai)
#pragma unroll
      for (int m = 0; m < 4; ++m) { const size_t row = (size_t)u.pm * BM + ai * HALF + wr * 64 + m * 16 + fr;
#pragma unroll
        for (int bj = 0; bj < 2; ++bj) { const int col0 = u.pn * BM + bj * HALF + wc * 32 + 8 * fq; const float rs = rss ? row_rstd(rss, row) : 1.0f; store8(O + row * ldc + col0, acc[ai][bj][m][0] * rs, acc[ai][bj][m][1] * rs); } }
  }
};
struct EpiInproj {
  bf16_t* proj; bf16_t* qrot; bf16_t* vst; bf16_t* kst; const f32x2* cs64; const f32x2* cs32; const float* rss;
  __device__ __forceinline__ void operator()(const f32x4 (&acc)[2][2][4][2], const Unit& u, int wr, int wc, int fr, int fq) const {
    constexpr unsigned ROPE_IN = (1u << 0) | (1u << 1) | (1u << 2) | (1u << 3) | (1u << 4) | (1u << 12) | (1u << 14);
    constexpr unsigned ROPE_DUAL = (1u << 6) | (1u << 7) | (1u << 8) | (1u << 9);
#pragma unroll
    for (int ai = 0; ai < 2; ++ai)
#pragma unroll
      for (int m = 0; m < 4; ++m) { const size_t row = (size_t)u.pm * BM + ai * HALF + wr * 64 + m * 16 + fr; const float rs = row_rstd(rss, row);
#pragma unroll
        for (int bj = 0; bj < 2; ++bj) {
          const int seg = 2 * u.pn + bj; const int col0 = u.pn * BM + bj * HALF + wc * 32 + 8 * fq;
          f32x4 v0 = acc[ai][bj][m][0] * rs, v1 = acc[ai][bj][m][1] * rs;
          bf16_t* dst = proj + row * NPROJ + col0;
          if ((ROPE_IN >> seg) & 1u) { rope8(v0, v1, cs64 + row * 32 + ((col0 & 63) >> 1));
            if (seg == 12) {
              const int cc = col0 - C_BKS, gs = cc >> 6, d0 = cc & 63; const int b = (int)(row >> 13), s = (int)(row & 8191), blk = s >> 6, k6 = s & 63;
              const float a4[4] = {v0[0], v0[1], v0[2], v0[3]}, b4[4] = {v1[0], v1[1], v1[2], v1[3]};
              unsigned char* kd = (unsigned char*)kst + ((size_t)(b * 2 + gs) * 128 + blk) * 4096 + (((k6 >> 4) * 16 + (k6 & 15)) * 4 + ((d0 & 31) >> 3)) * 16 + (d0 >> 5) * 8;
              *(u32x2*)kd = pack8_fp8(a4, b4);
            } else store8(dst, v0, v1); }
          else if ((ROPE_DUAL >> seg) & 1u) { store8(dst, v0, v1); rope8(v0, v1, cs64 + row * 32 + ((col0 & 63) >> 1)); store8(qrot + row * 512 + (col0 - C_BQ), v0, v1); }
          else if (seg == 21 && wc == 0) { rope8(v0, v1, cs32 + row * 16 + ((col0 - C_CKR) >> 1)); store8(dst, v0, v1); }
          else {
            store8(dst, v0, v1);
            if (seg == 13) {
              const int cc = col0 - C_BVS, gs = cc >> 6, d0 = cc & 63; const int b = (int)(row >> 13), s = (int)(row & 8191), blk = s >> 6, k6 = s & 63, k5 = k6 & 31;
              const int lgp = (k5 & 15) >> 2, jj = ((k5 >> 4) << 2) | (k5 & 3);
              const float a4[4] = {v0[0], v0[1], v0[2], v0[3]}, b4[4] = {v1[0], v1[1], v1[2], v1[3]};
              const u32x2 q8 = pack8_fp8(a4, b4);
              unsigned char* vd = (unsigned char*)vst + ((size_t)(b * 2 + gs) * 128 + blk) * 4096 + (((d0 >> 4) * 16 + (d0 & 15)) * 4 + lgp) * 16 + (k6 >> 5) * 8 + jj;
              vd[0 * 64] = (unsigned char)(q8.x); vd[1 * 64] = (unsigned char)(q8.x >> 8); vd[2 * 64] = (unsigned char)(q8.x >> 16); vd[3 * 64] = (unsigned char)(q8.x >> 24);
              vd[4 * 64] = (unsigned char)(q8.y); vd[5 * 64] = (unsigned char)(q8.y >> 8); vd[6 * 64] = (unsigned char)(q8.y >> 16); vd[7 * 64] = (unsigned char)(q8.y >> 24);
            }
          }
        } }
  }
};
struct EpiMlaQ {
  bf16_t* O; const f32x2* cs32;
  __device__ __forceinline__ void operator()(const f32x4 (&acc)[2][2][4][2], const Unit& u, int wr, int wc, int fr, int fq) const {
#pragma unroll
    for (int ai = 0; ai < 2; ++ai)
#pragma unroll
      for (int m = 0; m < 4; ++m) { const size_t row = (size_t)u.pm * BM + ai * HALF + wr * 64 + m * 16 + fr;
#pragma unroll
        for (int bj = 0; bj < 2; ++bj) { const int col0 = u.pn * BM + bj * HALF + wc * 32 + 8 * fq; const int o = col0 % 96;
          f32x4 v0 = acc[ai][bj][m][0], v1 = acc[ai][bj][m][1];
          if (o >= 64) rope8(v0, v1, cs32 + row * 16 + ((o - 64) >> 1));
          store8(O + row * 768 + col0, v0, v1); } }
  }
};
struct EpiGates {
  bf16_t* O; const float* rss;
  __device__ __forceinline__ void operator()(const f32x4 (&acc)[2][2][4][2], const Unit& u, int wr, int wc, int fr, int fq) const {
#pragma unroll
    for (int ai = 0; ai < 2; ++ai)
#pragma unroll
      for (int m = 0; m < 4; ++m) { const size_t row = (size_t)u.pm * BM + ai * HALF + wr * 64 + m * 16 + fr; const float rs = row_rstd(rss, row);
#pragma unroll
        for (int bj = 0; bj < 2; ++bj) { const int col0 = u.pn * BM + bj * HALF + wc * 32 + 8 * fq;
          f32x4 v0 = acc[ai][bj][m][0], v1 = acc[ai][bj][m][1];
#pragma unroll
          for (int e = 0; e < 4; ++e) { v0[e] = sigmoidf_(v0[e] * rs); v1[e] = sigmoidf_(v1[e] * rs); }
          store8(O + row * NGATE + col0, v0, v1); } }
  }
};
struct EpiMerge {
  const bf16_t* gates; bf16_t* merged;
  __device__ __forceinline__ void operator()(const f32x4 (&acc)[2][2][4][2], const Unit& u, int wr, int wc, int fr, int fq) const {
    const int br = u.pm >> 7, pm = u.pm & 127, pn = u.pn & 3;
#pragma unroll
    for (int ai = 0; ai < 2; ++ai) {
      u32x4 gw[4][2], pw[4][2];
#pragma unroll
      for (int m = 0; m < 4; ++m) { const size_t row = (size_t)pm * BM + ai * HALF + wr * 64 + m * 16 + fr;
#pragma unroll
        for (int bj = 0; bj < 2; ++bj) { const int col0 = pn * BM + bj * HALF + wc * 32 + 8 * fq;
          gw[m][bj] = *(const u32x4*)(gates + row * NGATE + br * 1024 + col0);
          pw[m][bj] = br > 0 ? *(const u32x4*)(merged + row * 1024 + col0) : (u32x4){0u, 0u, 0u, 0u}; } }
#pragma unroll
      for (int m = 0; m < 4; ++m) { const size_t row = (size_t)pm * BM + ai * HALF + wr * 64 + m * 16 + fr;
#pragma unroll
        for (int bj = 0; bj < 2; ++bj) { const int col0 = pn * BM + bj * HALF + wc * 32 + 8 * fq;
          f32x4 v0 = acc[ai][bj][m][0], v1 = acc[ai][bj][m][1]; const u32x4 g4 = gw[m][bj], p4 = pw[m][bj];
          v0[0] = v0[0] * bflo(g4.x) + bflo(p4.x); v0[1] = v0[1] * bfhi(g4.x) + bfhi(p4.x); v0[2] = v0[2] * bflo(g4.y) + bflo(p4.y); v0[3] = v0[3] * bfhi(g4.y) + bfhi(p4.y);
          v1[0] = v1[0] * bflo(g4.z) + bflo(p4.z); v1[1] = v1[1] * bfhi(g4.z) + bfhi(p4.z); v1[2] = v1[2] * bflo(g4.w) + bflo(p4.w); v1[3] = v1[3] * bfhi(g4.w) + bfhi(p4.w);
          store8(merged + row * 1024 + col0, v0, v1); } }
    }
  }
};
struct EpiResid {
  const float* res; float* out; bf16_t* xb; float* rss; LAS float* xl;
  __device__ __forceinline__ void operator()(const f32x4 (&acc)[2][2][4][2], const Unit& u, int wr, int wc, int fr, int fq) const {
#pragma unroll
    for (int ai = 0; ai < 2; ++ai) {
      f32x4 rv[4][2][2];
#pragma unroll
      for (int m = 0; m < 4; ++m) { const size_t row = (size_t)u.pm * BM + ai * HALF + wr * 64 + m * 16 + fr;
#pragma unroll
        for (int bj = 0; bj < 2; ++bj) { const size_t off = row * 1024 + u.pn * BM + bj * HALF + wc * 32 + 8 * fq; rv[m][bj][0] = *(const f32x4*)(res + off); rv[m][bj][1] = *(const f32x4*)(res + off + 4); } }
#pragma unroll
      for (int m = 0; m < 4; ++m) { const size_t row = (size_t)u.pm * BM + ai * HALF + wr * 64 + m * 16 + fr; float ss = 0.f;
#pragma unroll
        for (int bj = 0; bj < 2; ++bj) { const size_t off = row * 1024 + u.pn * BM + bj * HALF + wc * 32 + 8 * fq;
          const f32x4 r0 = rv[m][bj][0] + acc[ai][bj][m][0], r1 = rv[m][bj][1] + acc[ai][bj][m][1];
          *(f32x4*)(out + off) = r0; *(f32x4*)(out + off + 4) = r1; store8(xb + off, r0, r1);
          ss += (r0[0] * r0[0] + r0[1] * r0[1]) + (r0[2] * r0[2] + r0[3] * r0[3]) + (r1[0] * r1[0] + r1[1] * r1[1]) + (r1[2] * r1[2] + r1[3] * r1[3]); }
        ss += xor16(ss); ss += xor32(ss);
        if (fq == 0) xl[wc * 256 + ai * HALF + wr * 64 + m * 16 + fr] = ss; }
    }
    asm volatile("s_waitcnt lgkmcnt(0)\n\ts_barrier" ::: "memory");
    { const int t2 = otid(); if (t2 < 256) rss[((size_t)u.pm * BM + t2) * 4 + u.pn] = (xl[t2] + xl[256 + t2]) + (xl[512 + t2] + xl[768 + t2]); }
    asm volatile("s_waitcnt lgkmcnt(0)\n\ts_barrier" ::: "memory");
  }
};
struct EpiSwiglu {
  bf16_t* O; const float* rss;
  __device__ __forceinline__ void operator()(const f32x4 (&acc)[2][2][4][2], const Unit& u, int wr, int wc, int fr, int fq) const {
#pragma unroll
    for (int ai = 0; ai < 2; ++ai)
#pragma unroll
      for (int m = 0; m < 4; ++m) { const size_t row = (size_t)u.pm * BM + ai * HALF + wr * 64 + m * 16 + fr; const float rs = row_rstd(rss, row);
#pragma unroll
        for (int bj = 0; bj < 2; ++bj) { const int col0 = u.pn * BM + bj * HALF + wc * 32 + 8 * fq;
          const f32x4 gt = acc[ai][bj][m][0] * rs, up = acc[ai][bj][m][1] * rs; float r[4];
#pragma unroll
          for (int e = 0; e < 4; ++e) r[e] = gt[e] * sigmoidf_(gt[e]) * up[e];
          u32x2 w; w.x = cvt_pk_bf16(r[0], r[1]); w.y = cvt_pk_bf16(r[2], r[3]);
          *(u32x2*)(O + row * DFF + (col0 >> 1)) = w; } }
  }
};
}

__device__ __forceinline__ f32x4 mfma16(bf16x8 a, bf16x8 b, f32x4 c) { return __builtin_amdgcn_mfma_f32_16x16x32_bf16(a, b, c, 0, 0, 0); }
__device__ __forceinline__ s16x4 ds_tr(LAS const unsigned char* p) { return __builtin_bit_cast(s16x4, __builtin_amdgcn_ds_read_tr16_b64_v4i16((LAS v4i16_t*)p)); }
__device__ __forceinline__ bf16x8 pack8(const float (&a)[4], const float (&b)[4]) {
  u32x4 w; w.x = cvt_pk_bf16(a[0], a[1]); w.y = cvt_pk_bf16(a[2], a[3]); w.z = cvt_pk_bf16(b[0], b[1]); w.w = cvt_pk_bf16(b[2], b[3]); return __builtin_bit_cast(bf16x8, w);
}
enum { MODE_NONE = 0, MODE_CAUSAL = 1, MODE_WINDOW = 2, MODE_CMP = 3 };
template <int MODE> __device__ __forceinline__ bool mask_ok(int tq, int kp, int W) {
  if (MODE == MODE_CAUSAL) return kp <= tq;
  if (MODE == MODE_WINDOW) return kp <= tq && kp > tq - W;
  if (MODE == MODE_CMP) return 16 * kp + 31 <= tq;
  return true;
}
template <int NT, int NKK, int NDT, int MODE, bool MASK>
__device__ __forceinline__ void attn_chunk(f32x4 (&o)[NT][NDT], float (&m)[NT], float (&l)[NT], const bf16x8 (&qf)[NT][NKK],
                                           LAS const unsigned char* Kl, int KSTR, LAS const unsigned char* Vl, int VSTR, int kpos0, const int (&tq)[NT], float c, int W, int lane) {
  constexpr int JB = 2;
  const int r = lane & 15, lg = lane >> 4, vq = (lane & 15) >> 2, vp = lane & 3;
#pragma unroll 1
  for (int st = 0; st < 2; ++st) {
#pragma unroll
    for (int jh = 0; jh < NT / JB; ++jh) {
      int oz = 0; if (NT > JB) asm volatile("" : "+v"(oz));
      f32x4 s[JB][2];
      __builtin_amdgcn_s_setprio(1);
#pragma unroll
      for (int t = 0; t < 2; ++t)
#pragma unroll
        for (int kk = 0; kk < NKK; ++kk) {
          const bf16x8 kf = *(LAS const bf16x8*)(Kl + oz + (32 * st + 16 * t + r) * KSTR + (32 * kk + 8 * lg) * 2);
#pragma unroll
          for (int jj = 0; jj < JB; ++jj) s[jj][t] = mfma16(kf, qf[jh * JB + jj][kk], kk == 0 ? (f32x4){0.f, 0.f, 0.f, 0.f} : s[jj][t]);
        }
      __builtin_amdgcn_s_setprio(0);
      bf16x8 pf[JB];
      if (NT > JB) __builtin_amdgcn_sched_barrier(0);
#pragma unroll
      for (int jj = 0; jj < JB; ++jj) {
        const int j = jh * JB + jj;
        float mx = -INFINITY;
#pragma unroll
        for (int t = 0; t < 2; ++t)
#pragma unroll
          for (int i = 0; i < 4; ++i) {
            if (MASK) { const int kp = kpos0 + 32 * st + 16 * t + 4 * lg + i; if (!mask_ok<MODE>(tq[j], kp, W)) s[jj][t][i] = -INFINITY; }
            mx = fmaxf(mx, s[jj][t][i]);
          }
        mx = max_x16_x32(mx);
        if (NT > 2 || __any(mx > m[j] + 8.0f / c)) {
          const float mnew = fmaxf(m[j], mx);
          const float ms2 = (mnew == -INFINITY) ? 0.f : mnew;
          const float alpha = ex2((m[j] - ms2) * c);
          m[j] = mnew; l[j] *= alpha;
#pragma unroll
          for (int dt = 0; dt < NDT; ++dt) o[j][dt] *= alpha;
        }
        const float mc = ((m[j] == -INFINITY) ? 0.f : m[j]) * c;
        float p0[4], p1[4], ps = 0.f;
#pragma unroll
        for (int i = 0; i < 4; ++i) { p0[i] = ex2(s[jj][0][i] * c - mc); p1[i] = ex2(s[jj][1][i] * c - mc); ps += p0[i] + p1[i]; }
        l[j] += ps;
        pf[jj] = pack8(p0, p1);
      }
      if (NT > JB) __builtin_amdgcn_sched_barrier(0);
      __builtin_amdgcn_s_setprio(1);
#pragma unroll
      for (int dt = 0; dt < NDT; ++dt) {
        const s16x4 v0 = ds_tr(Vl + oz + (32 * st + 4 * lg + vq) * VSTR + (16 * dt + 4 * vp) * 2);
        const s16x4 v1 = ds_tr(Vl + oz + (32 * st + 16 + 4 * lg + vq) * VSTR + (16 * dt + 4 * vp) * 2);
        const bf16x8 vf = (bf16x8){v0[0], v0[1], v0[2], v0[3], v1[0], v1[1], v1[2], v1[3]};
#pragma unroll
        for (int jj = 0; jj < JB; ++jj) o[jh * JB + jj][dt] = mfma16(vf, pf[jj], o[jh * JB + jj][dt]);
      }
      __builtin_amdgcn_s_setprio(0);
      if (NT > JB) __builtin_amdgcn_sched_barrier(0);
    }
  }
}

template <int NT, int NKK, int NDT, int MODE, bool MASK>
__device__ __forceinline__ void attn_chunk_wide(f32x4 (&o)[NT][NDT], float (&m)[NT], float (&l)[NT], const bf16x8 (&qf)[NT][NKK],
                                                LAS const unsigned char* Kl, int KSTR, LAS const unsigned char* Vl, int VSTR, int kpos0, const int (&tq)[NT], float c, int W, int lane) {
  const int r = lane & 15, lg = lane >> 4, vq = (lane & 15) >> 2, vp = lane & 3;
  f32x4 s[NT][4];
  __builtin_amdgcn_s_setprio(1);
#pragma unroll
  for (int t = 0; t < 4; ++t)
#pragma unroll
    for (int kk = 0; kk < NKK; ++kk) {
      const bf16x8 kf = *(LAS const bf16x8*)(Kl + (16 * t + r) * KSTR + (32 * kk + 8 * lg) * 2);
#pragma unroll
      for (int j = 0; j < NT; ++j) s[j][t] = mfma16(kf, qf[j][kk], kk == 0 ? (f32x4){0.f, 0.f, 0.f, 0.f} : s[j][t]);
    }
  __builtin_amdgcn_s_setprio(0);
  bf16x8 pf[NT][2];
#pragma unroll
  for (int j = 0; j < NT; ++j) {
    float mx = -INFINITY;
#pragma unroll
    for (int t = 0; t < 4; ++t)
#pragma unroll
      for (int i = 0; i < 4; ++i) {
        if (MASK) { const int kp = kpos0 + 16 * t + 4 * lg + i; if (!mask_ok<MODE>(tq[j], kp, W)) s[j][t][i] = -INFINITY; }
        mx = fmaxf(mx, s[j][t][i]);
      }
    mx = max_x16_x32(mx);
    if (__any(mx > m[j] + 8.0f / c)) {
      const float mnew = fmaxf(m[j], mx);
      const float ms2 = (mnew == -INFINITY) ? 0.f : mnew;
      const float alpha = ex2((m[j] - ms2) * c);
      m[j] = mnew; l[j] *= alpha;
#pragma unroll
      for (int dt = 0; dt < NDT; ++dt) o[j][dt] *= alpha;
    }
    const float mc = ((m[j] == -INFINITY) ? 0.f : m[j]) * c;
    float p[4][4], ps = 0.f;
#pragma unroll
    for (int t = 0; t < 4; ++t)
#pragma unroll
      for (int i = 0; i < 4; ++i) { p[t][i] = ex2(s[j][t][i] * c - mc); ps += p[t][i]; }
    l[j] += ps;
    pf[j][0] = pack8(p[0], p[1]); pf[j][1] = pack8(p[2], p[3]);
  }
  __builtin_amdgcn_s_setprio(1);
#pragma unroll
  for (int st = 0; st < 2; ++st)
#pragma unroll
    for (int dt = 0; dt < NDT; ++dt) {
      const s16x4 v0 = ds_tr(Vl + (32 * st + 4 * lg + vq) * VSTR + (16 * dt + 4 * vp) * 2);
      const s16x4 v1 = ds_tr(Vl + (32 * st + 16 + 4 * lg + vq) * VSTR + (16 * dt + 4 * vp) * 2);
      const bf16x8 vf = (bf16x8){v0[0], v0[1], v0[2], v0[3], v1[0], v1[1], v1[2], v1[3]};
#pragma unroll
      for (int j = 0; j < NT; ++j) o[j][dt] = mfma16(vf, pf[j][st], o[j][dt]);
    }
  __builtin_amdgcn_s_setprio(0);
}

template <int NT, int DQK, int DV, int MODE, int PD, class Src>
__device__ __forceinline__ void attn_block_loop(LAS unsigned char* lds, const Src& src, f32x4 (&o)[NT][DV / 16], float (&m)[NT], float (&l)[NT], const bf16x8 (&qf)[NT][DQK / 32],
                                                const int (&tq)[NT], int kc0, int kc1, int kbase, int tq_min, int tq_max, float c, int W) {
  constexpr int KSTR = DQK * 2 + 16, VSTR = DV * 2 + 32, KB = 64 * KSTR, VB = 64 * VSTR, BUF = KB + VB;
  constexpr int KCH = DQK / 8, VCH = DV / 8, NKI = 64 * KCH, NVI = 64 * VCH, NKR = (NKI + 511) / 512, NVR = (NVI + 511) / 512;
  const int tid = otid(), lane = tid & 63;
  u32x4 kreg[PD][NKR], vreg[PD][NVR];
#define ABL_LOAD(u, kc) do { \
    _Pragma("unroll") for (int rr = 0; rr < NKR; ++rr) { const int idx = tid + 512 * rr; if (idx < NKI) { const int row = idx / KCH, ch = idx % KCH; kreg[u][rr] = *(const u32x4*)src.kaddr((kc) * 64 + row, ch); } } \
    _Pragma("unroll") for (int rr = 0; rr < NVR; ++rr) { const int idx = tid + 512 * rr; if (idx < NVI) { const int row = idx / VCH, ch = idx % VCH; vreg[u][rr] = *(const u32x4*)src.vaddr((kc) * 64 + row, ch); } } } while (0)
#pragma unroll
  for (int u = 0; u < PD; ++u) if (kc0 + u < kc1) ABL_LOAD(u, kc0 + u);
  for (int kcb = kc0; kcb < kc1; kcb += PD) {
#pragma unroll
    for (int u = 0; u < PD; ++u) {
      const int kc = kcb + u;
      if (kc < kc1) {
        LAS unsigned char* buf = lds + ((kc - kc0) & 1) * BUF;
#pragma unroll
        for (int rr = 0; rr < NKR; ++rr) { const int idx = tid + 512 * rr; if (idx < NKI) { const int row = idx / KCH, ch = idx % KCH; *(LAS u32x4*)(buf + row * KSTR + ch * 16) = kreg[u][rr]; } }
#pragma unroll
        for (int rr = 0; rr < NVR; ++rr) { const int idx = tid + 512 * rr; if (idx < NVI) { const int row = idx / VCH, ch = idx % VCH; *(LAS u32x4*)(buf + KB + row * VSTR + ch * 16) = vreg[u][rr]; } }
        if (kc + PD < kc1) ABL_LOAD(u, kc + PD);
        LBAR();
        const int lo = kbase + 64 * kc, hi = lo + 63;
        bool rel = true, full = true;
        if (MODE == MODE_CAUSAL) { rel = lo <= tq_max; full = hi <= tq_min; }
        if (MODE == MODE_WINDOW) { rel = (lo <= tq_max) && (hi > tq_min - W); full = (hi <= tq_min) && (lo > tq_max - W); }
        if (MODE == MODE_CMP) { rel = 16 * lo + 31 <= tq_max; full = 16 * hi + 31 <= tq_min; }
        if (rel) {
          if (NT <= 2) {
            if (full) attn_chunk_wide<NT, DQK / 32, DV / 16, MODE, false>(o, m, l, qf, buf, KSTR, buf + KB, VSTR, lo, tq, c, W, lane);
            else attn_chunk_wide<NT, DQK / 32, DV / 16, MODE, true>(o, m, l, qf, buf, KSTR, buf + KB, VSTR, lo, tq, c, W, lane);
          } else {
            if (full) attn_chunk<NT, DQK / 32, DV / 16, MODE, false>(o, m, l, qf, buf, KSTR, buf + KB, VSTR, lo, tq, c, W, lane);
            else attn_chunk<NT, DQK / 32, DV / 16, MODE, true>(o, m, l, qf, buf, KSTR, buf + KB, VSTR, lo, tq, c, W, lane);
          }
        }
      }
    }
  }
#undef ABL_LOAD
  LBAR();
}
__device__ __forceinline__ float lsum4(float l) { l += xor16(l); l += xor32(l); return l; }
__device__ __forceinline__ void store4(bf16_t* p, const f32x4& v, float sc) { u32x2 w; w.x = cvt_pk_bf16(v[0] * sc, v[1] * sc); w.y = cvt_pk_bf16(v[2] * sc, v[3] * sc); *(u32x2*)p = w; }

struct Params {
  const float* in[29]; float* out; unsigned char* ws; float invf64[32]; float invf32[16]; int pad0, pad1;
};
struct Ctx {
  const float* const* in; unsigned char* ws; float* out; int G, blk;
  __device__ __forceinline__ bf16_t* W() const { return (bf16_t*)(ws + WS_W); }
  __device__ __forceinline__ bf16_t* H() const { return (bf16_t*)(ws + WS_H); }
  __device__ __forceinline__ bf16_t* PROJ() const { return (bf16_t*)(ws + WS_PROJ); }
  __device__ __forceinline__ bf16_t* QM() const { return (bf16_t*)(ws + WS_QM); }
  __device__ __forceinline__ bf16_t* KVM() const { return (bf16_t*)(ws + WS_KVM); }
  __device__ __forceinline__ bf16_t* OA() const { return (bf16_t*)(ws + WS_KVM); }
  __device__ __forceinline__ bf16_t* OC() const { return (bf16_t*)(ws + WS_OC); }
  __device__ __forceinline__ bf16_t* QROT() const { return (bf16_t*)(ws + WS_QROT); }
  __device__ __forceinline__ bf16_t* VST() const { return (bf16_t*)(ws + WS_VST); }
  __device__ __forceinline__ bf16_t* KST() const { return (bf16_t*)(ws + WS_KST); }
  __device__ __forceinline__ bf16_t* KCMP() const { return (bf16_t*)(ws + WS_KCMP); }
  __device__ __forceinline__ bf16_t* VCMP() const { return (bf16_t*)(ws + WS_VCMP); }
  __device__ __forceinline__ bf16_t* MEMKV() const { return (bf16_t*)(ws + WS_MEMKV); }
  __device__ __forceinline__ bf16_t* HM() const { return (bf16_t*)(ws + WS_HM); }
  __device__ __forceinline__ float* RSS() const { return (float*)(ws + WS_RSS); }
  __device__ __forceinline__ unsigned char* SELL() const { return ws + WS_SELL; }
  __device__ __forceinline__ bf16_t* OW() const { return (bf16_t*)(ws + WS_QM); }
  __device__ __forceinline__ f32x2* CS64() const { return (f32x2*)(ws + WS_CS64); }
  __device__ __forceinline__ f32x2* CS32() const { return (f32x2*)(ws + WS_CS32); }
};

struct SrcMla { const bf16_t* kvm; const bf16_t* proj; size_t rowbase; int h;
  __device__ __forceinline__ const bf16_t* kaddr(int krow, int ch) const { return ch < 8 ? kvm + (rowbase + krow) * 1024 + 128 * h + 8 * ch : proj + (rowbase + krow) * NPROJ + C_CKR + 8 * (ch - 8); }
  __device__ __forceinline__ const bf16_t* vaddr(int krow, int ch) const { return kvm + (rowbase + krow) * 1024 + 128 * h + 64 + 8 * ch; } };
__device__ __forceinline__ void mla_unit(LAS unsigned char* lds, const Ctx& X, int b, int h, int qb) {
  const int tid = otid(), lane = tid & 63, w = __builtin_amdgcn_readfirstlane(tid >> 6), cq = lane & 15, lg = lane >> 4;
  const size_t rowbase = (size_t)b * S; const int qw = qb * 256 + 32 * w;
  bf16x8 qf[2][3]; int tq[2]; f32x4 o[2][4]; float m[2], l[2];
#pragma unroll
  for (int j = 0; j < 2; ++j) { tq[j] = qw + 16 * j + cq; m[j] = -INFINITY; l[j] = 0.f;
#pragma unroll
    for (int kk = 0; kk < 3; ++kk) qf[j][kk] = *(const bf16x8*)(X.QM() + (rowbase + tq[j]) * 768 + 96 * h + 32 * kk + 8 * lg);
#pragma unroll
    for (int dt = 0; dt < 4; ++dt) o[j][dt] = (f32x4){0.f, 0.f, 0.f, 0.f}; }
  SrcMla src{X.KVM(), X.PROJ(), rowbase, h};
  const float c = 0.10206207261596577f * LOG2E;
  attn_block_loop<2, 96, 64, MODE_CAUSAL, 3, SrcMla>(lds, src, o, m, l, qf, tq, 0, 4 * (qb + 1), 0, qw, qw + 31, c, 0);
#pragma unroll
  for (int j = 0; j < 2; ++j) { const float lt = lsum4(l[j]); const float inv = lt > 0.f ? 1.0f / lt : 0.f;
#pragma unroll
    for (int dt = 0; dt < 4; ++dt) store4(X.OC() + (rowbase + tq[j]) * 512 + 64 * h + 16 * dt + 4 * lg, o[j][dt], inv); }
}
struct SrcX { const bf16_t* kv; size_t rowbase; int h;
  __device__ __forceinline__ const bf16_t* kaddr(int krow, int ch) const { return kv + (rowbase + krow) * 1024 + 128 * h + 8 * ch; }
  __device__ __forceinline__ const bf16_t* vaddr(int krow, int ch) const { return kv + (rowbase + krow) * 1024 + 512 + 128 * h + 8 * ch; } };
__device__ __forceinline__ void xattn_unit(LAS unsigned char* lds, const Ctx& X, const bf16_t* xq, bf16_t* ox, int b, int h, int qb) {
  const int tid = otid(), lane = tid & 63, w = __builtin_amdgcn_readfirstlane(tid >> 6), cq = lane & 15, lg = lane >> 4;
  const size_t rowbase = (size_t)b * S; const int qw = qb * 256 + 32 * w;
  bf16x8 qf[2][4]; int tq[2]; f32x4 o[2][8]; float m[2], l[2];
#pragma unroll
  for (int j = 0; j < 2; ++j) { tq[j] = qw + 16 * j + cq; m[j] = -INFINITY; l[j] = 0.f;
#pragma unroll
    for (int kk = 0; kk < 4; ++kk) qf[j][kk] = *(const bf16x8*)(xq + (rowbase + tq[j]) * 512 + 128 * h + 32 * kk + 8 * lg);
#pragma unroll
    for (int dt = 0; dt < 8; ++dt) o[j][dt] = (f32x4){0.f, 0.f, 0.f, 0.f}; }
  SrcX src{X.MEMKV(), (size_t)b * 256, h};
  const float c = 0.08838834764831845f * LOG2E;
  attn_block_loop<2, 128, 128, MODE_NONE, 2, SrcX>(lds, src, o, m, l, qf, tq, 0, 4, 0, 0, 0, c, 0);
#pragma unroll
  for (int j = 0; j < 2; ++j) { const float lt = lsum4(l[j]); const float inv = lt > 0.f ? 1.0f / lt : 0.f;
#pragma unroll
    for (int dt = 0; dt < 8; ++dt) store4(ox + (rowbase + tq[j]) * 512 + 128 * h + 16 * dt + 4 * lg, o[j][dt], inv); }
}
struct SrcProj { const bf16_t* proj; size_t rowbase; int kcol, vcol;
  __device__ __forceinline__ const bf16_t* kaddr(int krow, int ch) const { return proj + (rowbase + krow) * NPROJ + kcol + 8 * ch; }
  __device__ __forceinline__ const bf16_t* vaddr(int krow, int ch) const { return proj + (rowbase + krow) * NPROJ + vcol + 8 * ch; } };
__device__ __forceinline__ void swa_unit(LAS unsigned char* lds, const Ctx& X, const float* sinks, int b, int kvh, int qb) {
  const int tid = otid(), lane = tid & 63, w = __builtin_amdgcn_readfirstlane(tid >> 6), cq = lane & 15, lg = lane >> 4;
  const size_t rowbase = (size_t)b * S; const int q0 = qb * 128, qw = q0 + 16 * w;
  bf16x8 qf[4][2]; int tq[4]; f32x4 o[4][4]; float m[4], l[4];
#pragma unroll
  for (int j = 0; j < 4; ++j) { tq[j] = qw + cq; m[j] = sinks[4 * kvh + j] * 8.0f; l[j] = (lg == 0) ? 1.0f : 0.f;
#pragma unroll
    for (int kk = 0; kk < 2; ++kk) qf[j][kk] = *(const bf16x8*)(X.PROJ() + (rowbase + tq[j]) * NPROJ + C_AQ + 64 * (4 * kvh + j) + 32 * kk + 8 * lg);
#pragma unroll
    for (int dt = 0; dt < 4; ++dt) o[j][dt] = (f32x4){0.f, 0.f, 0.f, 0.f}; }
  const int kbase = q0 - 128;
  SrcProj src{X.PROJ(), rowbase + kbase, C_AK + 64 * kvh, C_AV + 64 * kvh};
  const float c = 0.125f * LOG2E;
  attn_block_loop<4, 64, 64, MODE_WINDOW, 2, SrcProj>(lds, src, o, m, l, qf, tq, q0 == 0 ? 2 : 0, 4, kbase, qw, qw + 15, c, 128);
#pragma unroll
  for (int j = 0; j < 4; ++j) { const float lt = lsum4(l[j]); const float inv = lt > 0.f ? 1.0f / lt : 0.f;
#pragma unroll
    for (int dt = 0; dt < 4; ++dt) store4(X.OA() + (rowbase + tq[j]) * 512 + 64 * (4 * kvh + j) + 16 * dt + 4 * lg, o[j][dt], inv); }
}

struct SrcCmp { const bf16_t* k; const bf16_t* v;
  __device__ __forceinline__ const bf16_t* kaddr(int krow, int ch) const { return k + (size_t)krow * 64 + 8 * ch; }
  __device__ __forceinline__ const bf16_t* vaddr(int krow, int ch) const { return v + (size_t)krow * 64 + 8 * ch; } };
constexpr int NSA_BUF = 2 * (64 * 144 + 64 * 160);
constexpr int NSA_IMP = 16 * 132 * 4;
static_assert(NSA_BUF + 8 * NSA_IMP <= LDS_BYTES, "nsa lds");

template <bool MASK>
__device__ __forceinline__ void cmp_imp_chunk(const bf16x8 (&qf)[4][2], LAS const unsigned char* Kl, int kpos0, int tq, const float (&mc)[4], const float (&inv)[4], float c,
                                              float& carry_prev, LAS float* imp_row, int lane) {
  const int r = lane & 15, lg = lane >> 4; const int src = (lane + 48) & 63;
#pragma unroll
  for (int st = 0; st < 2; ++st)
#pragma unroll
    for (int t = 0; t < 2; ++t) {
      f32x4 s[4];
#pragma unroll
      for (int kk = 0; kk < 2; ++kk) { const bf16x8 kf = *(LAS const bf16x8*)(Kl + (32 * st + 16 * t + r) * 144 + (32 * kk + 8 * lg) * 2);
#pragma unroll
        for (int j = 0; j < 4; ++j) s[j] = mfma16(kf, qf[j][kk], kk == 0 ? (f32x4){0.f, 0.f, 0.f, 0.f} : s[j]); }
      float ps[4];
#pragma unroll
      for (int i = 0; i < 4; ++i) { const int kp = kpos0 + 32 * st + 16 * t + 4 * lg + i; float a = 0.f;
#pragma unroll
        for (int j = 0; j < 4; ++j) a += ex2(s[j][i] * c - mc[j]) * inv[j];
        ps[i] = (!MASK || (16 * kp + 31 <= tq)) ? a : 0.f; }
      const float own = 2.0f * (ps[0] + ps[1] + ps[2]) + ps[3];
      const float up_same = __shfl(ps[3], src), up_prev = __shfl(carry_prev, src);
      const float cin = lg > 0 ? up_same : up_prev;
      carry_prev = ps[3];
      imp_row[((kpos0 + 32 * st + 16 * t) >> 2) + lg] = own + cin;
    }
}

__device__ __forceinline__ void nsa_unit(LAS unsigned char* lds, const Ctx& X, bf16_t* OB, int b, int g, int qb) {
  const int tid = otid(), lane = tid & 63, w = __builtin_amdgcn_readfirstlane(tid >> 6);
#define cq ((otid() & 63) & 15)
#define lg ((otid() & 63) >> 4)
  const size_t rowbase = (size_t)b * S; const int q0 = qb * 128, qw = q0 + 16 * w;
#define tqc (qw + cq)
#define myrow (rowbase + (size_t)tqc)
  const float c = 0.125f * LOG2E;
  LAS float* impw = (LAS float*)(lds + NSA_BUF + w * NSA_IMP);
  int tq[4];
#pragma unroll
  for (int j = 0; j < 4; ++j) tq[j] = tqc;
  for (int i = lane; i < 16 * 132; i += 64) impw[i] = 0.f;
#ifndef NSA_NO_A
  {
    bf16x8 qf[4][2]; f32x4 o[4][4]; float m[4], l[4];
#pragma unroll
    for (int j = 0; j < 4; ++j) { m[j] = -INFINITY; l[j] = 0.f;
#pragma unroll
      for (int kk = 0; kk < 2; ++kk) qf[j][kk] = *(const bf16x8*)(X.PROJ() + myrow * NPROJ + C_BQ + 64 * (4 * g + j) + 32 * kk + 8 * lg);
#pragma unroll
      for (int dt = 0; dt < 4; ++dt) o[j][dt] = (f32x4){0.f, 0.f, 0.f, 0.f}; }
    SrcCmp src{X.KCMP() + (size_t)(b * 2 + g) * 512 * 64, X.VCMP() + (size_t)(b * 2 + g) * 512 * 64};
    const int ncb = 8 * qb + 7, nch = (ncb + 63) >> 6;
    attn_block_loop<4, 64, 64, MODE_CMP, 1, SrcCmp>(lds, src, o, m, l, qf, tq, 0, nch, 0, qw, qw + 15, c, 0);
    float mc[4], inv[4];
#pragma unroll
    for (int j = 0; j < 4; ++j) { const float lt = lsum4(l[j]); inv[j] = lt > 0.f ? 1.0f / lt : 0.f; mc[j] = ((m[j] == -INFINITY) ? 0.f : m[j]) * c;
      const float g0 = sigmoidf_(bf2f(X.PROJ()[myrow * NPROJ + C_BG + 3 * (4 * g + j) + 0])); const float sc = inv[j] * g0;
#pragma unroll
      for (int dt = 0; dt < 4; ++dt) store4(OB + myrow * 512 + 64 * (4 * g + j) + 16 * dt + 4 * lg, o[j][dt], sc); }
    {
      constexpr int KB = 64 * 144, BUF = KB + 64 * 160;
      float carry = 0.f;
      u32x4 kreg;
      { const int row = tid >> 3, ch = tid & 7; kreg = *(const u32x4*)src.kaddr(row, ch); }
      for (int kc = 0; kc < nch; ++kc) {
        LAS unsigned char* buf = lds + (kc & 1) * BUF;
        { const int row = tid >> 3, ch = tid & 7; *(LAS u32x4*)(buf + row * 144 + ch * 16) = kreg; if (kc + 1 < nch) kreg = *(const u32x4*)src.kaddr((kc + 1) * 64 + row, ch); }
        LBAR();
        const int lo = 64 * kc, hi = lo + 63;
        const bool rel = 16 * lo + 31 <= qw + 15, full = 16 * hi + 31 <= qw;
        if (rel) { if (full) cmp_imp_chunk<false>(qf, buf, lo, tqc, mc, inv, c, carry, impw + cq * 132, lane);
                   else cmp_imp_chunk<true>(qf, buf, lo, tqc, mc, inv, c, carry, impw + cq * 132, lane); }
      }
      LBAR();
    }
  }
#endif
#ifndef NSA_NO_C
  {
    for (int idx = lane; idx < 16 * 128; idx += 64) { const int q = idx >> 7, j = idx & 127; const int t = qw + q, cur = t >> 6;
      const float v = impw[q * 132 + j]; const bool forced = (j == 0) || (j == cur) || (j == cur - 1);
      impw[q * 132 + j] = (j > cur) ? -INFINITY : v + (forced ? 1e4f : 0.f); }
    LWAIT();
    for (int idx = lane; idx < 16 * 128; idx += 64) { const int qq = idx >> 7, j = idx & 127; const unsigned u = __float_as_uint(impw[qq * 132 + j]);
      const unsigned ok = (u & 0x80000000u) ? ~u : (u | 0x80000000u); ((LAS unsigned*)impw)[qq * 132 + j] = (ok & ~127u) | (unsigned)(127 - j); }
    LWAIT();
    const int q = lane >> 2, part = lane & 3;
    unsigned sj[32];
    LAS const unsigned* keyw = (LAS const unsigned*)impw;
#pragma unroll
    for (int jj = 0; jj < 32; ++jj) sj[jj] = keyw[q * 132 + 32 * part + jj];
    unsigned thr = 0u;
#pragma unroll 1
    for (int bit = 31; bit >= 0; --bit) {
      const unsigned cand = thr | (1u << bit); int cn = 0;
#pragma unroll
      for (int jj = 0; jj < 32; ++jj) cn += (sj[jj] >= cand) ? 1 : 0;
      cn += __shfl_xor(cn, 1); cn += __shfl_xor(cn, 2);
      thr = (cn >= 16) ? cand : thr;
    }
    int mine = 0;
#pragma unroll
    for (int jj = 0; jj < 32; ++jj) mine += (sj[jj] >= thr) ? 1 : 0;
    const int c0 = __shfl(mine, (lane & ~3) + 0), c1 = __shfl(mine, (lane & ~3) + 1), c2 = __shfl(mine, (lane & ~3) + 2);
    int slot = (part > 0 ? c0 : 0) + (part > 1 ? c1 : 0) + (part > 2 ? c2 : 0);
    unsigned char* sell = X.SELL() + ((rowbase + qw + q) * 2 + g) * 16;
#pragma unroll
    for (int jj = 0; jj < 32; ++jj) if (sj[jj] >= thr) { sell[slot] = (unsigned char)((32 * part + jj) | (((sj[jj] & ~127u) == 0x007FFF80u) ? 128 : 0)); ++slot; }
    LWAIT();
  }
#endif
#ifndef NSA_NO_E

  {
    bf16x8 qf[4][2]; f32x4 o[4][4]; float m[4], l[4];
#pragma unroll
    for (int j = 0; j < 4; ++j) { m[j] = -INFINITY; l[j] = 0.f;
#pragma unroll
      for (int kk = 0; kk < 2; ++kk) qf[j][kk] = *(const bf16x8*)(X.QROT() + myrow * 512 + 64 * (4 * g + j) + 32 * kk + 8 * lg);
#pragma unroll
      for (int dt = 0; dt < 4; ++dt) o[j][dt] = (f32x4){0.f, 0.f, 0.f, 0.f}; }
    const int kbase = q0 - 512;
    SrcProj src{X.PROJ(), rowbase + kbase, C_BKW + 64 * g, C_BVW + 64 * g};
    const int kc0 = kbase < 0 ? (-kbase) >> 6 : 0;
    attn_block_loop<4, 64, 64, MODE_WINDOW, 1, SrcProj>(lds, src, o, m, l, qf, tq, kc0, 10, kbase, qw, qw + 15, c, 512);
#pragma unroll
    for (int j = 0; j < 4; ++j) { const float lt = lsum4(l[j]); const float inv = lt > 0.f ? 1.0f / lt : 0.f;
      const float g2 = sigmoidf_(bf2f(X.PROJ()[myrow * NPROJ + C_BG + 3 * (4 * g + j) + 2])); const float sc = inv * g2;
#pragma unroll
      for (int dt = 0; dt < 4; ++dt) store4(X.OW() + myrow * 512 + 64 * (4 * g + j) + 16 * dt + 4 * lg, o[j][dt], sc); }
  }
#endif
  LBAR();
}
#undef cq
#undef lg
#undef tqc
#undef myrow

struct SelFrag { u32x4 kf[4]; u32x4 vf[4]; };
__device__ __forceinline__ void sel_load(SelFrag& F, const bf16_t* kst, const bf16_t* vst, int blk, int cq, int lg) {
  const unsigned char* kp = (const unsigned char*)kst + (size_t)blk * 4096 + (cq * 4 + lg) * 16;
  const unsigned char* vp = (const unsigned char*)vst + (size_t)blk * 4096 + (cq * 4 + lg) * 16;
#pragma unroll
  for (int t4 = 0; t4 < 4; ++t4) F.kf[t4] = *(const u32x4*)(kp + t4 * 1024);
#pragma unroll
  for (int dt = 0; dt < 4; ++dt) F.vf[dt] = *(const u32x4*)(vp + dt * 1024);
}
__device__ __forceinline__ void sel_compute(const SelFrag& F, const long (&qs)[2], f32x4 (&os)[4], float& m, float& l, int blk, int cur, int t, int lg, float c) {
  f32x4 s[4];
#pragma unroll
  for (int t4 = 0; t4 < 4; ++t4) { s[t4] = mfma16_fp8(as_long(F.kf[t4].x, F.kf[t4].y), qs[0], (f32x4){0.f, 0.f, 0.f, 0.f}); s[t4] = mfma16_fp8(as_long(F.kf[t4].z, F.kf[t4].w), qs[1], s[t4]); }
  float mx = -INFINITY;
#pragma unroll
  for (int t4 = 0; t4 < 4; ++t4)
#pragma unroll
    for (int i = 0; i < 4; ++i) { if (blk == cur) { const int key = 64 * blk + 16 * t4 + 4 * lg + i; if (key > t) s[t4][i] = -INFINITY; } mx = fmaxf(mx, s[t4][i]); }
  mx = max_x16_x32(mx);
  if (__any(mx > m + 8.0f / c)) {
    const float mnew = fmaxf(m, mx), ms2 = (mnew == -INFINITY) ? 0.f : mnew, alpha = ex2((m - ms2) * c);
    m = mnew; l *= alpha;
#pragma unroll
    for (int dt = 0; dt < 4; ++dt) os[dt] *= alpha;
  }
  const float mcc = ((m == -INFINITY) ? 0.f : m) * c;
  float p[4][4], ps = 0.f;
#pragma unroll
  for (int t4 = 0; t4 < 4; ++t4)
#pragma unroll
    for (int i = 0; i < 4; ++i) { p[t4][i] = ex2(s[t4][i] * c - mcc); ps += p[t4][i]; }
  l += ps;
  const u32x2 pa = pack8_fp8(p[0], p[1]), pb = pack8_fp8(p[2], p[3]);
  const long pf0 = as_long(pa.x, pa.y), pf1 = as_long(pb.x, pb.y);
#pragma unroll
  for (int dt = 0; dt < 4; ++dt) { os[dt] = mfma16_fp8(as_long(F.vf[dt].x, F.vf[dt].y), pf0, os[dt]); os[dt] = mfma16_fp8(as_long(F.vf[dt].z, F.vf[dt].w), pf1, os[dt]); }
}
__device__ __forceinline__ int sel_slot(const u32x4& sl, int slot) {
  const unsigned wsel = slot < 4 ? sl.x : slot < 8 ? sl.y : slot < 12 ? sl.z : sl.w;
  return __builtin_amdgcn_readfirstlane((int)((wsel >> (8 * (slot & 3))) & 127u));
}
__device__ __forceinline__ void nsa_sel_phase(const Ctx& X, bf16_t* OBp) {
  const int tid = otid(), lane = tid & 63, cq = lane & 15, lg = lane >> 4, hcol = lane & 3;
  const int w = __builtin_amdgcn_readfirstlane(tid >> 6);
  const float c = 0.125f * LOG2E;
  const bool xmap = (X.G % 8) == 0;
  const int npw = xmap ? (X.G / 8) * 8 : X.G * 8;
  const int wi = xmap ? (X.blk / 8) * 8 + w : X.blk * 8 + w;
  const int ntask = xmap ? S : T * 2;
#define SEL_DECODE(kk_, b_, g_, t_) do { if (xmap) { const int pr = X.blk & 7; b_ = pr >> 1; g_ = pr & 1; t_ = (kk_); } else { const int rowi = (kk_) >> 1; g_ = (kk_) & 1; b_ = rowi >> 13; t_ = rowi & 8191; } } while (0)
  int k = wi;
  if (k >= ntask) return;
  SelFrag FA, FB;
  u32x4 sl, sln;
  { int b, g, t; SEL_DECODE(k, b, g, t); sl = *(const u32x4*)(X.SELL() + (((size_t)b * S + t) * 2 + g) * 16); sln = sl;
    sel_load(FA, (const bf16_t*)((const unsigned char*)X.KST() + (size_t)(b * 2 + g) * 128 * 4096), (const bf16_t*)((const unsigned char*)X.VST() + (size_t)(b * 2 + g) * 128 * 4096), sel_slot(sl, 0), cq, lg); }
  for (; k < ntask; k += npw) {
    int b, g, t; SEL_DECODE(k, b, g, t);
    const int cur = t >> 6; const int nv = cur + 1 < 16 ? cur + 1 : 16;
    const size_t rowbase = (size_t)b * S, row = rowbase + t;
    const bf16_t* projk = (const bf16_t*)((const unsigned char*)X.KST() + (size_t)(b * 2 + g) * 128 * 4096);
    const bf16_t* vst = (const bf16_t*)((const unsigned char*)X.VST() + (size_t)(b * 2 + g) * 128 * 4096);
    const int kn = k + npw; int bn = b, gn = g, tn = t;
    if (kn < ntask) { SEL_DECODE(kn, bn, gn, tn); sln = *(const u32x4*)(X.SELL() + (((size_t)bn * S + tn) * 2 + gn) * 16); }
    long qs[2];
#pragma unroll
    for (int kk = 0; kk < 2; ++kk) { const u32x4 qw4 = *(const u32x4*)(X.QROT() + row * 512 + 64 * (4 * g + hcol) + 32 * kk + 8 * lg);
      const float a4[4] = {bflo(qw4.x), bfhi(qw4.x), bflo(qw4.y), bfhi(qw4.y)}, b4[4] = {bflo(qw4.z), bfhi(qw4.z), bflo(qw4.w), bfhi(qw4.w)};
      const u32x2 q8 = pack8_fp8(a4, b4); qs[kk] = as_long(q8.x, q8.y); }
    float m = -INFINITY, l = 0.f; f32x4 os[4];
#pragma unroll
    for (int dt = 0; dt < 4; ++dt) os[dt] = (f32x4){0.f, 0.f, 0.f, 0.f};
    int blkA = sel_slot(sl, 0), blkB = 0;
    for (int sidx = 0; sidx < nv; sidx += 2) {
      const bool hasB = sidx + 1 < nv;
      if (hasB) { blkB = sel_slot(sl, sidx + 1); sel_load(FB, projk, vst, blkB, cq, lg); }
      sel_compute(FA, qs, os, m, l, blkA, cur, t, lg, c);
      if (hasB) {
        if (sidx + 2 < nv) { blkA = sel_slot(sl, sidx + 2); sel_load(FA, projk, vst, blkA, cq, lg); }
        sel_compute(FB, qs, os, m, l, blkB, cur, t, lg, c);
      }
    }
    if (kn < ntask) sel_load(FA, (const bf16_t*)((const unsigned char*)X.KST() + (size_t)(bn * 2 + gn) * 128 * 4096), (const bf16_t*)((const unsigned char*)X.VST() + (size_t)(bn * 2 + gn) * 128 * 4096), sel_slot(sln, 0), cq, lg);
    const float lt = lsum4(l); const float inv = lt > 0.f ? 1.0f / lt : 0.f;
    const float g1 = sigmoidf_(bf2f(X.PROJ()[row * NPROJ + C_BG + 3 * (4 * g + hcol) + 1]));
    if (cq < 4) {
      const float sc = inv * g1;
#pragma unroll
      for (int dt = 0; dt < 4; ++dt) { const size_t off = row * 512 + 64 * (4 * g + cq) + 16 * dt + 4 * lg;
        const u32x2 a = *(const u32x2*)(OBp + off), w2 = *(const u32x2*)(X.OW() + off);
        f32x4 v = os[dt] * sc; v[0] += bflo(a.x) + bflo(w2.x); v[1] += bfhi(a.x) + bfhi(w2.x); v[2] += bflo(a.y) + bflo(w2.y); v[3] += bfhi(a.y) + bfhi(w2.y);
        store4(OBp + off, v, 1.0f); }
    }
    sl = sln;
  }
#undef SEL_DECODE
}

__device__ __forceinline__ void nsa_compress_task(LAS unsigned char* lds, const Ctx& X, const float* pe_k, const float* pe_v, int task) {
  const int tid = otid(), lane = tid & 63, w = __builtin_amdgcn_readfirstlane(tid >> 6), r = lane & 15, lg = lane >> 4;
  const int kind = task >> 8, rem = task & 255, b = rem >> 6, g = (rem >> 5) & 1, c0 = (rem & 31) * 16;
  const float* pe = kind ? pe_v : pe_k; const bf16_t* w1 = X.W() + (kind ? W_V1 : W_K1); const bf16_t* w2 = X.W() + (kind ? W_V2 : W_K2);
  const int col = (kind ? C_BVC : C_BKC) + 64 * g;
  LAS float* red = (LAS float*)lds;
  LAS bf16_t* h1 = (LAS bf16_t*)(lds + 8 * 16 * 64 * 4);
  f32x4 acc[4];
#pragma unroll
  for (int nt = 0; nt < 4; ++nt) acc[nt] = (f32x4){0.f, 0.f, 0.f, 0.f};
  const int cmy = c0 + r;
#pragma unroll 2
  for (int k8 = 0; k8 < 8; ++k8) { const int kk = 8 * w + k8; const int lt = kk >> 1, d = (kk & 1) * 32 + 8 * lg;
    int tok = 16 * cmy + lt; tok = tok > S - 1 ? S - 1 : tok;
    const u32x4 kv = *(const u32x4*)(X.PROJ() + ((size_t)b * S + tok) * NPROJ + col + d);
    const f32x4 pa = *(const f32x4*)(pe + lt * 64 + d), pb = *(const f32x4*)(pe + lt * 64 + d + 4);
    u32x4 aw; aw.x = cvt_pk_bf16(bflo(kv.x) + pa[0], bfhi(kv.x) + pa[1]); aw.y = cvt_pk_bf16(bflo(kv.y) + pa[2], bfhi(kv.y) + pa[3]);
    aw.z = cvt_pk_bf16(bflo(kv.z) + pb[0], bfhi(kv.z) + pb[1]); aw.w = cvt_pk_bf16(bflo(kv.w) + pb[2], bfhi(kv.w) + pb[3]);
    const bf16x8 af = __builtin_bit_cast(bf16x8, aw);
#pragma unroll
    for (int nt = 0; nt < 4; ++nt) { const bf16x8 bfr = *(const bf16x8*)(w1 + (size_t)(16 * nt + r) * 2048 + 32 * kk + 8 * lg); acc[nt] = mfma16(af, bfr, acc[nt]); }
  }
#pragma unroll
  for (int nt = 0; nt < 4; ++nt)
#pragma unroll
    for (int i = 0; i < 4; ++i) red[(w * 16 + 4 * lg + i) * 64 + 16 * nt + r] = acc[nt][i];
  LBAR();
  for (int e = tid; e < 1024; e += 512) { float sacc = 0.f;
#pragma unroll
    for (int ww = 0; ww < 8; ++ww) sacc += red[ww * 1024 + e];
    const float hval = sacc * sigmoidf_(sacc); h1[(e >> 6) * 72 + (e & 63)] = (bf16_t)(cvt_pk_bf16(hval, 0.f) & 0xffffu); }
  LBAR();
  if (w == 0) {
    f32x4 o2[4];
#pragma unroll
    for (int nt = 0; nt < 4; ++nt) o2[nt] = (f32x4){0.f, 0.f, 0.f, 0.f};
#pragma unroll
    for (int kk = 0; kk < 2; ++kk) { const bf16x8 af = *(LAS const bf16x8*)(h1 + r * 72 + 32 * kk + 8 * lg);
#pragma unroll
      for (int nt = 0; nt < 4; ++nt) { const bf16x8 bfr = *(const bf16x8*)(w2 + (16 * nt + r) * 64 + 32 * kk + 8 * lg); o2[nt] = mfma16(af, bfr, o2[nt]); } }
    bf16_t* dst = (kind ? X.VCMP() : X.KCMP()) + ((size_t)(b * 2 + g) * 512 + c0) * 64;
#pragma unroll
    for (int nt = 0; nt < 4; ++nt)
#pragma unroll
      for (int i = 0; i < 4; ++i) dst[(4 * lg + i) * 64 + 16 * nt + r] = (bf16_t)(cvt_pk_bf16(o2[nt][i], 0.f) & 0xffffu);
  }
  LBAR();
}

__device__ __forceinline__ void rms_row_bf16(const float* xrow, const float* gain, bf16_t* orow, int lane) {
  const f32x4* xr = (const f32x4*)xrow + lane; const f32x4* gr = (const f32x4*)gain + lane;
  f32x4 v[4]; float s = 0.f;
#pragma unroll
  for (int j = 0; j < 4; ++j) { v[j] = xr[64 * j]; s += (v[j].x * v[j].x + v[j].y * v[j].y) + (v[j].z * v[j].z + v[j].w * v[j].w); }
  const float rstd = 1.0f / sqrtf(wave_sum(s) * (1.f / 1024.f) + NORM_EPS);
  u32x2* o8 = (u32x2*)orow + lane;
#pragma unroll
  for (int j = 0; j < 4; ++j) { const f32x4 gg = gr[64 * j]; u32x2 wv; wv.x = cvt_pk_bf16(v[j].x * rstd * gg.x, v[j].y * rstd * gg.y); wv.y = cvt_pk_bf16(v[j].z * rstd * gg.z, v[j].w * rstd * gg.w); o8[64 * j] = wv; }
}
__device__ __forceinline__ void rms_phase(const Ctx& X, const float* src, const float* gain, bf16_t* dst, int rows) {
  const int tid_ = otid(); const int lane = tid_ & 63, gw = X.blk * 8 + (tid_ >> 6), NGW = X.G * 8;
  for (int mrow = gw; mrow < rows; mrow += NGW) rms_row_bf16(src + (size_t)mrow * 1024, gain, dst + (size_t)mrow * 1024, lane);
}
__device__ __forceinline__ void xb_prepass(const Ctx& X, const float* src) {
  const int tid_ = otid(); const int lane = tid_ & 63, gw = X.blk * 8 + (tid_ >> 6), NGW = X.G * 8;
  for (int mrow = gw; mrow < T; mrow += NGW) {
    const f32x4* xr = (const f32x4*)(src + (size_t)mrow * 1024) + lane; u32x2* o8 = (u32x2*)(X.H() + (size_t)mrow * 1024) + lane; float sacc = 0.f;
#pragma unroll
    for (int j = 0; j < 4; ++j) { const f32x4 v = xr[64 * j]; sacc += (v.x * v.x + v.y * v.y) + (v.z * v.z + v.w * v.w); u32x2 wv; wv.x = cvt_pk_bf16(v.x, v.y); wv.y = cvt_pk_bf16(v.z, v.w); o8[64 * j] = wv; }
    sacc = wave_sum(sacc);
    if (lane == 0) *(f32x4*)(X.RSS() + (size_t)mrow * 4) = (f32x4){sacc, 0.f, 0.f, 0.f};
  }
}
__device__ __forceinline__ void final_norm_phase(const Ctx& X, const float* gain) {
  const int tid_ = otid(); const int lane = tid_ & 63, gw = X.blk * 8 + (tid_ >> 6), NGW = X.G * 8;
  for (int mrow = gw; mrow < T; mrow += NGW) {
    f32x4* xr = (f32x4*)(X.out + (size_t)mrow * 1024) + lane; const f32x4* gr = (const f32x4*)gain + lane;
    f32x4 v[4]; float s = 0.f;
#pragma unroll
    for (int j = 0; j < 4; ++j) { v[j] = xr[64 * j]; s += (v[j].x * v[j].x + v[j].y * v[j].y) + (v[j].z * v[j].z + v[j].w * v[j].w); }
    const float rstd = 1.0f / sqrtf(wave_sum(s) * (1.f / 1024.f) + NORM_EPS);
#pragma unroll
    for (int j = 0; j < 4; ++j) { const f32x4 gg = gr[64 * j]; xr[64 * j] = (f32x4){v[j].x * rstd * gg.x, v[j].y * rstd * gg.y, v[j].z * rstd * gg.z, v[j].w * rstd * gg.w}; }
  }
}
__device__ __forceinline__ void mla_norm_phase(const Ctx& X, const float* qg, const float* kvg) {
  const int tid_ = otid(); const int lane = tid_ & 63, gw = X.blk * 8 + (tid_ >> 6), NGW = X.G * 8;
  for (int mrow = gw; mrow < T; mrow += NGW) {
    bf16_t* pr = X.PROJ() + (size_t)mrow * NPROJ;
    u32x4 a = (u32x4){0, 0, 0, 0}, bq = (u32x4){0, 0, 0, 0};
    if (lane < 48) a = *(const u32x4*)(pr + C_CQA + 8 * lane);
    if (lane < 32) bq = *(const u32x4*)(pr + C_CKV + 8 * lane);
    float fa[8] = {bflo(a.x), bfhi(a.x), bflo(a.y), bfhi(a.y), bflo(a.z), bfhi(a.z), bflo(a.w), bfhi(a.w)};
    float fb[8] = {bflo(bq.x), bfhi(bq.x), bflo(bq.y), bfhi(bq.y), bflo(bq.z), bfhi(bq.z), bflo(bq.w), bfhi(bq.w)};
    float sa = 0.f, sb = 0.f;
#pragma unroll
    for (int e = 0; e < 8; ++e) { sa += fa[e] * fa[e]; sb += fb[e] * fb[e]; }
    const float ra = 1.0f / sqrtf(wave_sum(sa) * (1.f / 384.f) + NORM_EPS), rb = 1.0f / sqrtf(wave_sum(sb) * (1.f / 256.f) + NORM_EPS);
    if (lane < 48) { const f32x4 g0 = *(const f32x4*)(qg + 8 * lane), g1 = *(const f32x4*)(qg + 8 * lane + 4); u32x4 wv;
      wv.x = cvt_pk_bf16(fa[0] * ra * g0[0], fa[1] * ra * g0[1]); wv.y = cvt_pk_bf16(fa[2] * ra * g0[2], fa[3] * ra * g0[3]);
      wv.z = cvt_pk_bf16(fa[4] * ra * g1[0], fa[5] * ra * g1[1]); wv.w = cvt_pk_bf16(fa[6] * ra * g1[2], fa[7] * ra * g1[3]); *(u32x4*)(pr + C_CQA + 8 * lane) = wv; }
    if (lane < 32) { const f32x4 g0 = *(const f32x4*)(kvg + 8 * lane), g1 = *(const f32x4*)(kvg + 8 * lane + 4); u32x4 wv;
      wv.x = cvt_pk_bf16(fb[0] * rb * g0[0], fb[1] * rb * g0[1]); wv.y = cvt_pk_bf16(fb[2] * rb * g0[2], fb[3] * rb * g0[3]);
      wv.z = cvt_pk_bf16(fb[4] * rb * g1[0], fb[5] * rb * g1[1]); wv.w = cvt_pk_bf16(fb[6] * rb * g1[2], fb[7] * rb * g1[3]); *(u32x4*)(pr + C_CKV + 8 * lane) = wv; }
  }
}

__device__ __forceinline__ void sincos_precise(float a, float& cs, float& sn) {
  const double x = (double)a; const double k = rint(x * 0.63661977236758134308);
  double rr = fma(-k, 1.57079632679489655800e+00, x); rr = fma(-k, 6.12323399573676603587e-17, rr);
  const double r2 = rr * rr;
  double sp = -1.0 / 1307674368000.0; sp = sp * r2 + 1.0 / 6227020800.0; sp = sp * r2 - 1.0 / 39916800.0; sp = sp * r2 + 1.0 / 362880.0; sp = sp * r2 - 1.0 / 5040.0; sp = sp * r2 + 1.0 / 120.0; sp = sp * r2 - 1.0 / 6.0; sp = sp * r2 + 1.0;
  const double sv = sp * rr;
  double cp = 1.0 / 87178291200.0; cp = cp * r2 - 1.0 / 479001600.0; cp = cp * r2 + 1.0 / 3628800.0; cp = cp * r2 - 1.0 / 40320.0; cp = cp * r2 + 1.0 / 720.0; cp = cp * r2 - 1.0 / 24.0; cp = cp * r2 + 0.5; const double cv = 1.0 - cp * r2;
  const int q = ((int)(long long)k) & 3;
  const double c2 = (q == 0) ? cv : (q == 1) ? -sv : (q == 2) ? -cv : sv;
  const double s2 = (q == 0) ? sv : (q == 1) ? cv : (q == 2) ? -sv : -cv;
  cs = (float)c2; sn = (float)s2;
}
__device__ __forceinline__ void tables_phase(const Ctx& X, const Params& P) {
  const int* pos = (const int*)X.in[2];
  const int gt = X.blk * 512 + otid(), NG = X.G * 512;
  for (int idx = gt; idx < T * 48; idx += NG) {
    const int row = idx / 48, i = idx % 48; const float pf = (float)pos[row];
    float cs, sn;
    if (i < 32) { sincos_precise(pf * P.invf64[i], cs, sn); X.CS64()[(size_t)row * 32 + i] = (f32x2){cs, sn}; }
    else { sincos_precise(pf * P.invf32[i - 32], cs, sn); X.CS32()[(size_t)row * 16 + (i - 32)] = (f32x2){cs, sn}; }
  }
}

enum { CM_ID = 0, CM_INPROJ = 1, CM_QB = 2, CM_GU = 3, CM_IL64 = 4 };
__device__ __forceinline__ int colmap(int kind, int n, int off) {
  if (kind == CM_ID) return off + n;
  if (kind == CM_INPROJ) {
    if (n < 2048) { const int sg = n >> 7; const bool il = (sg <= 4) || (sg >= 6 && sg <= 9) || sg == 12 || sg == 14;
      if (!il) return n; const int hb = n & ~63, o = n & 63; return hb + (o >> 1) + 32 * (o & 1); }
    if (n < 2432) return 2072 + (n - 2048);
    if (n < 2688) return 2456 + (n - 2432);
    if (n < 2720) { const int o = n - 2688; return 2712 + (o >> 1) + 16 * (o & 1); }
    if (n < 2744) return 2048 + (n - 2720);
    return -1;
  }
  if (kind == CM_QB) { const int h = n / 96, o = n % 96; if (o < 64) return n; const int oo = o - 64; return 96 * h + 64 + (oo >> 1) + 16 * (oo & 1); }
  if (kind == CM_GU) { const int j = n >> 3, e = n & 7; return e < 4 ? 4 * j + e : DFF + 4 * j + (e - 4); }
    { const int o = n & 63; return (n & ~63) + (o >> 1) + 32 * (o & 1); }
}
struct WDesc { const float* src; int K, pitch, N, kind, off; size_t dst; };
__device__ __forceinline__ void wconv_tile(LAS float* tl, const WDesc& d, bf16_t* Wb, int tile, const float* gain) {
  const int tid = otid(); const int nb = d.N >> 6; const int kb = tile / nb, nbi = tile % nb; const int k0 = kb * 64, n0 = nbi * 64;
  { const int nn = tid & 63; const int sc = colmap(d.kind, n0 + nn, d.off);
#pragma unroll
    for (int rr = 0; rr < 8; ++rr) { const int kk = (tid >> 6) + 8 * rr; tl[kk * 65 + nn] = sc >= 0 ? d.src[(size_t)(k0 + kk) * d.pitch + sc] * (gain ? gain[k0 + kk] : 1.0f) : 0.f; } }
  LBAR();
  { const int kp = tid & 31;
#pragma unroll
    for (int rr = 0; rr < 4; ++rr) { const int nn = (tid >> 5) + 16 * rr; const unsigned wv = cvt_pk_bf16(tl[(2 * kp) * 65 + nn], tl[(2 * kp + 1) * 65 + nn]);
      *(unsigned*)(Wb + d.dst + (size_t)(n0 + nn) * d.K + k0 + 2 * kp) = wv; } }
  LBAR();
}
__device__ __forceinline__ WDesc wdesc(const float* const* in, size_t L, int i) {
  switch (i) {
    case 0: return WDesc{in[4] + L * 1024 * DIN, 1024, DIN, NPROJ, CM_INPROJ, 0, W_IN};
    case 1: return WDesc{in[4] + L * 1024 * DIN, 1024, DIN, NGATE, CM_ID, 2744, W_G};
    case 2: return WDesc{in[13] + L * 384 * 768, 384, 768, 768, CM_QB, 0, W_QB};
    case 3: return WDesc{in[15] + L * 256 * 1024, 256, 1024, 1024, CM_ID, 0, W_KVB};
    case 4: return WDesc{in[16] + L * 512 * 1024, 512, 1024, 1024, CM_ID, 0, W_BR};
    case 5: return WDesc{in[17] + L * 512 * 1024, 512, 1024, 1024, CM_ID, 0, W_BR + 1024 * 512};
    case 6: return WDesc{in[18] + L * 512 * 1024, 512, 1024, 1024, CM_ID, 0, W_BR + 2 * 1024 * 512};
    case 7: return WDesc{in[19] + L * 1024 * 1024, 1024, 1024, 1024, CM_ID, 0, W_OUT};
    case 8: return WDesc{in[22] + L * 1024 * 512, 1024, 512, 512, CM_ID, 0, W_XQ};
    case 9: return WDesc{in[23] + L * 1024 * 1024, 1024, 1024, 1024, CM_ID, 0, W_XKV};
    case 10: return WDesc{in[24] + L * 512 * 1024, 512, 1024, 1024, CM_ID, 0, W_XO};
    case 11: return WDesc{in[26] + L * 1024 * NGU, 1024, NGU, NGU, CM_GU, 0, W_GU};
    case 12: return WDesc{in[27] + L * DFF * 1024, DFF, 1024, 1024, CM_ID, 0, W_DOWN};
    case 13: return WDesc{in[8] + L * 2048 * 64, 2048, 64, 64, CM_ID, 0, W_K1};
    case 14: return WDesc{in[10] + L * 2048 * 64, 2048, 64, 64, CM_ID, 0, W_V1};
    case 15: return WDesc{in[9] + L * 64 * 64, 64, 64, 64, CM_IL64, 0, W_K2};
    default: return WDesc{in[11] + L * 64 * 64, 64, 64, 64, CM_ID, 0, W_V2};
  }
}
__device__ __forceinline__ int wtiles(int i) {
  constexpr int tl[17] = {16 * 44, 16 * 48, 6 * 12, 4 * 16, 8 * 16, 8 * 16, 8 * 16, 16 * 16, 16 * 8, 16 * 16, 8 * 16, 16 * 88, 44 * 16, 32, 32, 1, 1};
  int r = 0;
#pragma unroll
  for (int k = 0; k < 17; ++k) r = (i == k) ? tl[k] : r;
  return r;
}
__device__ __forceinline__ void wconv_phase(LAS unsigned char* lds, const Ctx& X, int layer) {
  constexpr int TOTAL = 16 * 44 + 16 * 48 + 6 * 12 + 4 * 16 + 3 * 8 * 16 + 16 * 16 + 16 * 8 + 16 * 16 + 8 * 16 + 16 * 88 + 44 * 16 + 32 + 32 + 1 + 1;
  for (int t = X.blk; t < TOTAL; t += X.G) {
    int rem = t, mi = 0;
#pragma unroll 1
    for (; mi < 16; ++mi) { const int n = wtiles(mi); if (rem < n) break; rem -= n; }
    const WDesc d = wdesc(X.in, (size_t)layer, mi);
    const int gi = (mi <= 1) ? 3 : (mi == 8) ? 20 : (mi == 11) ? 25 : -1;
    const float* gain = gi >= 0 ? X.in[gi] + (size_t)layer * 1024 : nullptr;
    wconv_tile((LAS float*)lds, d, X.W(), rem, gain);
  }
}

#define RLX_AGENT __ATOMIC_RELAXED, __HIP_MEMORY_SCOPE_AGENT
#define XB_TMO      128
#define XB_XCNT(j)  (256  + 64 * (j))
#define XB_XSUB(j)  (1280 + 64 * (j))
#define XB_XGEN(j)  (2304 + 64 * (j))
#define XB_TOP      3328
#define XB_TOPGEN   3392
#define XCD_BAR_WORDS 3456
#define XB_SPIN_CAP (1u << 18)

__device__ __forceinline__ unsigned xb_ld(unsigned* p)              { return __hip_atomic_load(p, __ATOMIC_RELAXED, __HIP_MEMORY_SCOPE_AGENT); }
__device__ __forceinline__ unsigned xb_add(unsigned* p, unsigned v) { return __hip_atomic_fetch_add(p, v, __ATOMIC_RELAXED, __HIP_MEMORY_SCOPE_AGENT); }
__device__ __forceinline__ unsigned xb_xcc_id() { return (unsigned)__builtin_amdgcn_s_getreg((3 << 11) | 20) & 0xFu; }
#define XB_SPIN(cond, bar) do { unsigned _sp = 0; while (cond) { __builtin_amdgcn_s_sleep(1); \
    if ((++_sp & 255u) == 0u) { if (xb_ld(&(bar)[XB_TMO])) break; if (_sp > XB_SPIN_CAP) { atomicAdd(&(bar)[XB_TMO], 1u); break; } } } } while (0)

struct XcdBarrier {
    unsigned* bar; unsigned x;
    volatile LAS unsigned* st;
};

__device__ __forceinline__ XcdBarrier xcd_barrier_post(unsigned* bar, volatile LAS unsigned* st) {
    XcdBarrier b; b.bar = bar; b.x = xb_xcc_id(); b.st = st;
    if (threadIdx.x == 0) (void)xb_add(&bar[XB_XCNT(b.x)], 1u);
    return b;
}
__device__ __forceinline__ void xcd_barrier_complete(unsigned* bar, unsigned x, unsigned& nloc, unsigned& nx) {
    const unsigned G = gridDim.x * gridDim.y * gridDim.z;
    unsigned sum, cnt, mine, sp = 0u;
    for (;;) {
        sum = 0u; cnt = 0u; mine = 0u;
#pragma unroll
        for (unsigned j = 0; j < 16; ++j) { const unsigned c = xb_ld(&bar[XB_XCNT(j)]); sum += c; cnt += (c > 0u) ? 1u : 0u; mine = (j == x) ? c : mine; }
        if (sum == G) break;
        __builtin_amdgcn_s_sleep(1);
        if ((++sp & 255u) == 0u) { if (xb_ld(&bar[XB_TMO])) break; if (sp > XB_SPIN_CAP) { atomicAdd(&bar[XB_TMO], 1u); break; } }
    }
    nloc = mine > 0u ? mine : 1u; nx = cnt > 0u ? cnt : 1u;
}

__device__ __forceinline__ void xcd_barrier(const XcdBarrier& b) {
    asm volatile("s_waitcnt vmcnt(0)" ::: "memory");
    __syncthreads();
    if (threadIdx.x == 0) {
        unsigned* bar = b.bar;
        __builtin_amdgcn_s_waitcnt(0);
        unsigned nloc = b.st[0], nx = b.st[1];
        if (nloc == 0u) { xcd_barrier_complete(bar, b.x, nloc, nx); b.st[0] = nloc; b.st[1] = nx; }
        const unsigned old = xb_add(&bar[XB_XSUB(b.x)], 1u);
        const unsigned gen = old / nloc;
        if (old + 1u == (gen + 1u) * nloc) {
            __builtin_amdgcn_fence(__ATOMIC_RELEASE, "agent");
            asm volatile("s_waitcnt vmcnt(0)" ::: "memory");
            const unsigned og = xb_add(&bar[XB_TOP], 1u);
            const unsigned tg = og / nx;
            if (og + 1u == (tg + 1u) * nx) xb_add(&bar[XB_TOPGEN], 1u);
            else XB_SPIN(xb_ld(&bar[XB_TOPGEN]) == tg, bar);
            __builtin_amdgcn_fence(__ATOMIC_ACQUIRE, "agent");
            xb_add(&bar[XB_XGEN(b.x)], 1u);
            asm volatile("s_waitcnt vmcnt(0)" ::: "memory");
        } else {
            XB_SPIN(xb_ld(&bar[XB_XGEN(b.x)]) == gen, bar);
            __builtin_amdgcn_fence(__ATOMIC_ACQUIRE, "agent");
            asm volatile("s_waitcnt vmcnt(0)" ::: "memory");
        }
    }
    __syncthreads();
}


__global__ void __launch_bounds__(512, 2) mega(Params P) {
  extern __shared__ __attribute__((aligned(16))) unsigned char lds_raw[];
  LAS unsigned char* lds = (LAS unsigned char*)lds_raw;
  cg::grid_group grid = cg::this_grid();
  if (threadIdx.x < 16) ((LAS unsigned*)(lds + (LDS_BYTES - 64)))[threadIdx.x] = 0u;
  __syncthreads();
  (void)xcd_barrier_post((unsigned*)(P.ws + WS_BAR), (volatile LAS unsigned*)(lds + (LDS_BYTES - 64)));
#define FRESH() Ctx X; { size_t z_ = 0; asm volatile("" : "+s"(z_)); X.ws = P.ws + z_; X.out = (float*)((unsigned char*)P.out + z_); X.in = P.in; X.G = gridDim.x; X.blk = blockIdx.x; }
#define GSYNC() do { XcdBarrier b_; unsigned zo_ = 0; asm volatile("" : "+s"(zo_)); b_.bar = (unsigned*)(P.ws + WS_BAR) + zo_;     b_.x = xb_xcc_id(); b_.st = (volatile LAS unsigned*)(lds + (LDS_BYTES - 64)); xcd_barrier(b_); } while (0)
#define OB (X.OA() + (size_t)T * 512)
#define GATES X.PROJ()
#define MERGED X.H()
#define XQ X.PROJ()
#define OX (X.PROJ() + (size_t)T * 512)
#define FFH X.PROJ()
#define PIN(k) P.in[oidx(k)]

#ifndef SKIP_TABLES
  { FRESH(); tables_phase(X, P); }
#endif
  if (P.pad0 != 0) grid.sync();
#pragma unroll 1
  for (int layer = 0; layer < DEPTH; ++layer) {
    const size_t L = (size_t)layer;
#define xin ((layer == 0) ? PIN(0) : (const float*)X.out)
    { FRESH();
#ifndef SKIP_WCONV
    wconv_phase(lds, X, layer);
#endif
#ifndef SKIP_RMS1
    if (layer == 0) xb_prepass(X, PIN(0));
    rms_phase(X, PIN(1), PIN(21) + L * 1024, X.HM(), NB * 256);
#endif
    }
    GSYNC();
    { FRESH();
#ifndef SKIP_INPROJ
    { pg8::Gemm g{X.H(), X.W() + W_IN, T, NPROJ, 1024, 1024, 1024}; pg8::StaticOrder So; So.init(T, NPROJ, X.G, X.blk);
      pg8::EpiInproj E{X.PROJ(), X.QROT(), X.VST(), X.KST(), X.CS64(), X.CS32(), X.RSS()}; pg8::gemm_phase(lds, g, So, E); }
#endif
#ifndef SKIP_MEMKV
    { pg8::Gemm g{X.HM(), X.W() + W_XKV, 1024, 1024, 1024, 1024, 1024}; pg8::StaticOrder So; So.init(1024, 1024, X.G, (X.blk + X.G / 2) % X.G);
      pg8::EpiPlain E{X.MEMKV(), 1024, nullptr}; pg8::gemm_phase(lds, g, So, E); }
#endif
    }
    GSYNC();
    { FRESH();
#ifndef SKIP_P3
    mla_norm_phase(X, PIN(12) + L * 384, PIN(14) + L * 256);
    for (int t = X.blk; t < 512; t += X.G) nsa_compress_task(lds, X, PIN(6) + L * 2048, PIN(7) + L * 2048, t);
#endif
    }
    GSYNC();
    { FRESH();
#ifndef SKIP_MLAQ
    { pg8::Gemm g{X.PROJ() + C_CQA, X.W() + W_QB, T, 768, 384, NPROJ, 384}; pg8::StaticOrder So; So.init(T, 768, X.G, X.blk);
      pg8::EpiMlaQ E{X.QM(), X.CS32()}; pg8::gemm_phase(lds, g, So, E); }
#endif
#ifndef SKIP_KVUP
    { pg8::Gemm g{X.PROJ() + C_CKV, X.W() + W_KVB, T, 1024, 256, NPROJ, 256}; pg8::StaticOrder So; So.init(T, 1024, X.G, X.blk);
      pg8::EpiPlain E{X.KVM(), 1024, nullptr}; pg8::gemm_phase(lds, g, So, E); }
#endif
    }
    GSYNC();
    { FRESH();
#ifndef SKIP_MLA
    if (X.G == 256) { const int vcu = (X.blk % 8) * 32 + X.blk / 8; const int bh = vcu >> 3, s = vcu & 7;
      for (int i = 0; i < 4; ++i) { const int qb = (i == 0) ? s : (i == 1) ? 15 - s : (i == 2) ? 16 + s : 31 - s; mla_unit(lds, X, bh >> 3, bh & 7, qb); } }
    else { for (int u = X.blk; u < 1024; u += X.G) mla_unit(lds, X, (u >> 5) >> 3, (u >> 5) & 7, 31 - (u & 31)); }
#endif
    }
    GSYNC();
    { FRESH();
#ifndef SKIP_SWA
    for (int u = X.blk; u < 512; u += X.G) swa_unit(lds, X, PIN(5) + L * 8, u >> 7, (u >> 6) & 1, u & 63);
#endif
#ifndef SKIP_NSA
    for (int u = X.blk; u < 512; u += X.G) { const int uu = u & 255; const int qb = (u < 256) ? 63 - (uu >> 3) : (uu >> 3), bg = uu & 7; nsa_unit(lds, X, OB, bg >> 1, bg & 1, qb); }
#endif
    }
    GSYNC();
    { FRESH();
#ifndef SKIP_NSA
    nsa_sel_phase(X, OB);
#endif
    }
    GSYNC();
    { FRESH();
#ifndef SKIP_GATES
    { pg8::Gemm g{X.H(), X.W() + W_G, T, NGATE, 1024, 1024, 1024}; pg8::StaticOrder So; So.init(T, NGATE, X.G, X.blk);
      pg8::EpiGates E{GATES, X.RSS()}; pg8::gemm_phase(lds, g, So, E); }
#endif
    }
    GSYNC();
    { FRESH();
#ifndef SKIP_MERGE
    { pg8::Gemm g{X.OA(), X.W() + W_BR, 3 * T, 3 * 1024, 512, 512, 512}; pg8::MergeOrder So{X.G, X.blk};
      pg8::EpiMerge E{GATES, MERGED}; pg8::gemm_phase(lds, g, So, E); }
#endif
    }
    GSYNC();
    { FRESH();
#ifndef SKIP_RESID
    { pg8::Gemm g{MERGED, X.W() + W_OUT, T, 1024, 1024, 1024, 1024}; pg8::StaticOrder So; So.init(T, 1024, X.G, X.blk);
      pg8::EpiResid E{xin, X.out, X.KVM(), X.RSS(), (LAS float*)(lds + 131072)}; pg8::gemm_phase(lds, g, So, E); }
#endif
    }
    GSYNC();
    { FRESH();
#ifndef SKIP_XQ
    { pg8::Gemm g{X.KVM(), X.W() + W_XQ, T, 512, 1024, 1024, 1024}; pg8::StaticOrder So; So.init(T, 512, X.G, X.blk);
      pg8::EpiPlain E{XQ, 512, X.RSS()}; pg8::gemm_phase(lds, g, So, E); }
#endif
    }
    GSYNC();
    { FRESH();
#ifndef SKIP_XATT
    for (int u = X.blk; u < 512; u += X.G) xattn_unit(lds, X, XQ, OX, u >> 7, (u >> 5) & 3, u & 31);
#endif
    }
    GSYNC();
    { FRESH();
#ifndef SKIP_XO
    { pg8::Gemm g{OX, X.W() + W_XO, T, 1024, 512, 512, 512}; pg8::StaticOrder So; So.init(T, 1024, X.G, X.blk);
      pg8::EpiResid E{X.out, X.out, X.H(), X.RSS(), (LAS float*)(lds + 131072)}; pg8::gemm_phase(lds, g, So, E); }
#endif
    }
    GSYNC();
    { FRESH();
#ifndef SKIP_SWIGLU
    { pg8::Gemm g{X.H(), X.W() + W_GU, T, NGU, 1024, 1024, 1024}; pg8::StaticOrder So; So.init(T, NGU, X.G, X.blk);
      pg8::EpiSwiglu E{FFH, X.RSS()}; pg8::gemm_phase(lds, g, So, E); }
#endif
    }
    GSYNC();
    { FRESH();
#ifndef SKIP_DOWN
    { pg8::Gemm g{FFH, X.W() + W_DOWN, T, 1024, DFF, DFF, DFF}; pg8::StaticOrder So; So.init(T, 1024, X.G, X.blk);
      pg8::EpiResid E{X.out, X.out, X.H(), X.RSS(), (LAS float*)(lds + 131072)}; pg8::gemm_phase(lds, g, So, E); }
#endif
    }
    GSYNC();
  }
#ifndef SKIP_FINAL
  { FRESH(); final_norm_phase(X, PIN(28)); }
#endif
}

extern "C" void kernel_launch(void* const* d_in, const int* in_sizes, int n_in, void* d_out, int out_size, void* d_ws, size_t ws_size, hipStream_t stream) {
  static int grid_blocks = 0;
  if (!grid_blocks) {
    int dev = 0, cus = 0, per_cu = 0;
    (void)hipGetDevice(&dev);
    (void)hipDeviceGetAttribute(&cus, hipDeviceAttributeMultiprocessorCount, dev);
    (void)hipFuncSetAttribute((const void*)mega, hipFuncAttributeMaxDynamicSharedMemorySize, LDS_BYTES);
    (void)hipOccupancyMaxActiveBlocksPerMultiprocessor(&per_cu, (const void*)mega, 512, LDS_BYTES);
    if (per_cu < 1) per_cu = 1;
    if (per_cu > 1) per_cu = 1;
    grid_blocks = cus * per_cu;
    if (ws_size < WS_END || n_in != 29 || out_size != T * DM) fprintf(stderr, "kernel_launch: unexpected sizes: ws %zu (need %zu) n_in %d out %d\n", ws_size, (size_t)WS_END, n_in, out_size);
  }
  Params p;
  memset(&p, 0, sizeof(p));
  for (int i = 0; i < 29; ++i) p.in[i] = (const float*)d_in[i];
  p.out = (float*)d_out; p.ws = (unsigned char*)d_ws;
  for (int i = 0; i < 32; ++i) p.invf64[i] = (float)pow(10000.0, -(double)i / 32.0);
  for (int i = 0; i < 16; ++i) p.invf32[i] = (float)pow(10000.0, -(double)i / 16.0);
  (void)hipMemsetAsync((char*)d_ws + WS_BAR, 0, BAR_BYTES, stream);
  void* args[] = {&p};
  hipError_t e = hipLaunchCooperativeKernel((const void*)mega, dim3(grid_blocks), dim3(512), args, LDS_BYTES, stream);
  if (e != hipSuccess) fprintf(stderr, "cooperative launch failed: %s (grid %d)\n", hipGetErrorString(e), grid_blocks);
}
```

```cpp
#include <hip/hip_runtime.h>
#include <hip/hip_cooperative_groups.h>
#include <cstdio>
#include <cstdint>
#include <cmath>
#include <cstring>
namespace cg = cooperative_groups;

#define LAS __attribute__((address_space(3)))
typedef unsigned short bf16_t;
typedef short bf16x8 __attribute__((ext_vector_type(8)));
typedef short s16x4 __attribute__((ext_vector_type(4)));
typedef short v4i16_t __attribute__((ext_vector_type(4)));
typedef float f32x4 __attribute__((ext_vector_type(4)));
typedef float f32x2 __attribute__((ext_vector_type(2)));
typedef unsigned u32x4 __attribute__((ext_vector_type(4)));
typedef unsigned u32x2 __attribute__((ext_vector_type(2)));

constexpr int NB = 4, S = 8192, T = NB * S, DM = 1024, DEPTH = 2;
constexpr int DIN = 5816, NPROJ = 2816, NGATE = 3072, DFF = 2816, NGU = 5632;
constexpr int C_AQ = 0, C_AK = 512, C_AV = 640, C_BQ = 768, C_BKC = 1280, C_BVC = 1408, C_BKS = 1536, C_BVS = 1664, C_BKW = 1792, C_BVW = 1920;
constexpr int C_CQA = 2048, C_CKV = 2432, C_CKR = 2688, C_BG = 2720;
constexpr float LOG2E = 1.4426950408889634f;
constexpr float NORM_EPS = 1e-6f;

constexpr size_t MiB = 1u << 20;
constexpr size_t WS_KCMP = 0, WS_VCMP = MiB / 2, WS_MEMKV = 1 * MiB, WS_HM = 3 * MiB;
constexpr size_t WS_SELL = 5 * MiB;
constexpr size_t WS_BAR = 7 * MiB, BAR_BYTES = 16384;
constexpr size_t WS_CS64 = 8 * MiB, WS_CS32 = 16 * MiB;
constexpr size_t WS_W = 20 * MiB;
constexpr size_t WS_RSS = 59 * MiB;
constexpr size_t WS_H = 64 * MiB;
constexpr size_t WS_PROJ = 128 * MiB;
constexpr size_t WS_QM = 304 * MiB;
constexpr size_t WS_KVM = 352 * MiB;
constexpr size_t WS_OC = 416 * MiB;
constexpr size_t WS_QROT = 448 * MiB;
constexpr size_t WS_VST = 480 * MiB;
constexpr size_t WS_KST = 488 * MiB;
constexpr size_t WS_END = 496 * MiB;
constexpr size_t W_IN = 0, W_G = W_IN + (size_t)NPROJ * 1024, W_QB = W_G + (size_t)NGATE * 1024, W_KVB = W_QB + 768 * 384,
                 W_BR = W_KVB + 1024 * 256, W_OUT = W_BR + 3 * 1024 * 512, W_XQ = W_OUT + 1024 * 1024, W_XKV = W_XQ + 512 * 1024,
                 W_XO = W_XKV + 1024 * 1024, W_GU = W_XO + 1024 * 512, W_DOWN = W_GU + (size_t)NGU * 1024, W_K1 = W_DOWN + (size_t)1024 * DFF,
                 W_V1 = W_K1 + 64 * 2048, W_K2 = W_V1 + 64 * 2048, W_V2 = W_K2 + 64 * 64, W_ENDE = W_V2 + 64 * 64;
static_assert(W_ENDE * 2 <= 39 * MiB, "weights fit below the row-statistics buffer");

constexpr int LDS_BYTES = 147456;

typedef __bf16 bf16x2_t __attribute__((ext_vector_type(2)));
__device__ __forceinline__ unsigned cvt_pk_bf16(float lo, float hi) { f32x2 v = {lo, hi}; bf16x2_t b = __builtin_convertvector(v, bf16x2_t); return __builtin_bit_cast(unsigned, b); }
__device__ __forceinline__ float bf2f(unsigned short b) { return __uint_as_float(((unsigned)b) << 16); }
__device__ __forceinline__ float bflo(unsigned w) { return __uint_as_float(w << 16); }
__device__ __forceinline__ float bfhi(unsigned w) { return __uint_as_float(w & 0xffff0000u); }
__device__ __forceinline__ float ex2(float x) { return __builtin_amdgcn_exp2f(x); }
__device__ __forceinline__ float sigmoidf_(float x) { return __builtin_amdgcn_rcpf(1.0f + ex2(-x * LOG2E)); }
__device__ __forceinline__ float wave_sum(float v) {
#pragma unroll
  for (int o = 1; o < 64; o <<= 1) v += __shfl_xor(v, o);
  return v;
}
__device__ __forceinline__ int otid() { int t = threadIdx.x; asm volatile("" : "+v"(t)); return t; }
__device__ __forceinline__ int oidx(int k) { asm volatile("" : "+s"(k)); return k; }
#define LBAR() asm volatile("s_waitcnt lgkmcnt(0)\n\ts_barrier" ::: "memory")
#define LWAIT() asm volatile("s_waitcnt lgkmcnt(0)" ::: "memory")

__device__ __forceinline__ u32x2 pack8_fp8(const float (&a)[4], const float (&b)[4]) {
  int w0 = __builtin_amdgcn_cvt_pk_fp8_f32(a[0], a[1], 0, false); w0 = __builtin_amdgcn_cvt_pk_fp8_f32(a[2], a[3], w0, true);
  int w1 = __builtin_amdgcn_cvt_pk_fp8_f32(b[0], b[1], 0, false); w1 = __builtin_amdgcn_cvt_pk_fp8_f32(b[2], b[3], w1, true);
  return (u32x2){(unsigned)w0, (unsigned)w1};
}
__device__ __forceinline__ long as_long(unsigned lo, unsigned hi) { return (long)(((unsigned long long)hi << 32) | (unsigned long long)lo); }
__device__ __forceinline__ f32x4 mfma16_fp8(long a, long b, f32x4 c) { return __builtin_amdgcn_mfma_f32_16x16x32_fp8_fp8(a, b, c, 0, 0, 0); }

__device__ __forceinline__ float xor32(float v) { const unsigned u = __float_as_uint(v); auto rr = __builtin_amdgcn_permlane32_swap(u, u, false, false); return __uint_as_float((threadIdx.x & 32) ? rr[0] : rr[1]); }
__device__ __forceinline__ float xor16(float v) { const unsigned u = __float_as_uint(v); auto rr = __builtin_amdgcn_permlane16_swap(u, u, false, false); return __uint_as_float((threadIdx.x & 16) ? rr[0] : rr[1]); }
__device__ __forceinline__ float max_x16_x32(float v) { const unsigned u = __float_as_uint(v); auto a = __builtin_amdgcn_permlane16_swap(u, u, false, false); const float w = fmaxf(__uint_as_float(a[0]), __uint_as_float(a[1]));
  const unsigned u2 = __float_as_uint(w); auto b = __builtin_amdgcn_permlane32_swap(u2, u2, false, false); return fmaxf(__uint_as_float(b[0]), __uint_as_float(b[1])); }

namespace pg8 {
constexpr int BM = 256, BK = 64, HALF = 128, HTB = HALF * BK * 2, STAGE_BYTES = 8 * HTB, NXCD = 8, WGM = 8;
__device__ __forceinline__ int lds_byte(int r, int c) { const int st = (r >> 4) * 2 + (c >> 5), rr = r & 15, cc = c & 31, ob = rr * 64 + cc * 2; return st * 1024 + (ob ^ (((ob >> 9) & 1) << 5)); }
__device__ __forceinline__ void stage_rc(int b, int& R, int& C) { const int st = b / 1024, sb = b % 1024, swz = sb ^ (((sb >> 9) & 1) << 5); R = (st >> 1) * 16 + swz / 64; C = (st & 1) * 32 + (swz % 64) / 2; }
__device__ __forceinline__ int perm32(int rho) { const int n = rho >> 4, i = rho & 15; return 8 * (i >> 2) + 4 * n + (i & 3); }
struct Unit { int pm, pn; };
struct Gemm { const bf16_t* A; const bf16_t* Bt; int M, N, K, lda, ldb; };
__device__ __forceinline__ void tile_of(int L, int nM, int nN, Unit& u) {
  const int nwg = nM * nN; int wgid = L;
  { const int q = nwg / NXCD, r = nwg % NXCD, xcd = wgid % NXCD, off = wgid / NXCD; wgid = (xcd < r ? xcd * (q + 1) : r * (q + 1) + (xcd - r) * q) + off; }
  const int nig = WGM * nN, gid = wgid / nig, fm = gid * WGM, gsz = (nM - fm) < WGM ? (nM - fm) : WGM;
  u.pm = fm + ((wgid % nig) % gsz); u.pn = (wgid % nig) / gsz;
}
struct StaticOrder {
  int nM, nN, nwg, G, c;
  __device__ void init(int M, int N, int G_, int c_) { nM = M / BM; nN = N / BM; nwg = nM * nN; G = G_; c = c_; }
  __device__ __forceinline__ bool next(int i, Unit& u) const { const long L = (long)i * G + c; if (L >= nwg) return false; tile_of((int)L, nM, nN, u); return true; }
};
struct MergeOrder {
  int G, c;
  __device__ __forceinline__ bool next(int k, Unit& u) const { const int r = k / 3, i = k - 3 * r; const int L = r * G + c; if (L >= 512) return false; Unit t; tile_of(L, 128, 4, t); u.pm = i * 128 + t.pm; u.pn = i * 4 + t.pn; return true; }
};

template <class Epi, class Sched>
__device__ __forceinline__ void gemm_phase(LAS unsigned char* lds, const Gemm g, const Sched& S, const Epi& E) {
  const int tid = otid(), wid = __builtin_amdgcn_readfirstlane(tid >> 6), lane = tid & 63, wr = wid >> 2, wc = wid & 3, fr = lane & 15, fq = lane >> 4;
  const int K = g.K, nt = K / BK;
  unsigned voffA[2], voffB[2];
#pragma unroll
  for (int i = 0; i < 2; ++i) { int R, C; stage_rc(tid * 16 + i * 8192, R, C); const int Rb = (R & ~31) + perm32(R & 31);
    voffA[i] = (unsigned)(R * g.lda + C) * 2u; voffB[i] = (unsigned)(Rb * g.ldb + C) * 2u; }
  const size_t kstep = (size_t)(BK * 2);
  const size_t hstepA = (size_t)HALF * g.lda * 2, hstepB = (size_t)HALF * g.ldb * 2;
  const size_t tstepA = 2 * hstepA, tstepB = 2 * hstepB;
  const unsigned ldsw = (unsigned)wid * 1024u;
  const int aoff = lds_byte(wr * 64 + fr, fq * 8), boff = lds_byte(wc * 32 + fr, fq * 8);
#define PG8_SA(b, h) (((b) * 2 + (h)) * HTB)
#define PG8_SB(b, h) ((4 + (b) * 2 + (h)) * HTB)
#define PG8_STAGE(bufoff, gbase, voff) do { _Pragma("unroll") for (int _i = 0; _i < 2; ++_i) \
        __builtin_amdgcn_global_load_lds((const unsigned*)((const char*)(gbase) + (voff)[_i]), (LAS unsigned*)(lds + (bufoff) + ldsw + _i * 8192), 16, 0, 0); } while (0)
#define PG8_LDA(dst, b, h) do { _Pragma("unroll") for (int m = 0; m < 4; ++m) _Pragma("unroll") for (int k = 0; k < 2; ++k) dst[m][k] = *(const LAS bf16x8*)(lds + PG8_SA(b, h) + aoff + m * 2048 + k * 1024); } while (0)
#define PG8_LDB(dst, b, h) do { _Pragma("unroll") for (int n = 0; n < 2; ++n) _Pragma("unroll") for (int k = 0; k < 2; ++k) dst[n][k] = *(const LAS bf16x8*)(lds + PG8_SB(b, h) + boff + n * 2048 + k * 1024); } while (0)
#define PG8_MMA(ai, bj, At, Bt) do { __builtin_amdgcn_s_setprio(1); _Pragma("unroll") for (int m = 0; m < 4; ++m) _Pragma("unroll") for (int n = 0; n < 2; ++n) _Pragma("unroll") for (int k = 0; k < 2; ++k) \
        acc[ai][bj][m][n] = __builtin_amdgcn_mfma_f32_16x16x32_bf16(Bt[n][k], At[m][k], acc[ai][bj][m][n], 0, 0, 0); __builtin_amdgcn_s_setprio(0); } while (0)
#define PG8_WAIT_V(n) asm volatile("s_waitcnt vmcnt(" #n ")" ::: "memory")
#define PG8_WAIT_L(n) asm volatile("s_waitcnt lgkmcnt(" #n ")" ::: "memory")
#define PG8_BAR __builtin_amdgcn_s_barrier()
#define PG8_SCHED __builtin_amdgcn_sched_barrier(0)
  Unit cur, nxt; int ui = 0;
  if (!S.next(0, cur)) return;
  f32x4 acc[2][2][4][2];
#pragma unroll
  for (int a = 0; a < 2; ++a)
#pragma unroll
    for (int b = 0; b < 2; ++b)
#pragma unroll
      for (int m = 0; m < 4; ++m)
#pragma unroll
        for (int n = 0; n < 2; ++n) acc[a][b][m][n] = (f32x4){0.f, 0.f, 0.f, 0.f};
  bf16x8 At[4][2], B0[2][2], B1[2][2];
  const char* cA = (const char*)g.A + (size_t)cur.pm * tstepA; const char* cB = (const char*)g.Bt + (size_t)cur.pn * tstepB;
  PG8_STAGE(PG8_SB(0, 0), cB, voffB); PG8_STAGE(PG8_SB(0, 1), cB + hstepB, voffB); PG8_STAGE(PG8_SA(0, 0), cA, voffA); PG8_STAGE(PG8_SA(0, 1), cA + hstepA, voffA);
  if (wr == 1) PG8_BAR;
  PG8_WAIT_V(2); PG8_BAR;
  PG8_STAGE(PG8_SB(1, 0), cB + kstep, voffB); PG8_STAGE(PG8_SA(1, 0), cA + kstep, voffA); PG8_STAGE(PG8_SB(1, 1), cB + hstepB + kstep, voffB);
  PG8_WAIT_V(6); PG8_BAR;
  for (;;) {
    const bool has_next = S.next(ui + 1, nxt);
    const char* nA = has_next ? (const char*)g.A + (size_t)nxt.pm * tstepA : cA; const char* nB = has_next ? (const char*)g.Bt + (size_t)nxt.pn * tstepB : cB;
    for (int t = 0; t < nt; t += 2) {
      const bool last = (t == nt - 2);
      const char* a1 = cA + (size_t)(t + 1) * kstep;
      const char* a2 = last ? nA : cA + (size_t)(t + 2) * kstep; const char* b2 = last ? nB : cB + (size_t)(t + 2) * kstep;
      const char* a3 = a2 + kstep; const char* b3 = b2 + kstep;
      PG8_LDB(B0, 0, 0); PG8_LDB(B1, 0, 1); PG8_SCHED; PG8_LDA(At, 0, 0); PG8_STAGE(PG8_SA(1, 1), a1 + hstepA, voffA);
      PG8_WAIT_V(8); PG8_WAIT_L(0); PG8_BAR; PG8_MMA(0, 0, At, B0); PG8_MMA(0, 1, At, B1); PG8_BAR; PG8_SCHED;
      PG8_LDA(At, 0, 1); PG8_STAGE(PG8_SB(0, 0), b2, voffB); PG8_STAGE(PG8_SB(0, 1), b2 + hstepB, voffB); PG8_STAGE(PG8_SA(0, 0), a2, voffA);
      PG8_WAIT_V(8); PG8_WAIT_L(0); PG8_BAR; PG8_MMA(1, 0, At, B0); PG8_MMA(1, 1, At, B1); PG8_BAR; PG8_SCHED;
      PG8_LDB(B0, 1, 0); PG8_LDB(B1, 1, 1); PG8_SCHED; PG8_LDA(At, 1, 0); PG8_STAGE(PG8_SA(0, 1), a2 + hstepA, voffA);
      PG8_WAIT_V(8); PG8_WAIT_L(0); PG8_BAR; PG8_MMA(0, 0, At, B0); PG8_MMA(0, 1, At, B1); PG8_BAR; PG8_SCHED;
      PG8_LDA(At, 1, 1); PG8_STAGE(PG8_SB(1, 0), b3, voffB); PG8_STAGE(PG8_SB(1, 1), b3 + hstepB, voffB); PG8_STAGE(PG8_SA(1, 0), a3, voffA);
      PG8_WAIT_V(8); PG8_WAIT_L(0); PG8_BAR; PG8_MMA(1, 0, At, B0); PG8_MMA(1, 1, At, B1); PG8_BAR; PG8_SCHED;
    }
    if (wr == 0) PG8_BAR;
    { const int l2 = otid() & 63; E(acc, cur, wr, wc, l2 & 15, l2 >> 4); }
    if (!has_next) break;
#pragma unroll
    for (int a = 0; a < 2; ++a)
#pragma unroll
      for (int b = 0; b < 2; ++b)
#pragma unroll
        for (int m = 0; m < 4; ++m)
#pragma unroll
          for (int n = 0; n < 2; ++n) acc[a][b][m][n] = (f32x4){0.f, 0.f, 0.f, 0.f};
    cur = nxt; cA = nA; cB = nB; ++ui;
    if (wr == 1) PG8_BAR;
  }
  PG8_WAIT_V(0);
  PG8_BAR;
#undef PG8_SA
#undef PG8_SB
#undef PG8_STAGE
#undef PG8_LDA
#undef PG8_LDB
#undef PG8_MMA
#undef PG8_WAIT_V
#undef PG8_WAIT_L
#undef PG8_BAR
#undef PG8_SCHED
}

__device__ __forceinline__ void store8(bf16_t* p, const f32x4& v0, const f32x4& v1) {
  u32x4 w; w.x = cvt_pk_bf16(v0[0], v0[1]); w.y = cvt_pk_bf16(v0[2], v0[3]); w.z = cvt_pk_bf16(v1[0], v1[1]); w.w = cvt_pk_bf16(v1[2], v1[3]); *(u32x4*)p = w;
}
__device__ __forceinline__ void rope8(f32x4& v0, f32x4& v1, const f32x2* cs) {
  const f32x4 a = *(const f32x4*)cs, b = *(const f32x4*)(cs + 2);
  float x1, x2;
  x1 = v0[0]; x2 = v0[1]; v0[0] = x1 * a[0] - x2 * a[1]; v0[1] = x2 * a[0] + x1 * a[1];
  x1 = v0[2]; x2 = v0[3]; v0[2] = x1 * a[2] - x2 * a[3]; v0[3] = x2 * a[2] + x1 * a[3];
  x1 = v1[0]; x2 = v1[1]; v1[0] = x1 * b[0] - x2 * b[1]; v1[1] = x2 * b[0] + x1 * b[1];
  x1 = v1[2]; x2 = v1[3]; v1[2] = x1 * b[2] - x2 * b[3]; v1[3] = x2 * b[2] + x1 * b[3];
}
__device__ __forceinline__ float row_rstd(const float* rss, size_t row) { const f32x4 q = *(const f32x4*)(rss + row * 4); return __builtin_amdgcn_rsqf(((q[0] + q[1]) + (q[2] + q[3])) * (1.f / 1024.f) + NORM_EPS); }
#define EPI_FOR_ROWS for (int ai = 0; ai < 2; ++ai) for (int m = 0; m < 4; ++m)
struct EpiPlain {
  bf16_t* O; int ldc; const float* rss;
  __device__ __forceinline__ void operator()(const f32x4 (&acc)[2][2][4][2], const Unit& u, int wr, int wc, int fr, int fq) const {
#pragma unroll
    for (int ai = 0; ai < 2; ++ai)
#pragma unroll
      for (int m = 0; m < 4; ++m) { const size_t row = (size_t)u.pm * BM + ai * HALF + wr * 64 + m * 16 + fr;
#pragma unroll
        for (int bj = 0; bj < 2; ++bj) { const int col0 = u.pn * BM + bj * HALF + wc * 32 + 8 * fq; const float rs = rss ? row_rstd(rss, row) : 1.0f; store8(O + row * ldc + col0, acc[ai][bj][m][0] * rs, acc[ai][bj][m][1] * rs); } }
  }
};
struct EpiInproj {
  bf16_t* proj; bf16_t* qrot; bf16_t* vst; bf16_t* kst; const f32x2* cs64; const f32x2* cs32; const float* rss;
  __device__ __forceinline__ void operator()(const f32x4 (&acc)[2][2][4][2], const Unit& u, int wr, int wc, int fr, int fq) const {
    constexpr unsigned ROPE_IN = (1u << 0) | (1u << 1) | (1u << 2) | (1u << 3) | (1u << 4) | (1u << 12) | (1u << 14);
    constexpr unsigned ROPE_DUAL = (1u << 6) | (1u << 7) | (1u << 8) | (1u << 9);
#pragma unroll
    for (int ai = 0; ai < 2; ++ai)
#pragma unroll
      for (int m = 0; m < 4; ++m) { const size_t row = (size_t)u.pm * BM + ai * HALF + wr * 64 + m * 16 + fr; const float rs = row_rstd(rss, row);
#pragma unroll
        for (int bj = 0; bj < 2; ++bj) {
          const int seg = 2 * u.pn + bj; const int col0 = u.pn * BM + bj * HALF + wc * 32 + 8 * fq;
          f32x4 v0 = acc[ai][bj][m][0] * rs, v1 = acc[ai][bj][m][1] * rs;
          bf16_t* dst = proj + row * NPROJ + col0;
          if ((ROPE_IN >> seg) & 1u) { rope8(v0, v1, cs64 + row * 32 + ((col0 & 63) >> 1));
            if (seg == 12) {
              const int cc = col0 - C_BKS, gs = cc >> 6, d0 = cc & 63; const int b = (int)(row >> 13), s = (int)(row & 8191), blk = s >> 6, k6 = s & 63;
              const float a4[4] = {v0[0], v0[1], v0[2], v0[3]}, b4[4] = {v1[0], v1[1], v1[2], v1[3]};
              unsigned char* kd = (unsigned char*)kst + ((size_t)(b * 2 + gs) * 128 + blk) * 4096 + (((k6 >> 4) * 16 + (k6 & 15)) * 4 + ((d0 & 31) >> 3)) * 16 + (d0 >> 5) * 8;
              *(u32x2*)kd = pack8_fp8(a4, b4);
            } else store8(dst, v0, v1); }
          else if ((ROPE_DUAL >> seg) & 1u) { store8(dst, v0, v1); rope8(v0, v1, cs64 + row * 32 + ((col0 & 63) >> 1)); store8(qrot + row * 512 + (col0 - C_BQ), v0, v1); }
          else if (seg == 21 && wc == 0) { rope8(v0, v1, cs32 + row * 16 + ((col0 - C_CKR) >> 1)); store8(dst, v0, v1); }
          else {
            store8(dst, v0, v1);
            if (seg == 13) {
              const int cc = col0 - C_BVS, gs = cc >> 6, d0 = cc & 63; const int b = (int)(row >> 13), s = (int)(row & 8191), blk = s >> 6, k6 = s & 63, k5 = k6 & 31;
              const int lgp = (k5 & 15) >> 2, jj = ((k5 >> 4) << 2) | (k5 & 3);
              const float a4[4] = {v0[0], v0[1], v0[2], v0[3]}, b4[4] = {v1[0], v1[1], v1[2], v1[3]};
              const u32x2 q8 = pack8_fp8(a4, b4);
              unsigned char* vd = (unsigned char*)vst + ((size_t)(b * 2 + gs) * 128 + blk) * 4096 + (((d0 >> 4) * 16 + (d0 & 15)) * 4 + lgp) * 16 + (k6 >> 5) * 8 + jj;
              vd[0 * 64] = (unsigned char)(q8.x); vd[1 * 64] = (unsigned char)(q8.x >> 8); vd[2 * 64] = (unsigned char)(q8.x >> 16); vd[3 * 64] = (unsigned char)(q8.x >> 24);
              vd[4 * 64] = (unsigned char)(q8.y); vd[5 * 64] = (unsigned char)(q8.y >> 8); vd[6 * 64] = (unsigned char)(q8.y >> 16); vd[7 * 64] = (unsigned char)(q8.y >> 24);
            }
          }
        } }
  }
};
struct EpiMlaQ {
  bf16_t* O; const f32x2* cs32;
  __device__ __forceinline__ void operator()(const f32x4 (&acc)[2][2][4][2], const Unit& u, int wr, int wc, int fr, int fq) const {
#pragma unroll
    for (int ai = 0; ai < 2; ++ai)
#pragma unroll
      for (int m = 0; m < 4; ++m) { const size_t row = (size_t)u.pm * BM + ai * HALF + wr * 64 + m * 16 + fr;
#pragma unroll
        for (int bj = 0; bj < 2; ++bj) { const int col0 = u.pn * BM + bj * HALF + wc * 32 + 8 * fq; const int o = col0 % 96;
          f32x4 v0 = acc[ai][bj][m][0], v1 = acc[ai][bj][m][1];
          if (o >= 64) rope8(v0, v1, cs32 + row * 16 + ((o - 64) >> 1));
          store8(O + row * 768 + col0, v0, v1); } }
  }
};
struct EpiGates {
  bf16_t* O; const float* rss;
  __device__ __forceinline__ void operator()(const f32x4 (&acc)[2][2][4][2], const Unit& u, int wr, int wc, int fr, int fq) const {
#pragma unroll
    for (int ai = 0; ai < 2; ++ai)
#pragma unroll
      for (int m = 0; m < 4; ++m) { const size_t row = (size_t)u.pm * BM + ai * HALF + wr * 64 + m * 16 + fr; const float rs = row_rstd(rss, row);
#pragma unroll
        for (int bj = 0; bj < 2; ++bj) { const int col0 = u.pn * BM + bj * HALF + wc * 32 + 8 * fq;
          f32x4 v0 = acc[ai][bj][m][0], v1 = acc[ai][bj][m][1];
#pragma unroll
          for (int e = 0; e < 4; ++e) { v0[e] = sigmoidf_(v0[e] * rs); v1[e] = sigmoidf_(v1[e] * rs); }
          store8(O + row * NGATE + col0, v0, v1); } }
  }
};
struct EpiMerge {
  const bf16_t* gates; bf16_t* merged;
  __device__ __forceinline__ void operator()(const f32x4 (&acc)[2][2][4][2], const Unit& u, int wr, int wc, int fr, int fq) const {
    const int br = u.pm >> 7, pm = u.pm & 127, pn = u.pn & 3;
#pragma unroll
    for (int ai = 0; ai < 2; ++ai) {
      u32x4 gw[4][2], pw[4][2];
#pragma unroll
      for (int m = 0; m < 4; ++m) { const size_t row = (size_t)pm * BM + ai * HALF + wr * 64 + m * 16 + fr;
#pragma unroll
        for (int bj = 0; bj < 2; ++bj) { const int col0 = pn * BM + bj * HALF + wc * 32 + 8 * fq;
          gw[m][bj] = *(const u32x4*)(gates + row * NGATE + br * 1024 + col0);
          pw[m][bj] = br > 0 ? *(const u32x4*)(merged + row * 1024 + col0) : (u32x4){0u, 0u, 0u, 0u}; } }
#pragma unroll
      for (int m = 0; m < 4; ++m) { const size_t row = (size_t)pm * BM + ai * HALF + wr * 64 + m * 16 + fr;
#pragma unroll
        for (int bj = 0; bj < 2; ++bj) { const int col0 = pn * BM + bj * HALF + wc * 32 + 8 * fq;
          f32x4 v0 = acc[ai][bj][m][0], v1 = acc[ai][bj][m][1]; const u32x4 g4 = gw[m][bj], p4 = pw[m][bj];
          v0[0] = v0[0] * bflo(g4.x) + bflo(p4.x); v0[1] = v0[1] * bfhi(g4.x) + bfhi(p4.x); v0[2] = v0[2] * bflo(g4.y) + bflo(p4.y); v0[3] = v0[3] * bfhi(g4.y) + bfhi(p4.y);
          v1[0] = v1[0] * bflo(g4.z) + bflo(p4.z); v1[1] = v1[1] * bfhi(g4.z) + bfhi(p4.z); v1[2] = v1[2] * bflo(g4.w) + bflo(p4.w); v1[3] = v1[3] * bfhi(g4.w) + bfhi(p4.w);
          store8(merged + row * 1024 + col0, v0, v1); } }
    }
  }
};
struct EpiResid {
  const float* res; float* out; bf16_t* xb; float* rss; LAS float* xl;
  __device__ __forceinline__ void operator()(const f32x4 (&acc)[2][2][4][2], const Unit& u, int wr, int wc, int fr, int fq) const {
#pragma unroll
    for (int ai = 0; ai < 2; ++ai) {
      f32x4 rv[4][2][2];
#pragma unroll
      for (int m = 0; m < 4; ++m) { const size_t row = (size_t)u.pm * BM + ai * HALF + wr * 64 + m * 16 + fr;
#pragma unroll
        for (int bj = 0; bj < 2; ++bj) { const size_t off = row * 1024 + u.pn * BM + bj * HALF + wc * 32 + 8 * fq; rv[m][bj][0] = *(const f32x4*)(res + off); rv[m][bj][1] = *(const f32x4*)(res + off + 4); } }
#pragma unroll
      for (int m = 0; m < 4; ++m) { const size_t row = (size_t)u.pm * BM + ai * HALF + wr * 64 + m * 16 + fr; float ss = 0.f;
#pragma unroll
        for (int bj = 0; bj < 2; ++bj) { const size_t off = row * 1024 + u.pn * BM + bj * HALF + wc * 32 + 8 * fq;
          const f32x4 r0 = rv[m][bj][0] + acc[ai][bj][m][0], r1 = rv[m][bj][1] + acc[ai][bj][m][1];
          *(f32x4*)(out + off) = r0; *(f32x4*)(out + off + 4) = r1; store8(xb + off, r0, r1);
          ss += (r0[0] * r0[0] + r0[1] * r0[1]) + (r0[2] * r0[2] + r0[3] * r0[3]) + (r1[0] * r1[0] + r1[1] * r1[1]) + (r1[2] * r1[2] + r1[3] * r1[3]); }
        ss += xor16(ss); ss += xor32(ss);
        if (fq == 0) xl[wc * 256 + ai * HALF + wr * 64 + m * 16 + fr] = ss; }
    }
    asm volatile("s_waitcnt lgkmcnt(0)\n\ts_barrier" ::: "memory");
    { const int t2 = otid(); if (t2 < 256) rss[((size_t)u.pm * BM + t2) * 4 + u.pn] = (xl[t2] + xl[256 + t2]) + (xl[512 + t2] + xl[768 + t2]); }
    asm volatile("s_waitcnt lgkmcnt(0)\n\ts_barrier" ::: "memory");
  }
};
struct EpiSwiglu {
  bf16_t* O; const float* rss;
  __device__ __forceinline__ void operator()(const f32x4 (&acc)[2][2][4][2], const Unit& u, int wr, int wc, int fr, int fq) const {
#pragma unroll
    for (int ai = 0; ai < 2; ++ai)
#pragma unroll
      for (int m = 0; m < 4; ++m) { const size_t row = (size_t)u.pm * BM + ai * HALF + wr * 64 + m * 16 + fr; const float rs = row_rstd(rss, row);
#pragma unroll
        for (int bj = 0; bj < 2; ++bj) { const int col0 = u.pn * BM + bj * HALF + wc * 32 + 8 * fq;
          const f32x4 gt = acc[ai][bj][m][0] * rs, up = acc[ai][bj][m][1] * rs; float r[4];
#pragma unroll
          for (int e = 0; e < 4; ++e) r[e] = gt[e] * sigmoidf_(gt[e]) * up[e];
          u32x2 w; w.x = cvt_pk_bf16(r[0], r[1]); w.y = cvt_pk_bf16(r[2], r[3]);
          *(u32x2*)(O + row * DFF + (col0 >> 1)) = w; } }
  }
};
}

__device__ __forceinline__ f32x4 mfma16(bf16x8 a, bf16x8 b, f32x4 c) { return __builtin_amdgcn_mfma_f32_16x16x32_bf16(a, b, c, 0, 0, 0); }
__device__ __forceinline__ s16x4 ds_tr(LAS const unsigned char* p) { return __builtin_bit_cast(s16x4, __builtin_amdgcn_ds_read_tr16_b64_v4i16((LAS v4i16_t*)p)); }
__device__ __forceinline__ bf16x8 pack8(const float (&a)[4], const float (&b)[4]) {
  u32x4 w; w.x = cvt_pk_bf16(a[0], a[1]); w.y = cvt_pk_bf16(a[2], a[3]); w.z = cvt_pk_bf16(b[0], b[1]); w.w = cvt_pk_bf16(b[2], b[3]); return __builtin_bit_cast(bf16x8, w);
}
enum { MODE_NONE = 0, MODE_CAUSAL = 1, MODE_WINDOW = 2, MODE_CMP = 3 };
template <int MODE> __device__ __forceinline__ bool mask_ok(int tq, int kp, int W) {
  if (MODE == MODE_CAUSAL) return kp <= tq;
  if (MODE == MODE_WINDOW) return kp <= tq && kp > tq - W;
  if (MODE == MODE_CMP) return 16 * kp + 31 <= tq;
  return true;
}
template <int NT, int NKK, int NDT, int MODE, bool MASK>
__device__ __forceinline__ void attn_chunk(f32x4 (&o)[NT][NDT], float (&m)[NT], float (&l)[NT], const bf16x8 (&qf)[NT][NKK],
                                           LAS const unsigned char* Kl, int KSTR, LAS const unsigned char* Vl, int VSTR, int kpos0, const int (&tq)[NT], float c, int W, int lane) {
  constexpr int JB = 2;
  const int r = lane & 15, lg = lane >> 4, vq = (lane & 15) >> 2, vp = lane & 3;
#pragma unroll 1
  for (int st = 0; st < 2; ++st) {
#pragma unroll
    for (int jh = 0; jh < NT / JB; ++jh) {
      int oz = 0; if (NT > JB) asm volatile("" : "+v"(oz));
      f32x4 s[JB][2];
      __builtin_amdgcn_s_setprio(1);
#pragma unroll
      for (int t = 0; t < 2; ++t)
#pragma unroll
        for (int kk = 0; kk < NKK; ++kk) {
          const bf16x8 kf = *(LAS const bf16x8*)(Kl + oz + (32 * st + 16 * t + r) * KSTR + (32 * kk + 8 * lg) * 2);
#pragma unroll
          for (int jj = 0; jj < JB; ++jj) s[jj][t] = mfma16(kf, qf[jh * JB + jj][kk], kk == 0 ? (f32x4){0.f, 0.f, 0.f, 0.f} : s[jj][t]);
        }
      __builtin_amdgcn_s_setprio(0);
      bf16x8 pf[JB];
      if (NT > JB) __builtin_amdgcn_sched_barrier(0);
#pragma unroll
      for (int jj = 0; jj < JB; ++jj) {
        const int j = jh * JB + jj;
        float mx = -INFINITY;
#pragma unroll
        for (int t = 0; t < 2; ++t)
#pragma unroll
          for (int i = 0; i < 4; ++i) {
            if (MASK) { const int kp = kpos0 + 32 * st + 16 * t + 4 * lg + i; if (!mask_ok<MODE>(tq[j], kp, W)) s[jj][t][i] = -INFINITY; }
            mx = fmaxf(mx, s[jj][t][i]);
          }
        mx = max_x16_x32(mx);
        if (NT > 2 || __any(mx > m[j] + 8.0f / c)) {
          const float mnew = fmaxf(m[j], mx);
          const float ms2 = (mnew == -INFINITY) ? 0.f : mnew;
          const float alpha = ex2((m[j] - ms2) * c);
          m[j] = mnew; l[j] *= alpha;
#pragma unroll
          for (int dt = 0; dt < NDT; ++dt) o[j][dt] *= alpha;
        }
        const float mc = ((m[j] == -INFINITY) ? 0.f : m[j]) * c;
        float p0[4], p1[4], ps = 0.f;
#pragma unroll
        for (int i = 0; i < 4; ++i) { p0[i] = ex2(s[jj][0][i] * c - mc); p1[i] = ex2(s[jj][1][i] * c - mc); ps += p0[i] + p1[i]; }
        l[j] += ps;
        pf[jj] = pack8(p0, p1);
      }
      if (NT > JB) __builtin_amdgcn_sched_barrier(0);
      __builtin_amdgcn_s_setprio(1);
#pragma unroll
      for (int dt = 0; dt < NDT; ++dt) {
        const s16x4 v0 = ds_tr(Vl + oz + (32 * st + 4 * lg + vq) * VSTR + (16 * dt + 4 * vp) * 2);
        const s16x4 v1 = ds_tr(Vl + oz + (32 * st + 16 + 4 * lg + vq) * VSTR + (16 * dt + 4 * vp) * 2);
        const bf16x8 vf = (bf16x8){v0[0], v0[1], v0[2], v0[3], v1[0], v1[1], v1[2], v1[3]};
#pragma unroll
        for (int jj = 0; jj < JB; ++jj) o[jh * JB + jj][dt] = mfma16(vf, pf[jj], o[jh * JB + jj][dt]);
      }
      __builtin_amdgcn_s_setprio(0);
      if (NT > JB) __builtin_amdgcn_sched_barrier(0);
    }
  }
}

template <int NT, int NKK, int NDT, int MODE, bool MASK>
__device__ __forceinline__ void attn_chunk_wide(f32x4 (&o)[NT][NDT], float (&m)[NT], float (&l)[NT], const bf16x8 (&qf)[NT][NKK],
                                                LAS const unsigned char* Kl, int KSTR, LAS const unsigned char* Vl, int VSTR, int kpos0, const int (&tq)[NT], float c, int W, int lane) {
  const int r = lane & 15, lg = lane >> 4, vq = (lane & 15) >> 2, vp = lane & 3;
  f32x4 s[NT][4];
  __builtin_amdgcn_s_setprio(1);
#pragma unroll
  for (int t = 0; t < 4; ++t)
#pragma unroll
    for (int kk = 0; kk < NKK; ++kk) {
      const bf16x8 kf = *(LAS const bf16x8*)(Kl + (16 * t + r) * KSTR + (32 * kk + 8 * lg) * 2);
#pragma unroll
      for (int j = 0; j < NT; ++j) s[j][t] = mfma16(kf, qf[j][kk], kk == 0 ? (f32x4){0.f, 0.f, 0.f, 0.f} : s[j][t]);
    }
  __builtin_amdgcn_s_setprio(0);
  bf16x8 pf[NT][2];
#pragma unroll
  for (int j = 0; j < NT; ++j) {
    float mx = -INFINITY;
#pragma unroll
    for (int t = 0; t < 4; ++t)
#pragma unroll
      for (int i = 0; i < 4; ++i) {
        if (MASK) { const int kp = kpos0 + 16 * t + 4 * lg + i; if (!mask_ok<MODE>(tq[j], kp, W)) s[j][t][i] = -INFINITY; }
        mx = fmaxf(mx, s[j][t][i]);
      }
    mx = max_x16_x32(mx);
    if (__any(mx > m[j] + 8.0f / c)) {
      const float mnew = fmaxf(m[j], mx);
      const float ms2 = (mnew == -INFINITY) ? 0.f : mnew;
      const float alpha = ex2((m[j] - ms2) * c);
      m[j] = mnew; l[j] *= alpha;
#pragma unroll
      for (int dt = 0; dt < NDT; ++dt) o[j][dt] *= alpha;
    }
    const float mc = ((m[j] == -INFINITY) ? 0.f : m[j]) * c;
    float p[4][4], ps = 0.f;
#pragma unroll
    for (int t = 0; t < 4; ++t)
#pragma unroll
      for (int i = 0; i < 4; ++i) { p[t][i] = ex2(s[j][t][i] * c - mc); ps += p[t][i]; }
    l[j] += ps;
    pf[j][0] = pack8(p[0], p[1]); pf[j][1] = pack8(p[2], p[3]);
  }
  __builtin_amdgcn_s_setprio(1);
#pragma unroll
  for (int st = 0; st < 2; ++st)
#pragma unroll
    for (int dt = 0; dt < NDT; ++dt) {
      const s16x4 v0 = ds_tr(Vl + (32 * st + 4 * lg + vq) * VSTR + (16 * dt + 4 * vp) * 2);
      const s16x4 v1 = ds_tr(Vl + (32 * st + 16 + 4 * lg + vq) * VSTR + (16 * dt + 4 * vp) * 2);
      const bf16x8 vf = (bf16x8){v0[0], v0[1], v0[2], v0[3], v1[0], v1[1], v1[2], v1[3]};
#pragma unroll
      for (int j = 0; j < NT; ++j) o[j][dt] = mfma16(vf, pf[j][st], o[j][dt]);
    }
  __builtin_amdgcn_s_setprio(0);
}

template <int NT, int DQK, int DV, int MODE, int PD, class Src>
__device__ __forceinline__ void attn_block_loop(LAS unsigned char* lds, const Src& src, f32x4 (&o)[NT][DV / 16], float (&m)[NT], float (&l)[NT], const bf16x8 (&qf)[NT][DQK / 32],
                                                const int (&tq)[NT], int kc0, int kc1, int kbase, int tq_min, int tq_max, float c, int W) {
  constexpr int KSTR = DQK * 2 + 16, VSTR = DV * 2 + 32, KB = 64 * KSTR, VB = 64 * VSTR, BUF = KB + VB;
  constexpr int KCH = DQK / 8, VCH = DV / 8, NKI = 64 * KCH, NVI = 64 * VCH, NKR = (NKI + 511) / 512, NVR = (NVI + 511) / 512;
  const int tid = otid(), lane = tid & 63;
  u32x4 kreg[PD][NKR], vreg[PD][NVR];
#define ABL_LOAD(u, kc) do { \
    _Pragma("unroll") for (int rr = 0; rr < NKR; ++rr) { const int idx = tid + 512 * rr; if (idx < NKI) { const int row = idx / KCH, ch = idx % KCH; kreg[u][rr] = *(const u32x4*)src.kaddr((kc) * 64 + row, ch); } } \
    _Pragma("unroll") for (int rr = 0; rr < NVR; ++rr) { const int idx = tid + 512 * rr; if (idx < NVI) { const int row = idx / VCH, ch = idx % VCH; vreg[u][rr] = *(const u32x4*)src.vaddr((kc) * 64 + row, ch); } } } while (0)
#pragma unroll
  for (int u = 0; u < PD; ++u) if (kc0 + u < kc1) ABL_LOAD(u, kc0 + u);
  for (int kcb = kc0; kcb < kc1; kcb += PD) {
#pragma unroll
    for (int u = 0; u < PD; ++u) {
      const int kc = kcb + u;
      if (kc < kc1) {
        LAS unsigned char* buf = lds + ((kc - kc0) & 1) * BUF;
#pragma unroll
        for (int rr = 0; rr < NKR; ++rr) { const int idx = tid + 512 * rr; if (idx < NKI) { const int row = idx / KCH, ch = idx % KCH; *(LAS u32x4*)(buf + row * KSTR + ch * 16) = kreg[u][rr]; } }
#pragma unroll
        for (int rr = 0; rr < NVR; ++rr) { const int idx = tid + 512 * rr; if (idx < NVI) { const int row = idx / VCH, ch = idx % VCH; *(LAS u32x4*)(buf + KB + row * VSTR + ch * 16) = vreg[u][rr]; } }
        if (kc + PD < kc1) ABL_LOAD(u, kc + PD);
        LBAR();
        const int lo = kbase + 64 * kc, hi = lo + 63;
        bool rel = true, full = true;
        if (MODE == MODE_CAUSAL) { rel = lo <= tq_max; full = hi <= tq_min; }
        if (MODE == MODE_WINDOW) { rel = (lo <= tq_max) && (hi > tq_min - W); full = (hi <= tq_min) && (lo > tq_max - W); }
        if (MODE == MODE_CMP) { rel = 16 * lo + 31 <= tq_max; full = 16 * hi + 31 <= tq_min; }
        if (rel) {
          if (NT <= 2) {
            if (full) attn_chunk_wide<NT, DQK / 32, DV / 16, MODE, false>(o, m, l, qf, buf, KSTR, buf + KB, VSTR, lo, tq, c, W, lane);
            else attn_chunk_wide<NT, DQK / 32, DV / 16, MODE, true>(o, m, l, qf, buf, KSTR, buf + KB, VSTR, lo, tq, c, W, lane);
          } else {
            if (full) attn_chunk<NT, DQK / 32, DV / 16, MODE, false>(o, m, l, qf, buf, KSTR, buf + KB, VSTR, lo, tq, c, W, lane);
            else attn_chunk<NT, DQK / 32, DV / 16, MODE, true>(o, m, l, qf, buf, KSTR, buf + KB, VSTR, lo, tq, c, W, lane);
          }
        }
      }
    }
  }
#undef ABL_LOAD
  LBAR();
}
__device__ __forceinline__ float lsum4(float l) { l += xor16(l); l += xor32(l); return l; }
__device__ __forceinline__ void store4(bf16_t* p, const f32x4& v, float sc) { u32x2 w; w.x = cvt_pk_bf16(v[0] * sc, v[1] * sc); w.y = cvt_pk_bf16(v[2] * sc, v[3] * sc); *(u32x2*)p = w; }

struct Params {
  const float* in[29]; float* out; unsigned char* ws; float invf64[32]; float invf32[16]; int pad0, pad1;
};
struct Ctx {
  const float* const* in; unsigned char* ws; float* out; int G, blk;
  __device__ __forceinline__ bf16_t* W() const { return (bf16_t*)(ws + WS_W); }
  __device__ __forceinline__ bf16_t* H() const { return (bf16_t*)(ws + WS_H); }
  __device__ __forceinline__ bf16_t* PROJ() const { return (bf16_t*)(ws + WS_PROJ); }
  __device__ __forceinline__ bf16_t* QM() const { return (bf16_t*)(ws + WS_QM); }
  __device__ __forceinline__ bf16_t* KVM() const { return (bf16_t*)(ws + WS_KVM); }
  __device__ __forceinline__ bf16_t* OA() const { return (bf16_t*)(ws + WS_KVM); }
  __device__ __forceinline__ bf16_t* OC() const { return (bf16_t*)(ws + WS_OC); }
  __device__ __forceinline__ bf16_t* QROT() const { return (bf16_t*)(ws + WS_QROT); }
  __device__ __forceinline__ bf16_t* VST() const { return (bf16_t*)(ws + WS_VST); }
  __device__ __forceinline__ bf16_t* KST() const { return (bf16_t*)(ws + WS_KST); }
  __device__ __forceinline__ bf16_t* KCMP() const { return (bf16_t*)(ws + WS_KCMP); }
  __device__ __forceinline__ bf16_t* VCMP() const { return (bf16_t*)(ws + WS_VCMP); }
  __device__ __forceinline__ bf16_t* MEMKV() const { return (bf16_t*)(ws + WS_MEMKV); }
  __device__ __forceinline__ bf16_t* HM() const { return (bf16_t*)(ws + WS_HM); }
  __device__ __forceinline__ float* RSS() const { return (float*)(ws + WS_RSS); }
  __device__ __forceinline__ unsigned char* SELL() const { return ws + WS_SELL; }
  __device__ __forceinline__ bf16_t* OW() const { return (bf16_t*)(ws + WS_QM); }
  __device__ __forceinline__ f32x2* CS64() const { return (f32x2*)(ws + WS_CS64); }
  __device__ __forceinline__ f32x2* CS32() const { return (f32x2*)(ws + WS_CS32); }
};

struct SrcMla { const bf16_t* kvm; const bf16_t* proj; size_t rowbase; int h;
  __device__ __forceinline__ const bf16_t* kaddr(int krow, int ch) const { return ch < 8 ? kvm + (rowbase + krow) * 1024 + 128 * h + 8 * ch : proj + (rowbase + krow) * NPROJ + C_CKR + 8 * (ch - 8); }
  __device__ __forceinline__ const bf16_t* vaddr(int krow, int ch) const { return kvm + (rowbase + krow) * 1024 + 128 * h + 64 + 8 * ch; } };
__device__ __forceinline__ void mla_unit(LAS unsigned char* lds, const Ctx& X, int b, int h, int qb) {
  const int tid = otid(), lane = tid & 63, w = __builtin_amdgcn_readfirstlane(tid >> 6), cq = lane & 15, lg = lane >> 4;
  const size_t rowbase = (size_t)b * S; const int qw = qb * 256 + 32 * w;
  bf16x8 qf[2][3]; int tq[2]; f32x4 o[2][4]; float m[2], l[2];
#pragma unroll
  for (int j = 0; j < 2; ++j) { tq[j] = qw + 16 * j + cq; m[j] = -INFINITY; l[j] = 0.f;
#pragma unroll
    for (int kk = 0; kk < 3; ++kk) qf[j][kk] = *(const bf16x8*)(X.QM() + (rowbase + tq[j]) * 768 + 96 * h + 32 * kk + 8 * lg);
#pragma unroll
    for (int dt = 0; dt < 4; ++dt) o[j][dt] = (f32x4){0.f, 0.f, 0.f, 0.f}; }
  SrcMla src{X.KVM(), X.PROJ(), rowbase, h};
  const float c = 0.10206207261596577f * LOG2E;
  attn_block_loop<2, 96, 64, MODE_CAUSAL, 3, SrcMla>(lds, src, o, m, l, qf, tq, 0, 4 * (qb + 1), 0, qw, qw + 31, c, 0);
#pragma unroll
  for (int j = 0; j < 2; ++j) { const float lt = lsum4(l[j]); const float inv = lt > 0.f ? 1.0f / lt : 0.f;
#pragma unroll
    for (int dt = 0; dt < 4; ++dt) store4(X.OC() + (rowbase + tq[j]) * 512 + 64 * h + 16 * dt + 4 * lg, o[j][dt], inv); }
}
struct SrcX { const bf16_t* kv; size_t rowbase; int h;
  __device__ __forceinline__ const bf16_t* kaddr(int krow, int ch) const { return kv + (rowbase + krow) * 1024 + 128 * h + 8 * ch; }
  __device__ __forceinline__ const bf16_t* vaddr(int krow, int ch) const { return kv + (rowbase + krow) * 1024 + 512 + 128 * h + 8 * ch; } };
__device__ __forceinline__ void xattn_unit(LAS unsigned char* lds, const Ctx& X, const bf16_t* xq, bf16_t* ox, int b, int h, int qb) {
  const int tid = otid(), lane = tid & 63, w = __builtin_amdgcn_readfirstlane(tid >> 6), cq = lane & 15, lg = lane >> 4;
  const size_t rowbase = (size_t)b * S; const int qw = qb * 256 + 32 * w;
  bf16x8 qf[2][4]; int tq[2]; f32x4 o[2][8]; float m[2], l[2];
#pragma unroll
  for (int j = 0; j < 2; ++j) { tq[j] = qw + 16 * j + cq; m[j] = -INFINITY; l[j] = 0.f;
#pragma unroll
    for (int kk = 0; kk < 4; ++kk) qf[j][kk] = *(const bf16x8*)(xq + (rowbase + tq[j]) * 512 + 128 * h + 32 * kk + 8 * lg);
#pragma unroll
    for (int dt = 0; dt < 8; ++dt) o[j][dt] = (f32x4){0.f, 0.f, 0.f, 0.f}; }
  SrcX src{X.MEMKV(), (size_t)b * 256, h};
  const float c = 0.08838834764831845f * LOG2E;
  attn_block_loop<2, 128, 128, MODE_NONE, 2, SrcX>(lds, src, o, m, l, qf, tq, 0, 4, 0, 0, 0, c, 0);
#pragma unroll
  for (int j = 0; j < 2; ++j) { const float lt = lsum4(l[j]); const float inv = lt > 0.f ? 1.0f / lt : 0.f;
#pragma unroll
    for (int dt = 0; dt < 8; ++dt) store4(ox + (rowbase + tq[j]) * 512 + 128 * h + 16 * dt + 4 * lg, o[j][dt], inv); }
}
struct SrcProj { const bf16_t* proj; size_t rowbase; int kcol, vcol;
  __device__ __forceinline__ const bf16_t* kaddr(int krow, int ch) const { return proj + (rowbase + krow) * NPROJ + kcol + 8 * ch; }
  __device__ __forceinline__ const bf16_t* vaddr(int krow, int ch) const { return proj + (rowbase + krow) * NPROJ + vcol + 8 * ch; } };
__device__ __forceinline__ void swa_unit(LAS unsigned char* lds, const Ctx& X, const float* sinks, int b, int kvh, int qb) {
  const int tid = otid(), lane = tid & 63, w = __builtin_amdgcn_readfirstlane(tid >> 6), cq = lane & 15, lg = lane >> 4;
  const size_t rowbase = (size_t)b * S; const int q0 = qb * 128, qw = q0 + 16 * w;
  bf16x8 qf[4][2]; int tq[4]; f32x4 o[4][4]; float m[4], l[4];
#pragma unroll
  for (int j = 0; j < 4; ++j) { tq[j] = qw + cq; m[j] = sinks[4 * kvh + j] * 8.0f; l[j] = (lg == 0) ? 1.0f : 0.f;
#pragma unroll
    for (int kk = 0; kk < 2; ++kk) qf[j][kk] = *(const bf16x8*)(X.PROJ() + (rowbase + tq[j]) * NPROJ + C_AQ + 64 * (4 * kvh + j) + 32 * kk + 8 * lg);
#pragma unroll
    for (int dt = 0; dt < 4; ++dt) o[j][dt] = (f32x4){0.f, 0.f, 0.f, 0.f}; }
  const int kbase = q0 - 128;
  SrcProj src{X.PROJ(), rowbase + kbase, C_AK + 64 * kvh, C_AV + 64 * kvh};
  const float c = 0.125f * LOG2E;
  attn_block_loop<4, 64, 64, MODE_WINDOW, 2, SrcProj>(lds, src, o, m, l, qf, tq, q0 == 0 ? 2 : 0, 4, kbase, qw, qw + 15, c, 128);
#pragma unroll
  for (int j = 0; j < 4; ++j) { const float lt = lsum4(l[j]); const float inv = lt > 0.f ? 1.0f / lt : 0.f;
#pragma unroll
    for (int dt = 0; dt < 4; ++dt) store4(X.OA() + (rowbase + tq[j]) * 512 + 64 * (4 * kvh + j) + 16 * dt + 4 * lg, o[j][dt], inv); }
}

struct SrcCmp { const bf16_t* k; const bf16_t* v;
  __device__ __forceinline__ const bf16_t* kaddr(int krow, int ch) const { return k + (size_t)krow * 64 + 8 * ch; }
  __device__ __forceinline__ const bf16_t* vaddr(int krow, int ch) const { return v + (size_t)krow * 64 + 8 * ch; } };
constexpr int NSA_BUF = 2 * (64 * 144 + 64 * 160);
constexpr int NSA_IMP = 16 * 132 * 4;
static_assert(NSA_BUF + 8 * NSA_IMP <= LDS_BYTES, "nsa lds");

template <bool MASK>
__device__ __forceinline__ void cmp_imp_chunk(const bf16x8 (&qf)[4][2], LAS const unsigned char* Kl, int kpos0, int tq, const float (&mc)[4], const float (&inv)[4], float c,
                                              float& carry_prev, LAS float* imp_row, int lane) {
  const int r = lane & 15, lg = lane >> 4; const int src = (lane + 48) & 63;
#pragma unroll
  for (int st = 0; st < 2; ++st)
#pragma unroll
    for (int t = 0; t < 2; ++t) {
      f32x4 s[4];
#pragma unroll
      for (int kk = 0; kk < 2; ++kk) { const bf16x8 kf = *(LAS const bf16x8*)(Kl + (32 * st + 16 * t + r) * 144 + (32 * kk + 8 * lg) * 2);
#pragma unroll
        for (int j = 0; j < 4; ++j) s[j] = mfma16(kf, qf[j][kk], kk == 0 ? (f32x4){0.f, 0.f, 0.f, 0.f} : s[j]); }
      float ps[4];
#pragma unroll
      for (int i = 0; i < 4; ++i) { const int kp = kpos0 + 32 * st + 16 * t + 4 * lg + i; float a = 0.f;
#pragma unroll
        for (int j = 0; j < 4; ++j) a += ex2(s[j][i] * c - mc[j]) * inv[j];
        ps[i] = (!MASK || (16 * kp + 31 <= tq)) ? a : 0.f; }
      const float own = 2.0f * (ps[0] + ps[1] + ps[2]) + ps[3];
      const float up_same = __shfl(ps[3], src), up_prev = __shfl(carry_prev, src);
      const float cin = lg > 0 ? up_same : up_prev;
      carry_prev = ps[3];
      imp_row[((kpos0 + 32 * st + 16 * t) >> 2) + lg] = own + cin;
    }
}

__device__ __forceinline__ void nsa_unit(LAS unsigned char* lds, const Ctx& X, bf16_t* OB, int b, int g, int qb) {
  const int tid = otid(), lane = tid & 63, w = __builtin_amdgcn_readfirstlane(tid >> 6);
#define cq ((otid() & 63) & 15)
#define lg ((otid() & 63) >> 4)
  const size_t rowbase = (size_t)b * S; const int q0 = qb * 128, qw = q0 + 16 * w;
#define tqc (qw + cq)
#define myrow (rowbase + (size_t)tqc)
  const float c = 0.125f * LOG2E;
  LAS float* impw = (LAS float*)(lds + NSA_BUF + w * NSA_IMP);
  int tq[4];
#pragma unroll
  for (int j = 0; j < 4; ++j) tq[j] = tqc;
  for (int i = lane; i < 16 * 132; i += 64) impw[i] = 0.f;
#ifndef NSA_NO_A
  {
    bf16x8 qf[4][2]; f32x4 o[4][4]; float m[4], l[4];
#pragma unroll
    for (int j = 0; j < 4; ++j) { m[j] = -INFINITY; l[j] = 0.f;
#pragma unroll
      for (int kk = 0; kk < 2; ++kk) qf[j][kk] = *(const bf16x8*)(X.PROJ() + myrow * NPROJ + C_BQ + 64 * (4 * g + j) + 32 * kk + 8 * lg);
#pragma unroll
      for (int dt = 0; dt < 4; ++dt) o[j][dt] = (f32x4){0.f, 0.f, 0.f, 0.f}; }
    SrcCmp src{X.KCMP() + (size_t)(b * 2 + g) * 512 * 64, X.VCMP() + (size_t)(b * 2 + g) * 512 * 64};
    const int ncb = 8 * qb + 7, nch = (ncb + 63) >> 6;
    attn_block_loop<4, 64, 64, MODE_CMP, 1, SrcCmp>(lds, src, o, m, l, qf, tq, 0, nch, 0, qw, qw + 15, c, 0);
    float mc[4], inv[4];
#pragma unroll
    for (int j = 0; j < 4; ++j) { const float lt = lsum4(l[j]); inv[j] = lt > 0.f ? 1.0f / lt : 0.f; mc[j] = ((m[j] == -INFINITY) ? 0.f : m[j]) * c;
      const float g0 = sigmoidf_(bf2f(X.PROJ()[myrow * NPROJ + C_BG + 3 * (4 * g + j) + 0])); const float sc = inv[j] * g0;
#pragma unroll
      for (int dt = 0; dt < 4; ++dt) store4(OB + myrow * 512 + 64 * (4 * g + j) + 16 * dt + 4 * lg, o[j][dt], sc); }
    {
      constexpr int KB = 64 * 144, BUF = KB + 64 * 160;
      float carry = 0.f;
      u32x4 kreg;
      { const int row = tid >> 3, ch = tid & 7; kreg = *(const u32x4*)src.kaddr(row, ch); }
      for (int kc = 0; kc < nch; ++kc) {
        LAS unsigned char* buf = lds + (kc & 1) * BUF;
        { const int row = tid >> 3, ch = tid & 7; *(LAS u32x4*)(buf + row * 144 + ch * 16) = kreg; if (kc + 1 < nch) kreg = *(const u32x4*)src.kaddr((kc + 1) * 64 + row, ch); }
        LBAR();
        const int lo = 64 * kc, hi = lo + 63;
        const bool rel = 16 * lo + 31 <= qw + 15, full = 16 * hi + 31 <= qw;
        if (rel) { if (full) cmp_imp_chunk<false>(qf, buf, lo, tqc, mc, inv, c, carry, impw + cq * 132, lane);
                   else cmp_imp_chunk<true>(qf, buf, lo, tqc, mc, inv, c, carry, impw + cq * 132, lane); }
      }
      LBAR();
    }
  }
#endif
#ifndef NSA_NO_C
  {
    for (int idx = lane; idx < 16 * 128; idx += 64) { const int q = idx >> 7, j = idx & 127; const int t = qw + q, cur = t >> 6;
      const float v = impw[q * 132 + j]; const bool forced = (j == 0) || (j == cur) || (j == cur - 1);
      impw[q * 132 + j] = (j > cur) ? -INFINITY : v + (forced ? 1e4f : 0.f); }
    LWAIT();
    for (int idx = lane; idx < 16 * 128; idx += 64) { const int qq = idx >> 7, j = idx & 127; const unsigned u = __float_as_uint(impw[qq * 132 + j]);
      const unsigned ok = (u & 0x80000000u) ? ~u : (u | 0x80000000u); ((LAS unsigned*)impw)[qq * 132 + j] = (ok & ~127u) | (unsigned)(127 - j); }
    LWAIT();
    const int q = lane >> 2, part = lane & 3;
    unsigned sj[32];
    LAS const unsigned* keyw = (LAS const unsigned*)impw;
#pragma unroll
    for (int jj = 0; jj < 32; ++jj) sj[jj] = keyw[q * 132 + 32 * part + jj];
    unsigned thr = 0u;
#pragma unroll 1
    for (int bit = 31; bit >= 0; --bit) {
      const unsigned cand = thr | (1u << bit); int cn = 0;
#pragma unroll
      for (int jj = 0; jj < 32; ++jj) cn += (sj[jj] >= cand) ? 1 : 0;
      cn += __shfl_xor(cn, 1); cn += __shfl_xor(cn, 2);
      thr = (cn >= 16) ? cand : thr;
    }
    int mine = 0;
#pragma unroll
    for (int jj = 0; jj < 32; ++jj) mine += (sj[jj] >= thr) ? 1 : 0;
    const int c0 = __shfl(mine, (lane & ~3) + 0), c1 = __shfl(mine, (lane & ~3) + 1), c2 = __shfl(mine, (lane & ~3) + 2);
    int slot = (part > 0 ? c0 : 0) + (part > 1 ? c1 : 0) + (part > 2 ? c2 : 0);
    unsigned char* sell = X.SELL() + ((rowbase + qw + q) * 2 + g) * 16;
#pragma unroll
    for (int jj = 0; jj < 32; ++jj) if (sj[jj] >= thr) { sell[slot] = (unsigned char)((32 * part + jj) | (((sj[jj] & ~127u) == 0x007FFF80u) ? 128 : 0)); ++slot; }
    LWAIT();
  }
#endif
#ifndef NSA_NO_E

  {
    bf16x8 qf[4][2]; f32x4 o[4][4]; float m[4], l[4];
#pragma unroll
    for (int j = 0; j < 4; ++j) { m[j] = -INFINITY; l[j] = 0.f;
#pragma unroll
      for (int kk = 0; kk < 2; ++kk) qf[j][kk] = *(const bf16x8*)(X.QROT() + myrow * 512 + 64 * (4 * g + j) + 32 * kk + 8 * lg);
#pragma unroll
      for (int dt = 0; dt < 4; ++dt) o[j][dt] = (f32x4){0.f, 0.f, 0.f, 0.f}; }
    const int kbase = q0 - 512;
    SrcProj src{X.PROJ(), rowbase + kbase, C_BKW + 64 * g, C_BVW + 64 * g};
    const int kc0 = kbase < 0 ? (-kbase) >> 6 : 0;
    attn_block_loop<4, 64, 64, MODE_WINDOW, 1, SrcProj>(lds, src, o, m, l, qf, tq, kc0, 10, kbase, qw, qw + 15, c, 512);
#pragma unroll
    for (int j = 0; j < 4; ++j) { const float lt = lsum4(l[j]); const float inv = lt > 0.f ? 1.0f / lt : 0.f;
      const float g2 = sigmoidf_(bf2f(X.PROJ()[myrow * NPROJ + C_BG + 3 * (4 * g + j) + 2])); const float sc = inv * g2;
#pragma unroll
      for (int dt = 0; dt < 4; ++dt) store4(X.OW() + myrow * 512 + 64 * (4 * g + j) + 16 * dt + 4 * lg, o[j][dt], sc); }
  }
#endif
  LBAR();
}
#undef cq
#undef lg
#undef tqc
#undef myrow

struct SelFrag { u32x4 kf[4]; u32x4 vf[4]; };
__device__ __forceinline__ void sel_load(SelFrag& F, const bf16_t* kst, const bf16_t* vst, int blk, int cq, int lg) {
  const unsigned char* kp = (const unsigned char*)kst + (size_t)blk * 4096 + (cq * 4 + lg) * 16;
  const unsigned char* vp = (const unsigned char*)vst + (size_t)blk * 4096 + (cq * 4 + lg) * 16;
#pragma unroll
  for (int t4 = 0; t4 < 4; ++t4) F.kf[t4] = *(const u32x4*)(kp + t4 * 1024);
#pragma unroll
  for (int dt = 0; dt < 4; ++dt) F.vf[dt] = *(const u32x4*)(vp + dt * 1024);
}
__device__ __forceinline__ void sel_compute(const SelFrag& F, const long (&qs)[2], f32x4 (&os)[4], float& m, float& l, int blk, int cur, int t, int lg, float c) {
  f32x4 s[4];
#pragma unroll
  for (int t4 = 0; t4 < 4; ++t4) { s[t4] = mfma16_fp8(as_long(F.kf[t4].x, F.kf[t4].y), qs[0], (f32x4){0.f, 0.f, 0.f, 0.f}); s[t4] = mfma16_fp8(as_long(F.kf[t4].z, F.kf[t4].w), qs[1], s[t4]); }
  float mx = -INFINITY;
#pragma unroll
  for (int t4 = 0; t4 < 4; ++t4)
#pragma unroll
    for (int i = 0; i < 4; ++i) { if (blk == cur) { const int key = 64 * blk + 16 * t4 + 4 * lg + i; if (key > t) s[t4][i] = -INFINITY; } mx = fmaxf(mx, s[t4][i]); }
  mx = max_x16_x32(mx);
  if (__any(mx > m + 8.0f / c)) {
    const float mnew = fmaxf(m, mx), ms2 = (mnew == -INFINITY) ? 0.f : mnew, alpha = ex2((m - ms2) * c);
    m = mnew; l *= alpha;
#pragma unroll
    for (int dt = 0; dt < 4; ++dt) os[dt] *= alpha;
  }
  const float mcc = ((m == -INFINITY) ? 0.f : m) * c;
  float p[4][4], ps = 0.f;
#pragma unroll
  for (int t4 = 0; t4 < 4; ++t4)
#pragma unroll
    for (int i = 0; i < 4; ++i) { p[t4][i] = ex2(s[t4][i] * c - mcc); ps += p[t4][i]; }
  l += ps;
  const u32x2 pa = pack8_fp8(p[0], p[1]), pb = pack8_fp8(p[2], p[3]);
  const long pf0 = as_long(pa.x, pa.y), pf1 = as_long(pb.x, pb.y);
#pragma unroll
  for (int dt = 0; dt < 4; ++dt) { os[dt] = mfma16_fp8(as_long(F.vf[dt].x, F.vf[dt].y), pf0, os[dt]); os[dt] = mfma16_fp8(as_long(F.vf[dt].z, F.vf[dt].w), pf1, os[dt]); }
}
__device__ __forceinline__ int sel_slot(const u32x4& sl, int slot) {
  const unsigned wsel = slot < 4 ? sl.x : slot < 8 ? sl.y : slot < 12 ? sl.z : sl.w;
  return __builtin_amdgcn_readfirstlane((int)((wsel >> (8 * (slot & 3))) & 127u));
}
__device__ __forceinline__ void nsa_sel_phase(const Ctx& X, bf16_t* OBp) {
  const int tid = otid(), lane = tid & 63, cq = lane & 15, lg = lane >> 4, hcol = lane & 3;
  const int w = __builtin_amdgcn_readfirstlane(tid >> 6);
  const float c = 0.125f * LOG2E;
  const bool xmap = (X.G % 8) == 0;
  const int npw = xmap ? (X.G / 8) * 8 : X.G * 8;
  const int wi = xmap ? (X.blk / 8) * 8 + w : X.blk * 8 + w;
  const int ntask = xmap ? S : T * 2;
#define SEL_DECODE(kk_, b_, g_, t_) do { if (xmap) { const int pr = X.blk & 7; b_ = pr >> 1; g_ = pr & 1; t_ = (kk_); } else { const int rowi = (kk_) >> 1; g_ = (kk_) & 1; b_ = rowi >> 13; t_ = rowi & 8191; } } while (0)
  int k = wi;
  if (k >= ntask) return;
  SelFrag FA, FB;
  u32x4 sl, sln;
  { int b, g, t; SEL_DECODE(k, b, g, t); sl = *(const u32x4*)(X.SELL() + (((size_t)b * S + t) * 2 + g) * 16); sln = sl;
    sel_load(FA, (const bf16_t*)((const unsigned char*)X.KST() + (size_t)(b * 2 + g) * 128 * 4096), (const bf16_t*)((const unsigned char*)X.VST() + (size_t)(b * 2 + g) * 128 * 4096), sel_slot(sl, 0), cq, lg); }
  for (; k < ntask; k += npw) {
    int b, g, t; SEL_DECODE(k, b, g, t);
    const int cur = t >> 6; const int nv = cur + 1 < 16 ? cur + 1 : 16;
    const size_t rowbase = (size_t)b * S, row = rowbase + t;
    const bf16_t* projk = (const bf16_t*)((const unsigned char*)X.KST() + (size_t)(b * 2 + g) * 128 * 4096);
    const bf16_t* vst = (const bf16_t*)((const unsigned char*)X.VST() + (size_t)(b * 2 + g) * 128 * 4096);
    const int kn = k + npw; int bn = b, gn = g, tn = t;
    if (kn < ntask) { SEL_DECODE(kn, bn, gn, tn); sln = *(const u32x4*)(X.SELL() + (((size_t)bn * S + tn) * 2 + gn) * 16); }
    long qs[2];
#pragma unroll
    for (int kk = 0; kk < 2; ++kk) { const u32x4 qw4 = *(const u32x4*)(X.QROT() + row * 512 + 64 * (4 * g + hcol) + 32 * kk + 8 * lg);
      const float a4[4] = {bflo(qw4.x), bfhi(qw4.x), bflo(qw4.y), bfhi(qw4.y)}, b4[4] = {bflo(qw4.z), bfhi(qw4.z), bflo(qw4.w), bfhi(qw4.w)};
      const u32x2 q8 = pack8_fp8(a4, b4); qs[kk] = as_long(q8.x, q8.y); }
    float m = -INFINITY, l = 0.f; f32x4 os[4];
#pragma unroll
    for (int dt = 0; dt < 4; ++dt) os[dt] = (f32x4){0.f, 0.f, 0.f, 0.f};
    int blkA = sel_slot(sl, 0), blkB = 0;
    for (int sidx = 0; sidx < nv; sidx += 2) {
      const bool hasB = sidx + 1 < nv;
      if (hasB) { blkB = sel_slot(sl, sidx + 1); sel_load(FB, projk, vst, blkB, cq, lg); }
      sel_compute(FA, qs, os, m, l, blkA, cur, t, lg, c);
      if (hasB) {
        if (sidx + 2 < nv) { blkA = sel_slot(sl, sidx + 2); sel_load(FA, projk, vst, blkA, cq, lg); }
        sel_compute(FB, qs, os, m, l, blkB, cur, t, lg, c);
      }
    }
    if (kn < ntask) sel_load(FA, (const bf16_t*)((const unsigned char*)X.KST() + (size_t)(bn * 2 + gn) * 128 * 4096), (const bf16_t*)((const unsigned char*)X.VST() + (size_t)(bn * 2 + gn) * 128 * 4096), sel_slot(sln, 0), cq, lg);
    const float lt = lsum4(l); const float inv = lt > 0.f ? 1.0f / lt : 0.f;
    const float g1 = sigmoidf_(bf2f(X.PROJ()[row * NPROJ + C_BG + 3 * (4 * g + hcol) + 1]));
    if (cq < 4) {
      const float sc = inv * g1;
      u32x2 av[4], wv[4];
#pragma unroll
      for (int dt = 0; dt < 4; ++dt) { const size_t off = row * 512 + 64 * (4 * g + cq) + 16 * dt + 4 * lg; av[dt] = *(const u32x2*)(OBp + off); wv[dt] = *(const u32x2*)(X.OW() + off); }
#pragma unroll
      for (int dt = 0; dt < 4; ++dt) { const size_t off = row * 512 + 64 * (4 * g + cq) + 16 * dt + 4 * lg; const u32x2 a = av[dt], w2 = wv[dt];
        f32x4 v = os[dt] * sc; v[0] += bflo(a.x) + bflo(w2.x); v[1] += bfhi(a.x) + bfhi(w2.x); v[2] += bflo(a.y) + bflo(w2.y); v[3] += bfhi(a.y) + bfhi(w2.y);
        store4(OBp + off, v, 1.0f); }
    }
    sl = sln;
  }
#undef SEL_DECODE
}

__device__ __forceinline__ void nsa_compress_task(LAS unsigned char* lds, const Ctx& X, const float* pe_k, const float* pe_v, int task) {
  const int tid = otid(), lane = tid & 63, w = __builtin_amdgcn_readfirstlane(tid >> 6), r = lane & 15, lg = lane >> 4;
  const int kind = task >> 8, rem = task & 255, b = rem >> 6, g = (rem >> 5) & 1, c0 = (rem & 31) * 16;
  const float* pe = kind ? pe_v : pe_k; const bf16_t* w1 = X.W() + (kind ? W_V1 : W_K1); const bf16_t* w2 = X.W() + (kind ? W_V2 : W_K2);
  const int col = (kind ? C_BVC : C_BKC) + 64 * g;
  LAS float* red = (LAS float*)lds;
  LAS bf16_t* h1 = (LAS bf16_t*)(lds + 8 * 16 * 64 * 4);
  f32x4 acc[4];
#pragma unroll
  for (int nt = 0; nt < 4; ++nt) acc[nt] = (f32x4){0.f, 0.f, 0.f, 0.f};
  const int cmy = c0 + r;
#pragma unroll 2
  for (int k8 = 0; k8 < 8; ++k8) { const int kk = 8 * w + k8; const int lt = kk >> 1, d = (kk & 1) * 32 + 8 * lg;
    int tok = 16 * cmy + lt; tok = tok > S - 1 ? S - 1 : tok;
    const u32x4 kv = *(const u32x4*)(X.PROJ() + ((size_t)b * S + tok) * NPROJ + col + d);
    const f32x4 pa = *(const f32x4*)(pe + lt * 64 + d), pb = *(const f32x4*)(pe + lt * 64 + d + 4);
    u32x4 aw; aw.x = cvt_pk_bf16(bflo(kv.x) + pa[0], bfhi(kv.x) + pa[1]); aw.y = cvt_pk_bf16(bflo(kv.y) + pa[2], bfhi(kv.y) + pa[3]);
    aw.z = cvt_pk_bf16(bflo(kv.z) + pb[0], bfhi(kv.z) + pb[1]); aw.w = cvt_pk_bf16(bflo(kv.w) + pb[2], bfhi(kv.w) + pb[3]);
    const bf16x8 af = __builtin_bit_cast(bf16x8, aw);
#pragma unroll
    for (int nt = 0; nt < 4; ++nt) { const bf16x8 bfr = *(const bf16x8*)(w1 + (size_t)(16 * nt + r) * 2048 + 32 * kk + 8 * lg); acc[nt] = mfma16(af, bfr, acc[nt]); }
  }
#pragma unroll
  for (int nt = 0; nt < 4; ++nt)
#pragma unroll
    for (int i = 0; i < 4; ++i) red[(w * 16 + 4 * lg + i) * 64 + 16 * nt + r] = acc[nt][i];
  LBAR();
  for (int e = tid; e < 1024; e += 512) { float sacc = 0.f;
#pragma unroll
    for (int ww = 0; ww < 8; ++ww) sacc += red[ww * 1024 + e];
    const float hval = sacc * sigmoidf_(sacc); h1[(e >> 6) * 72 + (e & 63)] = (bf16_t)(cvt_pk_bf16(hval, 0.f) & 0xffffu); }
  LBAR();
  if (w == 0) {
    f32x4 o2[4];
#pragma unroll
    for (int nt = 0; nt < 4; ++nt) o2[nt] = (f32x4){0.f, 0.f, 0.f, 0.f};
#pragma unroll
    for (int kk = 0; kk < 2; ++kk) { const bf16x8 af = *(LAS const bf16x8*)(h1 + r * 72 + 32 * kk + 8 * lg);
#pragma unroll
      for (int nt = 0; nt < 4; ++nt) { const bf16x8 bfr = *(const bf16x8*)(w2 + (16 * nt + r) * 64 + 32 * kk + 8 * lg); o2[nt] = mfma16(af, bfr, o2[nt]); } }
    bf16_t* dst = (kind ? X.VCMP() : X.KCMP()) + ((size_t)(b * 2 + g) * 512 + c0) * 64;
#pragma unroll
    for (int nt = 0; nt < 4; ++nt)
#pragma unroll
      for (int i = 0; i < 4; ++i) dst[(4 * lg + i) * 64 + 16 * nt + r] = (bf16_t)(cvt_pk_bf16(o2[nt][i], 0.f) & 0xffffu);
  }
  LBAR();
}

__device__ __forceinline__ void rms_row_bf16(const float* xrow, const float* gain, bf16_t* orow, int lane) {
  const f32x4* xr = (const f32x4*)xrow + lane; const f32x4* gr = (const f32x4*)gain + lane;
  f32x4 v[4]; float s = 0.f;
#pragma unroll
  for (int j = 0; j < 4; ++j) { v[j] = xr[64 * j]; s += (v[j].x * v[j].x + v[j].y * v[j].y) + (v[j].z * v[j].z + v[j].w * v[j].w); }
  const float rstd = 1.0f / sqrtf(wave_sum(s) * (1.f / 1024.f) + NORM_EPS);
  u32x2* o8 = (u32x2*)orow + lane;
#pragma unroll
  for (int j = 0; j < 4; ++j) { const f32x4 gg = gr[64 * j]; u32x2 wv; wv.x = cvt_pk_bf16(v[j].x * rstd * gg.x, v[j].y * rstd * gg.y); wv.y = cvt_pk_bf16(v[j].z * rstd * gg.z, v[j].w * rstd * gg.w); o8[64 * j] = wv; }
}
__device__ __forceinline__ void rms_phase(const Ctx& X, const float* src, const float* gain, bf16_t* dst, int rows) {
  const int tid_ = otid(); const int lane = tid_ & 63, gw = X.blk * 8 + (tid_ >> 6), NGW = X.G * 8;
  for (int mrow = gw; mrow < rows; mrow += NGW) rms_row_bf16(src + (size_t)mrow * 1024, gain, dst + (size_t)mrow * 1024, lane);
}
__device__ __forceinline__ void xb_prepass(const Ctx& X, const float* src) {
  const int tid_ = otid(); const int lane = tid_ & 63, gw = X.blk * 8 + (tid_ >> 6), NGW = X.G * 8;
  for (int mrow = gw; mrow < T; mrow += NGW) {
    const f32x4* xr = (const f32x4*)(src + (size_t)mrow * 1024) + lane; u32x2* o8 = (u32x2*)(X.H() + (size_t)mrow * 1024) + lane; float sacc = 0.f;
#pragma unroll
    for (int j = 0; j < 4; ++j) { const f32x4 v = xr[64 * j]; sacc += (v.x * v.x + v.y * v.y) + (v.z * v.z + v.w * v.w); u32x2 wv; wv.x = cvt_pk_bf16(v.x, v.y); wv.y = cvt_pk_bf16(v.z, v.w); o8[64 * j] = wv; }
    sacc = wave_sum(sacc);
    if (lane == 0) *(f32x4*)(X.RSS() + (size_t)mrow * 4) = (f32x4){sacc, 0.f, 0.f, 0.f};
  }
}
__device__ __forceinline__ void final_norm_phase(const Ctx& X, const float* gain) {
  const int tid_ = otid(); const int lane = tid_ & 63, gw = X.blk * 8 + (tid_ >> 6), NGW = X.G * 8;
  for (int mrow = gw; mrow < T; mrow += NGW) {
    f32x4* xr = (f32x4*)(X.out + (size_t)mrow * 1024) + lane; const f32x4* gr = (const f32x4*)gain + lane;
    f32x4 v[4]; float s = 0.f;
#pragma unroll
    for (int j = 0; j < 4; ++j) { v[j] = xr[64 * j]; s += (v[j].x * v[j].x + v[j].y * v[j].y) + (v[j].z * v[j].z + v[j].w * v[j].w); }
    const float rstd = 1.0f / sqrtf(wave_sum(s) * (1.f / 1024.f) + NORM_EPS);
#pragma unroll
    for (int j = 0; j < 4; ++j) { const f32x4 gg = gr[64 * j]; xr[64 * j] = (f32x4){v[j].x * rstd * gg.x, v[j].y * rstd * gg.y, v[j].z * rstd * gg.z, v[j].w * rstd * gg.w}; }
  }
}
__device__ __forceinline__ void mla_norm_phase(const Ctx& X, const float* qg, const float* kvg) {
  const int tid_ = otid(); const int lane = tid_ & 63, gw = X.blk * 8 + (tid_ >> 6), NGW = X.G * 8;
  for (int mrow = gw; mrow < T; mrow += NGW) {
    bf16_t* pr = X.PROJ() + (size_t)mrow * NPROJ;
    u32x4 a = (u32x4){0, 0, 0, 0}, bq = (u32x4){0, 0, 0, 0};
    if (lane < 48) a = *(const u32x4*)(pr + C_CQA + 8 * lane);
    if (lane < 32) bq = *(const u32x4*)(pr + C_CKV + 8 * lane);
    float fa[8] = {bflo(a.x), bfhi(a.x), bflo(a.y), bfhi(a.y), bflo(a.z), bfhi(a.z), bflo(a.w), bfhi(a.w)};
    float fb[8] = {bflo(bq.x), bfhi(bq.x), bflo(bq.y), bfhi(bq.y), bflo(bq.z), bfhi(bq.z), bflo(bq.w), bfhi(bq.w)};
    float sa = 0.f, sb = 0.f;
#pragma unroll
    for (int e = 0; e < 8; ++e) { sa += fa[e] * fa[e]; sb += fb[e] * fb[e]; }
    const float ra = 1.0f / sqrtf(wave_sum(sa) * (1.f / 384.f) + NORM_EPS), rb = 1.0f / sqrtf(wave_sum(sb) * (1.f / 256.f) + NORM_EPS);
    if (lane < 48) { const f32x4 g0 = *(const f32x4*)(qg + 8 * lane), g1 = *(const f32x4*)(qg + 8 * lane + 4); u32x4 wv;
      wv.x = cvt_pk_bf16(fa[0] * ra * g0[0], fa[1] * ra * g0[1]); wv.y = cvt_pk_bf16(fa[2] * ra * g0[2], fa[3] * ra * g0[3]);
      wv.z = cvt_pk_bf16(fa[4] * ra * g1[0], fa[5] * ra * g1[1]); wv.w = cvt_pk_bf16(fa[6] * ra * g1[2], fa[7] * ra * g1[3]); *(u32x4*)(pr + C_CQA + 8 * lane) = wv; }
    if (lane < 32) { const f32x4 g0 = *(const f32x4*)(kvg + 8 * lane), g1 = *(const f32x4*)(kvg + 8 * lane + 4); u32x4 wv;
      wv.x = cvt_pk_bf16(fb[0] * rb * g0[0], fb[1] * rb * g0[1]); wv.y = cvt_pk_bf16(fb[2] * rb * g0[2], fb[3] * rb * g0[3]);
      wv.z = cvt_pk_bf16(fb[4] * rb * g1[0], fb[5] * rb * g1[1]); wv.w = cvt_pk_bf16(fb[6] * rb * g1[2], fb[7] * rb * g1[3]); *(u32x4*)(pr + C_CKV + 8 * lane) = wv; }
  }
}

__device__ __forceinline__ void sincos_precise(float a, float& cs, float& sn) {
  const double x = (double)a; const double k = rint(x * 0.63661977236758134308);
  double rr = fma(-k, 1.57079632679489655800e+00, x); rr = fma(-k, 6.12323399573676603587e-17, rr);
  const double r2 = rr * rr;
  double sp = -1.0 / 1307674368000.0; sp = sp * r2 + 1.0 / 6227020800.0; sp = sp * r2 - 1.0 / 39916800.0; sp = sp * r2 + 1.0 / 362880.0; sp = sp * r2 - 1.0 / 5040.0; sp = sp * r2 + 1.0 / 120.0; sp = sp * r2 - 1.0 / 6.0; sp = sp * r2 + 1.0;
  const double sv = sp * rr;
  double cp = 1.0 / 87178291200.0; cp = cp * r2 - 1.0 / 479001600.0; cp = cp * r2 + 1.0 / 3628800.0; cp = cp * r2 - 1.0 / 40320.0; cp = cp * r2 + 1.0 / 720.0; cp = cp * r2 - 1.0 / 24.0; cp = cp * r2 + 0.5; const double cv = 1.0 - cp * r2;
  const int q = ((int)(long long)k) & 3;
  const double c2 = (q == 0) ? cv : (q == 1) ? -sv : (q == 2) ? -cv : sv;
  const double s2 = (q == 0) ? sv : (q == 1) ? cv : (q == 2) ? -sv : -cv;
  cs = (float)c2; sn = (float)s2;
}
__device__ __forceinline__ void tables_phase(const Ctx& X, const Params& P) {
  const int* pos = (const int*)X.in[2];
  const int gt = X.blk * 512 + otid(), NG = X.G * 512;
  for (int idx = gt; idx < T * 48; idx += NG) {
    const int row = idx / 48, i = idx % 48; const float pf = (float)pos[row];
    float cs, sn;
    if (i < 32) { sincos_precise(pf * P.invf64[i], cs, sn); X.CS64()[(size_t)row * 32 + i] = (f32x2){cs, sn}; }
    else { sincos_precise(pf * P.invf32[i - 32], cs, sn); X.CS32()[(size_t)row * 16 + (i - 32)] = (f32x2){cs, sn}; }
  }
}

enum { CM_ID = 0, CM_INPROJ = 1, CM_QB = 2, CM_GU = 3, CM_IL64 = 4 };
__device__ __forceinline__ int colmap(int kind, int n, int off) {
  if (kind == CM_ID) return off + n;
  if (kind == CM_INPROJ) {
    if (n < 2048) { const int sg = n >> 7; const bool il = (sg <= 4) || (sg >= 6 && sg <= 9) || sg == 12 || sg == 14;
      if (!il) return n; const int hb = n & ~63, o = n & 63; return hb + (o >> 1) + 32 * (o & 1); }
    if (n < 2432) return 2072 + (n - 2048);
    if (n < 2688) return 2456 + (n - 2432);
    if (n < 2720) { const int o = n - 2688; return 2712 + (o >> 1) + 16 * (o & 1); }
    if (n < 2744) return 2048 + (n - 2720);
    return -1;
  }
  if (kind == CM_QB) { const int h = n / 96, o = n % 96; if (o < 64) return n; const int oo = o - 64; return 96 * h + 64 + (oo >> 1) + 16 * (oo & 1); }
  if (kind == CM_GU) { const int j = n >> 3, e = n & 7; return e < 4 ? 4 * j + e : DFF + 4 * j + (e - 4); }
    { const int o = n & 63; return (n & ~63) + (o >> 1) + 32 * (o & 1); }
}
struct WDesc { const float* src; int K, pitch, N, kind, off; size_t dst; };
__device__ __forceinline__ void wconv_tile(LAS float* tl, const WDesc& d, bf16_t* Wb, int tile, const float* gain) {
  const int tid = otid(); const int nb = d.N >> 6; const int kb = tile / nb, nbi = tile % nb; const int k0 = kb * 64, n0 = nbi * 64;
  { const int nn = tid & 63; const int sc = colmap(d.kind, n0 + nn, d.off);
#pragma unroll
    for (int rr = 0; rr < 8; ++rr) { const int kk = (tid >> 6) + 8 * rr; tl[kk * 65 + nn] = sc >= 0 ? d.src[(size_t)(k0 + kk) * d.pitch + sc] * (gain ? gain[k0 + kk] : 1.0f) : 0.f; } }
  LBAR();
  { const int kp = tid & 31;
#pragma unroll
    for (int rr = 0; rr < 4; ++rr) { const int nn = (tid >> 5) + 16 * rr; const unsigned wv = cvt_pk_bf16(tl[(2 * kp) * 65 + nn], tl[(2 * kp + 1) * 65 + nn]);
      *(unsigned*)(Wb + d.dst + (size_t)(n0 + nn) * d.K + k0 + 2 * kp) = wv; } }
  LBAR();
}
__device__ __forceinline__ WDesc wdesc(const float* const* in, size_t L, int i) {
  switch (i) {
    case 0: return WDesc{in[4] + L * 1024 * DIN, 1024, DIN, NPROJ, CM_INPROJ, 0, W_IN};
    case 1: return WDesc{in[4] + L * 1024 * DIN, 1024, DIN, NGATE, CM_ID, 2744, W_G};
    case 2: return WDesc{in[13] + L * 384 * 768, 384, 768, 768, CM_QB, 0, W_QB};
    case 3: return WDesc{in[15] + L * 256 * 1024, 256, 1024, 1024, CM_ID, 0, W_KVB};
    case 4: return WDesc{in[16] + L * 512 * 1024, 512, 1024, 1024, CM_ID, 0, W_BR};
    case 5: return WDesc{in[17] + L * 512 * 1024, 512, 1024, 1024, CM_ID, 0, W_BR + 1024 * 512};
    case 6: return WDesc{in[18] + L * 512 * 1024, 512, 1024, 1024, CM_ID, 0, W_BR + 2 * 1024 * 512};
    case 7: return WDesc{in[19] + L * 1024 * 1024, 1024, 1024, 1024, CM_ID, 0, W_OUT};
    case 8: return WDesc{in[22] + L * 1024 * 512, 1024, 512, 512, CM_ID, 0, W_XQ};
    case 9: return WDesc{in[23] + L * 1024 * 1024, 1024, 1024, 1024, CM_ID, 0, W_XKV};
    case 10: return WDesc{in[24] + L * 512 * 1024, 512, 1024, 1024, CM_ID, 0, W_XO};
    case 11: return WDesc{in[26] + L * 1024 * NGU, 1024, NGU, NGU, CM_GU, 0, W_GU};
    case 12: return WDesc{in[27] + L * DFF * 1024, DFF, 1024, 1024, CM_ID, 0, W_DOWN};
    case 13: return WDesc{in[8] + L * 2048 * 64, 2048, 64, 64, CM_ID, 0, W_K1};
    case 14: return WDesc{in[10] + L * 2048 * 64, 2048, 64, 64, CM_ID, 0, W_V1};
    case 15: return WDesc{in[9] + L * 64 * 64, 64, 64, 64, CM_IL64, 0, W_K2};
    default: return WDesc{in[11] + L * 64 * 64, 64, 64, 64, CM_ID, 0, W_V2};
  }
}
__device__ __forceinline__ int wtiles(int i) {
  constexpr int tl[17] = {16 * 44, 16 * 48, 6 * 12, 4 * 16, 8 * 16, 8 * 16, 8 * 16, 16 * 16, 16 * 8, 16 * 16, 8 * 16, 16 * 88, 44 * 16, 32, 32, 1, 1};
  int r = 0;
#pragma unroll
  for (int k = 0; k < 17; ++k) r = (i == k) ? tl[k] : r;
  return r;
}
__device__ __forceinline__ void wconv_phase(LAS unsigned char* lds, const Ctx& X, int layer) {
  constexpr int TOTAL = 16 * 44 + 16 * 48 + 6 * 12 + 4 * 16 + 3 * 8 * 16 + 16 * 16 + 16 * 8 + 16 * 16 + 8 * 16 + 16 * 88 + 44 * 16 + 32 + 32 + 1 + 1;
  for (int t = X.blk; t < TOTAL; t += X.G) {
    int rem = t, mi = 0;
#pragma unroll 1
    for (; mi < 16; ++mi) { const int n = wtiles(mi); if (rem < n) break; rem -= n; }
    const WDesc d = wdesc(X.in, (size_t)layer, mi);
    const int gi = (mi <= 1) ? 3 : (mi == 8) ? 20 : (mi == 11) ? 25 : -1;
    const float* gain = gi >= 0 ? X.in[gi] + (size_t)layer * 1024 : nullptr;
    wconv_tile((LAS float*)lds, d, X.W(), rem, gain);
  }
}

#define RLX_AGENT __ATOMIC_RELAXED, __HIP_MEMORY_SCOPE_AGENT
#define XB_TMO      128
#define XB_XCNT(j)  (256  + 64 * (j))
#define XB_XSUB(j)  (1280 + 64 * (j))
#define XB_XGEN(j)  (2304 + 64 * (j))
#define XB_TOP      3328
#define XB_TOPGEN   3392
#define XCD_BAR_WORDS 3456
#define XB_SPIN_CAP (1u << 18)

__device__ __forceinline__ unsigned xb_ld(unsigned* p)              { return __hip_atomic_load(p, __ATOMIC_RELAXED, __HIP_MEMORY_SCOPE_AGENT); }
__device__ __forceinline__ unsigned xb_add(unsigned* p, unsigned v) { return __hip_atomic_fetch_add(p, v, __ATOMIC_RELAXED, __HIP_MEMORY_SCOPE_AGENT); }
__device__ __forceinline__ unsigned xb_xcc_id() { return (unsigned)__builtin_amdgcn_s_getreg((3 << 11) | 20) & 0xFu; }
#define XB_SPIN(cond, bar) do { unsigned _sp = 0; while (cond) { __builtin_amdgcn_s_sleep(1); \
    if ((++_sp & 255u) == 0u) { if (xb_ld(&(bar)[XB_TMO])) break; if (_sp > XB_SPIN_CAP) { atomicAdd(&(bar)[XB_TMO], 1u); break; } } } } while (0)

struct XcdBarrier {
    unsigned* bar; unsigned x;
    volatile LAS unsigned* st;
};

__device__ __forceinline__ XcdBarrier xcd_barrier_post(unsigned* bar, volatile LAS unsigned* st) {
    XcdBarrier b; b.bar = bar; b.x = xb_xcc_id(); b.st = st;
    if (threadIdx.x == 0) (void)xb_add(&bar[XB_XCNT(b.x)], 1u);
    return b;
}
__device__ __forceinline__ void xcd_barrier_complete(unsigned* bar, unsigned x, unsigned& nloc, unsigned& nx) {
    const unsigned G = gridDim.x * gridDim.y * gridDim.z;
    unsigned sum, cnt, mine, sp = 0u;
    for (;;) {
        sum = 0u; cnt = 0u; mine = 0u;
#pragma unroll
        for (unsigned j = 0; j < 16; ++j) { const unsigned c = xb_ld(&bar[XB_XCNT(j)]); sum += c; cnt += (c > 0u) ? 1u : 0u; mine = (j == x) ? c : mine; }
        if (sum == G) break;
        __builtin_amdgcn_s_sleep(1);
        if ((++sp & 255u) == 0u) { if (xb_ld(&bar[XB_TMO])) break; if (sp > XB_SPIN_CAP) { atomicAdd(&bar[XB_TMO], 1u); break; } }
    }
    nloc = mine > 0u ? mine : 1u; nx = cnt > 0u ? cnt : 1u;
}

__device__ __forceinline__ void xcd_barrier(const XcdBarrier& b) {
    asm volatile("s_waitcnt vmcnt(0)" ::: "memory");
    __syncthreads();
    if (threadIdx.x == 0) {
        unsigned* bar = b.bar;
        __builtin_amdgcn_s_waitcnt(0);
        unsigned nloc = b.st[0], nx = b.st[1];
        if (nloc == 0u) { xcd_barrier_complete(bar, b.x, nloc, nx); b.st[0] = nloc; b.st[1] = nx; }
        const unsigned old = xb_add(&bar[XB_XSUB(b.x)], 1u);
        const unsigned gen = old / nloc;
        if (old + 1u == (gen + 1u) * nloc) {
            __builtin_amdgcn_fence(__ATOMIC_RELEASE, "agent");
            asm volatile("s_waitcnt vmcnt(0)" ::: "memory");
            const unsigned og = xb_add(&bar[XB_TOP], 1u);
            const unsigned tg = og / nx;
            if (og + 1u == (tg + 1u) * nx) xb_add(&bar[XB_TOPGEN], 1u);
            else XB_SPIN(xb_ld(&bar[XB_TOPGEN]) == tg, bar);
            __builtin_amdgcn_fence(__ATOMIC_ACQUIRE, "agent");
            xb_add(&bar[XB_XGEN(b.x)], 1u);
            asm volatile("s_waitcnt vmcnt(0)" ::: "memory");
        } else {
            XB_SPIN(xb_ld(&bar[XB_XGEN(b.x)]) == gen, bar);
            __builtin_amdgcn_fence(__ATOMIC_ACQUIRE, "agent");
            asm volatile("s_waitcnt vmcnt(0)" ::: "memory");
        }
    }
    __syncthreads();
}


__global__ void __launch_bounds__(512, 2) mega(Params P) {
  extern __shared__ __attribute__((aligned(16))) unsigned char lds_raw[];
  LAS unsigned char* lds = (LAS unsigned char*)lds_raw;
  cg::grid_group grid = cg::this_grid();
  if (threadIdx.x < 16) ((LAS unsigned*)(lds + (LDS_BYTES - 64)))[threadIdx.x] = 0u;
  __syncthreads();
  (void)xcd_barrier_post((unsigned*)(P.ws + WS_BAR), (volatile LAS unsigned*)(lds + (LDS_BYTES - 64)));
#define FRESH() Ctx X; { size_t z_ = 0; asm volatile("" : "+s"(z_)); X.ws = P.ws + z_; X.out = (float*)((unsigned char*)P.out + z_); X.in = P.in; X.G = gridDim.x; X.blk = blockIdx.x; }
#define GSYNC() do { XcdBarrier b_; unsigned zo_ = 0; asm volatile("" : "+s"(zo_)); b_.bar = (unsigned*)(P.ws + WS_BAR) + zo_;     b_.x = xb_xcc_id(); b_.st = (volatile LAS unsigned*)(lds + (LDS_BYTES - 64)); xcd_barrier(b_); } while (0)
#define OB (X.OA() + (size_t)T * 512)
#define GATES X.PROJ()
#define MERGED X.H()
#define XQ X.PROJ()
#define OX (X.PROJ() + (size_t)T * 512)
#define FFH X.PROJ()
#define PIN(k) P.in[oidx(k)]

#ifndef SKIP_TABLES
  { FRESH(); tables_phase(X, P); }
#endif
  if (P.pad0 != 0) grid.sync();
#pragma unroll 1
  for (int layer = 0; layer < DEPTH; ++layer) {
    const size_t L = (size_t)layer;
#define xin ((layer == 0) ? PIN(0) : (const float*)X.out)
    { FRESH();
#ifndef SKIP_WCONV
    wconv_phase(lds, X, layer);
#endif
#ifndef SKIP_RMS1
    if (layer == 0) xb_prepass(X, PIN(0));
    rms_phase(X, PIN(1), PIN(21) + L * 1024, X.HM(), NB * 256);
#endif
    }
    GSYNC();
    { FRESH();
#ifndef SKIP_INPROJ
    { pg8::Gemm g{X.H(), X.W() + W_IN, T, NPROJ, 1024, 1024, 1024}; pg8::StaticOrder So; So.init(T, NPROJ, X.G, X.blk);
      pg8::EpiInproj E{X.PROJ(), X.QROT(), X.VST(), X.KST(), X.CS64(), X.CS32(), X.RSS()}; pg8::gemm_phase(lds, g, So, E); }
#endif
#ifndef SKIP_MEMKV
    { pg8::Gemm g{X.HM(), X.W() + W_XKV, 1024, 1024, 1024, 1024, 1024}; pg8::StaticOrder So; So.init(1024, 1024, X.G, (X.blk + X.G / 2) % X.G);
      pg8::EpiPlain E{X.MEMKV(), 1024, nullptr}; pg8::gemm_phase(lds, g, So, E); }
#endif
    }
    GSYNC();
    { FRESH();
#ifndef SKIP_P3
    mla_norm_phase(X, PIN(12) + L * 384, PIN(14) + L * 256);
    for (int t = X.blk; t < 512; t += X.G) nsa_compress_task(lds, X, PIN(6) + L * 2048, PIN(7) + L * 2048, t);
#endif
    }
    GSYNC();
    { FRESH();
#ifndef SKIP_MLAQ
    { pg8::Gemm g{X.PROJ() + C_CQA, X.W() + W_QB, T, 768, 384, NPROJ, 384}; pg8::StaticOrder So; So.init(T, 768, X.G, X.blk);
      pg8::EpiMlaQ E{X.QM(), X.CS32()}; pg8::gemm_phase(lds, g, So, E); }
#endif
#ifndef SKIP_KVUP
    { pg8::Gemm g{X.PROJ() + C_CKV, X.W() + W_KVB, T, 1024, 256, NPROJ, 256}; pg8::StaticOrder So; So.init(T, 1024, X.G, X.blk);
      pg8::EpiPlain E{X.KVM(), 1024, nullptr}; pg8::gemm_phase(lds, g, So, E); }
#endif
    }
    GSYNC();
    { FRESH();
#ifndef SKIP_MLA
    if (X.G == 256) { const int vcu = (X.blk % 8) * 32 + X.blk / 8; const int bh = vcu >> 3, s = vcu & 7;
      for (int i = 0; i < 4; ++i) { const int qb = (i == 0) ? s : (i == 1) ? 15 - s : (i == 2) ? 16 + s : 31 - s; mla_unit(lds, X, bh >> 3, bh & 7, qb); } }
    else { for (int u = X.blk; u < 1024; u += X.G) mla_unit(lds, X, (u >> 5) >> 3, (u >> 5) & 7, 31 - (u & 31)); }
#endif
    }
    GSYNC();
    { FRESH();
#ifndef SKIP_SWA
    for (int u = X.blk; u < 512; u += X.G) swa_unit(lds, X, PIN(5) + L * 8, u >> 7, (u >> 6) & 1, u & 63);
#endif
#ifndef SKIP_NSA
    for (int u = X.blk; u < 512; u += X.G) { const int uu = u & 255; const int qb = (u < 256) ? 63 - (uu >> 3) : (uu >> 3), bg = uu & 7; nsa_unit(lds, X, OB, bg >> 1, bg & 1, qb); }
#endif
    }
    GSYNC();
    { FRESH();
#ifndef SKIP_NSA
    nsa_sel_phase(X, OB);
#endif
    }
    GSYNC();
    { FRESH();
#ifndef SKIP_GATES
    { pg8::Gemm g{X.H(), X.W() + W_G, T, NGATE, 1024, 1024, 1024}; pg8::StaticOrder So; So.init(T, NGATE, X.G, X.blk);
      pg8::EpiGates E{GATES, X.RSS()}; pg8::gemm_phase(lds, g, So, E); }
#endif
    }
    GSYNC();
    { FRESH();
#ifndef SKIP_MERGE
    { pg8::Gemm g{X.OA(), X.W() + W_BR, 3 * T, 3 * 1024, 512, 512, 512}; pg8::MergeOrder So{X.G, X.blk};
      pg8::EpiMerge E{GATES, MERGED}; pg8::gemm_phase(lds, g, So, E); }
#endif
    }
    GSYNC();
    { FRESH();
#ifndef SKIP_RESID
    { pg8::Gemm g{MERGED, X.W() + W_OUT, T, 1024, 1024, 1024, 1024}; pg8::StaticOrder So; So.init(T, 1024, X.G, X.blk);
      pg8::EpiResid E{xin, X.out, X.KVM(), X.RSS(), (LAS float*)(lds + 131072)}; pg8::gemm_phase(lds, g, So, E); }
#endif
    }
    GSYNC();
    { FRESH();
#ifndef SKIP_XQ
    { pg8::Gemm g{X.KVM(), X.W() + W_XQ, T, 512, 1024, 1024, 1024}; pg8::StaticOrder So; So.init(T, 512, X.G, X.blk);
      pg8::EpiPlain E{XQ, 512, X.RSS()}; pg8::gemm_phase(lds, g, So, E); }
#endif
    }
    GSYNC();
    { FRESH();
#ifndef SKIP_XATT
    for (int u = X.blk; u < 512; u += X.G) xattn_unit(lds, X, XQ, OX, u >> 7, (u >> 5) & 3, u & 31);
#endif
    }
    GSYNC();
    { FRESH();
#ifndef SKIP_XO
    { pg8::Gemm g{OX, X.W() + W_XO, T, 1024, 512, 512, 512}; pg8::StaticOrder So; So.init(T, 1024, X.G, X.blk);
      pg8::EpiResid E{X.out, X.out, X.H(), X.RSS(), (LAS float*)(lds + 131072)}; pg8::gemm_phase(lds, g, So, E); }
#endif
    }
    GSYNC();
    { FRESH();
#ifndef SKIP_SWIGLU
    { pg8::Gemm g{X.H(), X.W() + W_GU, T, NGU, 1024, 1024, 1024}; pg8::StaticOrder So; So.init(T, NGU, X.G, X.blk);
      pg8::EpiSwiglu E{FFH, X.RSS()}; pg8::gemm_phase(lds, g, So, E); }
#endif
    }
    GSYNC();
    { FRESH();
#ifndef SKIP_DOWN
    { pg8::Gemm g{FFH, X.W() + W_DOWN, T, 1024, DFF, DFF, DFF}; pg8::StaticOrder So; So.init(T, 1024, X.G, X.blk);
      pg8::EpiResid E{X.out, X.out, X.H(), X.RSS(), (LAS float*)(lds + 131072)}; pg8::gemm_phase(lds, g, So, E); }
#endif
    }
    GSYNC();
  }
#ifndef SKIP_FINAL
  { FRESH(); final_norm_phase(X, PIN(28)); }
#endif
}

extern "C" void kernel_launch(void* const* d_in, const int* in_sizes, int n_in, void* d_out, int out_size, void* d_ws, size_t ws_size, hipStream_t stream) {
  static int grid_blocks = 0;
  if (!grid_blocks) {
    int dev = 0, cus = 0, per_cu = 0;
    (void)hipGetDevice(&dev);
    (void)hipDeviceGetAttribute(&cus, hipDeviceAttributeMultiprocessorCount, dev);
    (void)hipFuncSetAttribute((const void*)mega, hipFuncAttributeMaxDynamicSharedMemorySize, LDS_BYTES);
    (void)hipOccupancyMaxActiveBlocksPerMultiprocessor(&per_cu, (const void*)mega, 512, LDS_BYTES);
    if (per_cu < 1) per_cu = 1;
    if (per_cu > 1) per_cu = 1;
    grid_blocks = cus * per_cu;
    if (ws_size < WS_END || n_in != 29 || out_size != T * DM) fprintf(stderr, "kernel_launch: unexpected sizes: ws %zu (need %zu) n_in %d out %d\n", ws_size, (size_t)WS_END, n_in, out_size);
  }
  Params p;
  memset(&p, 0, sizeof(p));
  for (int i = 0; i < 29; ++i) p.in[i] = (const float*)d_in[i];
  p.out = (float*)d_out; p.ws = (unsigned char*)d_ws;
  for (int i = 0; i < 32; ++i) p.invf64[i] = (float)pow(10000.0, -(double)i / 32.0);
  for (int i = 0; i < 16; ++i) p.invf32[i] = (float)pow(10000.0, -(double)i / 16.0);
  (void)hipMemsetAsync((char*)d_ws + WS_BAR, 0, BAR_BYTES, stream);
  void* args[] = {&p};
  hipError_t e = hipLaunchCooperativeKernel((const void*)mega, dim3(grid_blocks), dim3(512), args, LDS_BYTES, stream);
  if (e != hipSuccess) fprintf(stderr, "cooperative launch failed: %s (grid %d)\n", hipGetErrorString(e), grid_blocks);
}
```

```cpp
#include <hip/hip_runtime.h>
#include <hip/hip_cooperative_groups.h>
#include <cstdio>
#include <cstdint>
#include <cmath>
#include <cstring>
namespace cg = cooperative_groups;

#define LAS __attribute__((address_space(3)))
typedef unsigned short bf16_t;
typedef short bf16x8 __attribute__((ext_vector_type(8)));
typedef short s16x4 __attribute__((ext_vector_type(4)));
typedef short v4i16_t __attribute__((ext_vector_type(4)));
typedef float f32x4 __attribute__((ext_vector_type(4)));
typedef float f32x2 __attribute__((ext_vector_type(2)));
typedef unsigned u32x4 __attribute__((ext_vector_type(4)));
typedef unsigned u32x2 __attribute__((ext_vector_type(2)));

constexpr int NB = 4, S = 8192, T = NB * S, DM = 1024, DEPTH = 2;
constexpr int DIN = 5816, NPROJ = 2816, NGATE = 3072, DFF = 2816, NGU = 5632;
constexpr int C_AQ = 0, C_AK = 512, C_AV = 640, C_BQ = 768, C_BKC = 1280, C_BVC = 1408, C_BKS = 1536, C_BVS = 1664, C_BKW = 1792, C_BVW = 1920;
constexpr int C_CQA = 2048, C_CKV = 2432, C_CKR = 2688, C_BG = 2720;
constexpr float LOG2E = 1.4426950408889634f;
constexpr float NORM_EPS = 1e-6f;

constexpr size_t MiB = 1u << 20;
constexpr size_t WS_KCMP = 0, WS_VCMP = MiB / 2, WS_MEMKV = 1 * MiB, WS_HM = 3 * MiB;
constexpr size_t WS_SELL = 5 * MiB;
constexpr size_t WS_BAR = 7 * MiB, BAR_BYTES = 16384;
constexpr size_t WS_CS64 = 8 * MiB, WS_CS32 = 16 * MiB;
constexpr size_t WS_W = 20 * MiB;
constexpr size_t WS_RSS = 59 * MiB;
constexpr size_t WS_H = 64 * MiB;
constexpr size_t WS_PROJ = 128 * MiB;
constexpr size_t WS_QM = 304 * MiB;
constexpr size_t WS_KVM = 352 * MiB;
constexpr size_t WS_OC = 416 * MiB;
constexpr size_t WS_QROT = 448 * MiB;
constexpr size_t WS_VST = 480 * MiB;
constexpr size_t WS_KST = 488 * MiB;
constexpr size_t WS_END = 496 * MiB;
constexpr size_t W_IN = 0, W_G = W_IN + (size_t)NPROJ * 1024, W_QB = W_G + (size_t)NGATE * 1024, W_KVB = W_QB + 768 * 384,
                 W_BR = W_KVB + 1024 * 256, W_OUT = W_BR + 3 * 1024 * 512, W_XQ = W_OUT + 1024 * 1024, W_XKV = W_XQ + 512 * 1024,
                 W_XO = W_XKV + 1024 * 1024, W_GU = W_XO + 1024 * 512, W_DOWN = W_GU + (size_t)NGU * 1024, W_K1 = W_DOWN + (size_t)1024 * DFF,
                 W_V1 = W_K1 + 64 * 2048, W_K2 = W_V1 + 64 * 2048, W_V2 = W_K2 + 64 * 64, W_ENDE = W_V2 + 64 * 64;
static_assert(W_ENDE * 2 <= 39 * MiB, "weights fit below the row-statistics buffer");

constexpr int LDS_BYTES = 147456;

typedef __bf16 bf16x2_t __attribute__((ext_vector_type(2)));
__device__ __forceinline__ unsigned cvt_pk_bf16(float lo, float hi) { f32x2 v = {lo, hi}; bf16x2_t b = __builtin_convertvector(v, bf16x2_t); return __builtin_bit_cast(unsigned, b); }
__device__ __forceinline__ float bf2f(unsigned short b) { return __uint_as_float(((unsigned)b) << 16); }
__device__ __forceinline__ float bflo(unsigned w) { return __uint_as_float(w << 16); }
__device__ __forceinline__ float bfhi(unsigned w) { return __uint_as_float(w & 0xffff0000u); }
__device__ __forceinline__ float ex2(float x) { return __builtin_amdgcn_exp2f(x); }
__device__ __forceinline__ float sigmoidf_(float x) { return __builtin_amdgcn_rcpf(1.0f + ex2(-x * LOG2E)); }
__device__ __forceinline__ float wave_sum(float v) {
#pragma unroll
  for (int o = 1; o < 64; o <<= 1) v += __shfl_xor(v, o);
  return v;
}
__device__ __forceinline__ int otid() { int t = threadIdx.x; asm volatile("" : "+v"(t)); return t; }
__device__ __forceinline__ int oidx(int k) { asm volatile("" : "+s"(k)); return k; }
#define LBAR() asm volatile("s_waitcnt lgkmcnt(0)\n\ts_barrier" ::: "memory")
#define LWAIT() asm volatile("s_waitcnt lgkmcnt(0)" ::: "memory")

__device__ __forceinline__ u32x2 pack8_fp8(const float (&a)[4], const float (&b)[4]) {
  int w0 = __builtin_amdgcn_cvt_pk_fp8_f32(a[0], a[1], 0, false); w0 = __builtin_amdgcn_cvt_pk_fp8_f32(a[2], a[3], w0, true);
  int w1 = __builtin_amdgcn_cvt_pk_fp8_f32(b[0], b[1], 0, false); w1 = __builtin_amdgcn_cvt_pk_fp8_f32(b[2], b[3], w1, true);
  return (u32x2){(unsigned)w0, (unsigned)w1};
}
__device__ __forceinline__ long as_long(unsigned lo, unsigned hi) { return (long)(((unsigned long long)hi << 32) | (unsigned long long)lo); }
__device__ __forceinline__ f32x4 mfma16_fp8(long a, long b, f32x4 c) { return __builtin_amdgcn_mfma_f32_16x16x32_fp8_fp8(a, b, c, 0, 0, 0); }

__device__ __forceinline__ float xor32(float v) { const unsigned u = __float_as_uint(v); auto rr = __builtin_amdgcn_permlane32_swap(u, u, false, false); return __uint_as_float((threadIdx.x & 32) ? rr[0] : rr[1]); }
__device__ __forceinline__ float xor16(float v) { const unsigned u = __float_as_uint(v); auto rr = __builtin_amdgcn_permlane16_swap(u, u, false, false); return __uint_as_float((threadIdx.x & 16) ? rr[0] : rr[1]); }
__device__ __forceinline__ float max_x16_x32(float v) { const unsigned u = __float_as_uint(v); auto a = __builtin_amdgcn_permlane16_swap(u, u, false, false); const float w = fmaxf(__uint_as_float(a[0]), __uint_as_float(a[1]));
  const unsigned u2 = __float_as_uint(w); auto b = __builtin_amdgcn_permlane32_swap(u2, u2, false, false); return fmaxf(__uint_as_float(b[0]), __uint_as_float(b[1])); }

namespace pg8 {
constexpr int BM = 256, BK = 64, HALF = 128, HTB = HALF * BK * 2, STAGE_BYTES = 8 * HTB, NXCD = 8, WGM = 8;
__device__ __forceinline__ int lds_byte(int r, int c) { const int st = (r >> 4) * 2 + (c >> 5), rr = r & 15, cc = c & 31, ob = rr * 64 + cc * 2; return st * 1024 + (ob ^ (((ob >> 9) & 1) << 5)); }
__device__ __forceinline__ void stage_rc(int b, int& R, int& C) { const int st = b / 1024, sb = b % 1024, swz = sb ^ (((sb >> 9) & 1) << 5); R = (st >> 1) * 16 + swz / 64; C = (st & 1) * 32 + (swz % 64) / 2; }
__device__ __forceinline__ int perm32(int rho) { const int n = rho >> 4, i = rho & 15; return 8 * (i >> 2) + 4 * n + (i & 3); }
struct Unit { int pm, pn; };
struct Gemm { const bf16_t* A; const bf16_t* Bt; int M, N, K, lda, ldb; };
__device__ __forceinline__ void tile_of(int L, int nM, int nN, Unit& u) {
  const int nwg = nM * nN; int wgid = L;
  { const int q = nwg / NXCD, r = nwg % NXCD, xcd = wgid % NXCD, off = wgid / NXCD; wgid = (xcd < r ? xcd * (q + 1) : r * (q + 1) + (xcd - r) * q) + off; }
  const int nig = WGM * nN, gid = wgid / nig, fm = gid * WGM, gsz = (nM - fm) < WGM ? (nM - fm) : WGM;
  u.pm = fm + ((wgid % nig) % gsz); u.pn = (wgid % nig) / gsz;
}
struct StaticOrder {
  int nM, nN, nwg, G, c;
  __device__ void init(int M, int N, int G_, int c_) { nM = M / BM; nN = N / BM; nwg = nM * nN; G = G_; c = c_; }
  __device__ __forceinline__ bool next(int i, Unit& u) const { const long L = (long)i * G + c; if (L >= nwg) return false; tile_of((int)L, nM, nN, u); return true; }
};
struct MergeOrder {
  int G, c;
  __device__ __forceinline__ bool next(int k, Unit& u) const { const int r = k / 3, i = k - 3 * r; const int L = r * G + c; if (L >= 512) return false; Unit t; tile_of(L, 128, 4, t); u.pm = i * 128 + t.pm; u.pn = i * 4 + t.pn; return true; }
};

template <class Epi, class Sched>
__device__ __forceinline__ void gemm_phase(LAS unsigned char* lds, const Gemm g, const Sched& S, const Epi& E) {
  const int tid = otid(), wid = __builtin_amdgcn_readfirstlane(tid >> 6), lane = tid & 63, wr = wid >> 2, wc = wid & 3, fr = lane & 15, fq = lane >> 4;
  const int K = g.K, nt = K / BK;
  unsigned voffA[2], voffB[2];
#pragma unroll
  for (int i = 0; i < 2; ++i) { int R, C; stage_rc(tid * 16 + i * 8192, R, C); const int Rb = (R & ~31) + perm32(R & 31);
    voffA[i] = (unsigned)(R * g.lda + C) * 2u; voffB[i] = (unsigned)(Rb * g.ldb + C) * 2u; }
  const size_t kstep = (size_t)(BK * 2);
  const size_t hstepA = (size_t)HALF * g.lda * 2, hstepB = (size_t)HALF * g.ldb * 2;
  const size_t tstepA = 2 * hstepA, tstepB = 2 * hstepB;
  const unsigned ldsw = (unsigned)wid * 1024u;
  const int aoff = lds_byte(wr * 64 + fr, fq * 8), boff = lds_byte(wc * 32 + fr, fq * 8);
#define PG8_SA(b, h) (((b) * 2 + (h)) * HTB)
#define PG8_SB(b, h) ((4 + (b) * 2 + (h)) * HTB)
#define PG8_STAGE(bufoff, gbase, voff) do { _Pragma("unroll") for (int _i = 0; _i < 2; ++_i) \
        __builtin_amdgcn_global_load_lds((const unsigned*)((const char*)(gbase) + (voff)[_i]), (LAS unsigned*)(lds + (bufoff) + ldsw + _i * 8192), 16, 0, 0); } while (0)
#define PG8_LDA(dst, b, h) do { _Pragma("unroll") for (int m = 0; m < 4; ++m) _Pragma("unroll") for (int k = 0; k < 2; ++k) dst[m][k] = *(const LAS bf16x8*)(lds + PG8_SA(b, h) + aoff + m * 2048 + k * 1024); } while (0)
#define PG8_LDB(dst, b, h) do { _Pragma("unroll") for (int n = 0; n < 2; ++n) _Pragma("unroll") for (int k = 0; k < 2; ++k) dst[n][k] = *(const LAS bf16x8*)(lds + PG8_SB(b, h) + boff + n * 2048 + k * 1024); } while (0)
#define PG8_MMA(ai, bj, At, Bt) do { __builtin_amdgcn_s_setprio(1); _Pragma("unroll") for (int m = 0; m < 4; ++m) _Pragma("unroll") for (int n = 0; n < 2; ++n) _Pragma("unroll") for (int k = 0; k < 2; ++k) \
        acc[ai][bj][m][n] = __builtin_amdgcn_mfma_f32_16x16x32_bf16(Bt[n][k], At[m][k], acc[ai][bj][m][n], 0, 0, 0); __builtin_amdgcn_s_setprio(0); } while (0)
#define PG8_WAIT_V(n) asm volatile("s_waitcnt vmcnt(" #n ")" ::: "memory")
#define PG8_WAIT_L(n) asm volatile("s_waitcnt lgkmcnt(" #n ")" ::: "memory")
#define PG8_BAR __builtin_amdgcn_s_barrier()
#define PG8_SCHED __builtin_amdgcn_sched_barrier(0)
  Unit cur, nxt; int ui = 0;
  if (!S.next(0, cur)) return;
  f32x4 acc[2][2][4][2];
#pragma unroll
  for (int a = 0; a < 2; ++a)
#pragma unroll
    for (int b = 0; b < 2; ++b)
#pragma unroll
      for (int m = 0; m < 4; ++m)
#pragma unroll
        for (int n = 0; n < 2; ++n) acc[a][b][m][n] = (f32x4){0.f, 0.f, 0.f, 0.f};
  bf16x8 At[4][2], B0[2][2], B1[2][2];
  const char* cA = (const char*)g.A + (size_t)cur.pm * tstepA; const char* cB = (const char*)g.Bt + (size_t)cur.pn * tstepB;
  PG8_STAGE(PG8_SB(0, 0), cB, voffB); PG8_STAGE(PG8_SB(0, 1), cB + hstepB, voffB); PG8_STAGE(PG8_SA(0, 0), cA, voffA); PG8_STAGE(PG8_SA(0, 1), cA + hstepA, voffA);
  if (wr == 1) PG8_BAR;
  PG8_WAIT_V(2); PG8_BAR;
  PG8_STAGE(PG8_SB(1, 0), cB + kstep, voffB); PG8_STAGE(PG8_SA(1, 0), cA + kstep, voffA); PG8_STAGE(PG8_SB(1, 1), cB + hstepB + kstep, voffB);
  PG8_WAIT_V(6); PG8_BAR;
  for (;;) {
    const bool has_next = S.next(ui + 1, nxt);
    const char* nA = has_next ? (const char*)g.A + (size_t)nxt.pm * tstepA : cA; const char* nB = has_next ? (const char*)g.Bt + (size_t)nxt.pn * tstepB : cB;
    for (int t = 0; t < nt; t += 2) {
      const bool last = (t == nt - 2);
      const char* a1 = cA + (size_t)(t + 1) * kstep;
      const char* a2 = last ? nA : cA + (size_t)(t + 2) * kstep; const char* b2 = last ? nB : cB + (size_t)(t + 2) * kstep;
      const char* a3 = a2 + kstep; const char* b3 = b2 + kstep;
      PG8_LDB(B0, 0, 0); PG8_LDB(B1, 0, 1); PG8_SCHED; PG8_LDA(At, 0, 0); PG8_STAGE(PG8_SA(1, 1), a1 + hstepA, voffA);
      PG8_WAIT_V(8); PG8_WAIT_L(0); PG8_BAR; PG8_MMA(0, 0, At, B0); PG8_MMA(0, 1, At, B1); PG8_BAR; PG8_SCHED;
      PG8_LDA(At, 0, 1); PG8_STAGE(PG8_SB(0, 0), b2, voffB); PG8_STAGE(PG8_SB(0, 1), b2 + hstepB, voffB); PG8_STAGE(PG8_SA(0, 0), a2, voffA);
      PG8_WAIT_V(8); PG8_WAIT_L(0); PG8_BAR; PG8_MMA(1, 0, At, B0); PG8_MMA(1, 1, At, B1); PG8_BAR; PG8_SCHED;
      PG8_LDB(B0, 1, 0); PG8_LDB(B1, 1, 1); PG8_SCHED; PG8_LDA(At, 1, 0); PG8_STAGE(PG8_SA(0, 1), a2 + hstepA, voffA);
      PG8_WAIT_V(8); PG8_WAIT_L(0); PG8_BAR; PG8_MMA(0, 0, At, B0); PG8_MMA(0, 1, At, B1); PG8_BAR; PG8_SCHED;
      PG8_LDA(At, 1, 1); PG8_STAGE(PG8_SB(1, 0), b3, voffB); PG8_STAGE(PG8_SB(1, 1), b3 + hstepB, voffB); PG8_STAGE(PG8_SA(1, 0), a3, voffA);
      PG8_WAIT_V(8); PG8_WAIT_L(0); PG8_BAR; PG8_MMA(1, 0, At, B0); PG8_MMA(1, 1, At, B1); PG8_BAR; PG8_SCHED;
    }
    if (wr == 0) PG8_BAR;
    { const int l2 = otid() & 63; E(acc, cur, wr, wc, l2 & 15, l2 >> 4); }
    if (!has_next) break;
#pragma unroll
    for (int a = 0; a < 2; ++a)
#pragma unroll
      for (int b = 0; b < 2; ++b)
#pragma unroll
        for (int m = 0; m < 4; ++m)
#pragma unroll
          for (int n = 0; n < 2; ++n) acc[a][b][m][n] = (f32x4){0.f, 0.f, 0.f, 0.f};
    cur = nxt; cA = nA; cB = nB; ++ui;
    if (wr == 1) PG8_BAR;
  }
  PG8_WAIT_V(0);
  PG8_BAR;
#undef PG8_SA
#undef PG8_SB
#undef PG8_STAGE
#undef PG8_LDA
#undef PG8_LDB
#undef PG8_MMA
#undef PG8_WAIT_V
#undef PG8_WAIT_L
#undef PG8_BAR
#undef PG8_SCHED
}

__device__ __forceinline__ void store8(bf16_t* p, const f32x4& v0, const f32x4& v1) {
  u32x4 w; w.x = cvt_pk_bf16(v0[0], v0[1]); w.y = cvt_pk_bf16(v0[2], v0[3]); w.z = cvt_pk_bf16(v1[0], v1[1]); w.w = cvt_pk_bf16(v1[2], v1[3]); *(u32x4*)p = w;
}
__device__ __forceinline__ void rope8(f32x4& v0, f32x4& v1, const f32x2* cs) {
  const f32x4 a = *(const f32x4*)cs, b = *(const f32x4*)(cs + 2);
  float x1, x2;
  x1 = v0[0]; x2 = v0[1]; v0[0] = x1 * a[0] - x2 * a[1]; v0[1] = x2 * a[0] + x1 * a[1];
  x1 = v0[2]; x2 = v0[3]; v0[2] = x1 * a[2] - x2 * a[3]; v0[3] = x2 * a[2] + x1 * a[3];
  x1 = v1[0]; x2 = v1[1]; v1[0] = x1 * b[0] - x2 * b[1]; v1[1] = x2 * b[0] + x1 * b[1];
  x1 = v1[2]; x2 = v1[3]; v1[2] = x1 * b[2] - x2 * b[3]; v1[3] = x2 * b[2] + x1 * b[3];
}
__device__ __forceinline__ float row_rstd(const float* rss, size_t row) { const f32x4 q = *(const f32x4*)(rss + row * 4); return __builtin_amdgcn_rsqf(((q[0] + q[1]) + (q[2] + q[3])) * (1.f / 1024.f) + NORM_EPS); }
__device__ __forceinline__ void rope8v(f32x4& v0, f32x4& v1, const f32x4& a, const f32x4& b) {
  float x1, x2;
  x1 = v0[0]; x2 = v0[1]; v0[0] = x1 * a[0] - x2 * a[1]; v0[1] = x2 * a[0] + x1 * a[1];
  x1 = v0[2]; x2 = v0[3]; v0[2] = x1 * a[2] - x2 * a[3]; v0[3] = x2 * a[2] + x1 * a[3];
  x1 = v1[0]; x2 = v1[1]; v1[0] = x1 * b[0] - x2 * b[1]; v1[1] = x2 * b[0] + x1 * b[1];
  x1 = v1[2]; x2 = v1[3]; v1[2] = x1 * b[2] - x2 * b[3]; v1[3] = x2 * b[2] + x1 * b[3];
}
#define EPI_FOR_ROWS for (int ai = 0; ai < 2; ++ai) for (int m = 0; m < 4; ++m)
struct EpiPlain {
  bf16_t* O; int ldc; const float* rss;
  __device__ __forceinline__ void operator()(const f32x4 (&acc)[2][2][4][2], const Unit& u, int wr, int wc, int fr, int fq) const {
#pragma unroll
    for (int ai = 0; ai < 2; ++ai)
#pragma unroll
      for (int m = 0; m < 4; ++m) { const size_t row = (size_t)u.pm * BM + ai * HALF + wr * 64 + m * 16 + fr;
#pragma unroll
        for (int bj = 0; bj < 2; ++bj) { const int col0 = u.pn * BM + bj * HALF + wc * 32 + 8 * fq; const float rs = rss ? row_rstd(rss, row) : 1.0f; store8(O + row * ldc + col0, acc[ai][bj][m][0] * rs, acc[ai][bj][m][1] * rs); } }
  }
};
struct EpiInproj {
  bf16_t* proj; bf16_t* qrot; bf16_t* vst; bf16_t* kst; const f32x2* cs64; const f32x2* cs32; const float* rss;
  __device__ __forceinline__ void operator()(const f32x4 (&acc)[2][2][4][2], const Unit& u, int wr, int wc, int fr, int fq) const {
    constexpr unsigned ROPE_IN = (1u << 0) | (1u << 1) | (1u << 2) | (1u << 3) | (1u << 4) | (1u << 12) | (1u << 14);
    constexpr unsigned ROPE_DUAL = (1u << 6) | (1u << 7) | (1u << 8) | (1u << 9);
#pragma unroll
    for (int ai = 0; ai < 2; ++ai)
#pragma unroll
      for (int m = 0; m < 4; ++m) { const size_t row = (size_t)u.pm * BM + ai * HALF + wr * 64 + m * 16 + fr; const float rs = row_rstd(rss, row);
#pragma unroll
        for (int bj = 0; bj < 2; ++bj) {
          const int seg = 2 * u.pn + bj; const int col0 = u.pn * BM + bj * HALF + wc * 32 + 8 * fq;
          f32x4 v0 = acc[ai][bj][m][0] * rs, v1 = acc[ai][bj][m][1] * rs;
          bf16_t* dst = proj + row * NPROJ + col0;
          if ((ROPE_IN >> seg) & 1u) { rope8(v0, v1, cs64 + row * 32 + ((col0 & 63) >> 1));
            if (seg == 12) {
              const int cc = col0 - C_BKS, gs = cc >> 6, d0 = cc & 63; const int b = (int)(row >> 13), s = (int)(row & 8191), blk = s >> 6, k6 = s & 63;
              const float a4[4] = {v0[0], v0[1], v0[2], v0[3]}, b4[4] = {v1[0], v1[1], v1[2], v1[3]};
              unsigned char* kd = (unsigned char*)kst + ((size_t)(b * 2 + gs) * 128 + blk) * 4096 + (((k6 >> 4) * 16 + (k6 & 15)) * 4 + ((d0 & 31) >> 3)) * 16 + (d0 >> 5) * 8;
              *(u32x2*)kd = pack8_fp8(a4, b4);
            } else store8(dst, v0, v1); }
          else if ((ROPE_DUAL >> seg) & 1u) { store8(dst, v0, v1); rope8(v0, v1, cs64 + row * 32 + ((col0 & 63) >> 1)); store8(qrot + row * 512 + (col0 - C_BQ), v0, v1); }
          else if (seg == 21 && wc == 0) { rope8(v0, v1, cs32 + row * 16 + ((col0 - C_CKR) >> 1)); store8(dst, v0, v1); }
          else {
            store8(dst, v0, v1);
            if (seg == 13) {
              const int cc = col0 - C_BVS, gs = cc >> 6, d0 = cc & 63; const int b = (int)(row >> 13), s = (int)(row & 8191), blk = s >> 6, k6 = s & 63, k5 = k6 & 31;
              const int lgp = (k5 & 15) >> 2, jj = ((k5 >> 4) << 2) | (k5 & 3);
              const float a4[4] = {v0[0], v0[1], v0[2], v0[3]}, b4[4] = {v1[0], v1[1], v1[2], v1[3]};
              const u32x2 q8 = pack8_fp8(a4, b4);
              unsigned char* vd = (unsigned char*)vst + ((size_t)(b * 2 + gs) * 128 + blk) * 4096 + (((d0 >> 4) * 16 + (d0 & 15)) * 4 + lgp) * 16 + (k6 >> 5) * 8 + jj;
              vd[0 * 64] = (unsigned char)(q8.x); vd[1 * 64] = (unsigned char)(q8.x >> 8); vd[2 * 64] = (unsigned char)(q8.x >> 16); vd[3 * 64] = (unsigned char)(q8.x >> 24);
              vd[4 * 64] = (unsigned char)(q8.y); vd[5 * 64] = (unsigned char)(q8.y >> 8); vd[6 * 64] = (unsigned char)(q8.y >> 16); vd[7 * 64] = (unsigned char)(q8.y >> 24);
            }
          }
        } }
  }
};
struct EpiMlaQ {
  bf16_t* O; const f32x2* cs32;
  __device__ __forceinline__ void operator()(const f32x4 (&acc)[2][2][4][2], const Unit& u, int wr, int wc, int fr, int fq) const {
#pragma unroll
    for (int aq = 0; aq < 4; ++aq) { const int ai = aq >> 1, m0 = (aq & 1) * 2;
      f32x4 ca[2][2], cb[2][2];
#pragma unroll
      for (int mm = 0; mm < 2; ++mm) { const size_t row = (size_t)u.pm * BM + ai * HALF + wr * 64 + (m0 + mm) * 16 + fr;
#pragma unroll
        for (int bj = 0; bj < 2; ++bj) { const int col0 = u.pn * BM + bj * HALF + wc * 32 + 8 * fq; const int o = col0 % 96; const int pi = o >= 64 ? ((o - 64) >> 1) : 0;
          const f32x2* cp = cs32 + row * 16 + pi; ca[mm][bj] = *(const f32x4*)cp; cb[mm][bj] = *(const f32x4*)(cp + 2); } }
#pragma unroll
      for (int mm = 0; mm < 2; ++mm) { const int m = m0 + mm; const size_t row = (size_t)u.pm * BM + ai * HALF + wr * 64 + m * 16 + fr;
#pragma unroll
        for (int bj = 0; bj < 2; ++bj) { const int col0 = u.pn * BM + bj * HALF + wc * 32 + 8 * fq; const int o = col0 % 96;
          f32x4 v0 = acc[ai][bj][m][0], v1 = acc[ai][bj][m][1];
          if (o >= 64) rope8v(v0, v1, ca[mm][bj], cb[mm][bj]);
          store8(O + row * 768 + col0, v0, v1); } }
    }
  }
};
struct EpiGates {
  bf16_t* O; const float* rss;
  __device__ __forceinline__ void operator()(const f32x4 (&acc)[2][2][4][2], const Unit& u, int wr, int wc, int fr, int fq) const {
#pragma unroll
    for (int ai = 0; ai < 2; ++ai)
#pragma unroll
      for (int m = 0; m < 4; ++m) { const size_t row = (size_t)u.pm * BM + ai * HALF + wr * 64 + m * 16 + fr; const float rs = row_rstd(rss, row);
#pragma unroll
        for (int bj = 0; bj < 2; ++bj) { const int col0 = u.pn * BM + bj * HALF + wc * 32 + 8 * fq;
          f32x4 v0 = acc[ai][bj][m][0], v1 = acc[ai][bj][m][1];
#pragma unroll
          for (int e = 0; e < 4; ++e) { v0[e] = sigmoidf_(v0[e] * rs); v1[e] = sigmoidf_(v1[e] * rs); }
          store8(O + row * NGATE + col0, v0, v1); } }
  }
};
struct EpiMerge {
  const bf16_t* gates; bf16_t* merged;
  __device__ __forceinline__ void operator()(const f32x4 (&acc)[2][2][4][2], const Unit& u, int wr, int wc, int fr, int fq) const {
    const int br = u.pm >> 7, pm = u.pm & 127, pn = u.pn & 3;
#pragma unroll
    for (int ai = 0; ai < 2; ++ai) {
      u32x4 gw[4][2], pw[4][2];
#pragma unroll
      for (int m = 0; m < 4; ++m) { const size_t row = (size_t)pm * BM + ai * HALF + wr * 64 + m * 16 + fr;
#pragma unroll
        for (int bj = 0; bj < 2; ++bj) { const int col0 = pn * BM + bj * HALF + wc * 32 + 8 * fq;
          gw[m][bj] = *(const u32x4*)(gates + row * NGATE + br * 1024 + col0);
          pw[m][bj] = br > 0 ? *(const u32x4*)(merged + row * 1024 + col0) : (u32x4){0u, 0u, 0u, 0u}; } }
#pragma unroll
      for (int m = 0; m < 4; ++m) { const size_t row = (size_t)pm * BM + ai * HALF + wr * 64 + m * 16 + fr;
#pragma unroll
        for (int bj = 0; bj < 2; ++bj) { const int col0 = pn * BM + bj * HALF + wc * 32 + 8 * fq;
          f32x4 v0 = acc[ai][bj][m][0], v1 = acc[ai][bj][m][1]; const u32x4 g4 = gw[m][bj], p4 = pw[m][bj];
          v0[0] = v0[0] * bflo(g4.x) + bflo(p4.x); v0[1] = v0[1] * bfhi(g4.x) + bfhi(p4.x); v0[2] = v0[2] * bflo(g4.y) + bflo(p4.y); v0[3] = v0[3] * bfhi(g4.y) + bfhi(p4.y);
          v1[0] = v1[0] * bflo(g4.z) + bflo(p4.z); v1[1] = v1[1] * bfhi(g4.z) + bfhi(p4.z); v1[2] = v1[2] * bflo(g4.w) + bflo(p4.w); v1[3] = v1[3] * bfhi(g4.w) + bfhi(p4.w);
          store8(merged + row * 1024 + col0, v0, v1); } }
    }
  }
};
struct EpiResid {
  const float* res; float* out; bf16_t* xb; float* rss; LAS float* xl;
  __device__ __forceinline__ void operator()(const f32x4 (&acc)[2][2][4][2], const Unit& u, int wr, int wc, int fr, int fq) const {
#pragma unroll
    for (int ai = 0; ai < 2; ++ai) {
      f32x4 rv[4][2][2];
#pragma unroll
      for (int m = 0; m < 4; ++m) { const size_t row = (size_t)u.pm * BM + ai * HALF + wr * 64 + m * 16 + fr;
#pragma unroll
        for (int bj = 0; bj < 2; ++bj) { const size_t off = row * 1024 + u.pn * BM + bj * HALF + wc * 32 + 8 * fq; rv[m][bj][0] = *(const f32x4*)(res + off); rv[m][bj][1] = *(const f32x4*)(res + off + 4); } }
#pragma unroll
      for (int m = 0; m < 4; ++m) { const size_t row = (size_t)u.pm * BM + ai * HALF + wr * 64 + m * 16 + fr; float ss = 0.f;
#pragma unroll
        for (int bj = 0; bj < 2; ++bj) { const size_t off = row * 1024 + u.pn * BM + bj * HALF + wc * 32 + 8 * fq;
          const f32x4 r0 = rv[m][bj][0] + acc[ai][bj][m][0], r1 = rv[m][bj][1] + acc[ai][bj][m][1];
          *(f32x4*)(out + off) = r0; *(f32x4*)(out + off + 4) = r1; store8(xb + off, r0, r1);
          ss += (r0[0] * r0[0] + r0[1] * r0[1]) + (r0[2] * r0[2] + r0[3] * r0[3]) + (r1[0] * r1[0] + r1[1] * r1[1]) + (r1[2] * r1[2] + r1[3] * r1[3]); }
        ss += xor16(ss); ss += xor32(ss);
        if (fq == 0) xl[wc * 256 + ai * HALF + wr * 64 + m * 16 + fr] = ss; }
    }
    asm volatile("s_waitcnt lgkmcnt(0)\n\ts_barrier" ::: "memory");
    { const int t2 = otid(); if (t2 < 256) rss[((size_t)u.pm * BM + t2) * 4 + u.pn] = (xl[t2] + xl[256 + t2]) + (xl[512 + t2] + xl[768 + t2]); }
    asm volatile("s_waitcnt lgkmcnt(0)\n\ts_barrier" ::: "memory");
  }
};
struct EpiSwiglu {
  bf16_t* O; const float* rss;
  __device__ __forceinline__ void operator()(const f32x4 (&acc)[2][2][4][2], const Unit& u, int wr, int wc, int fr, int fq) const {
#pragma unroll
    for (int ai = 0; ai < 2; ++ai)
#pragma unroll
      for (int m = 0; m < 4; ++m) { const size_t row = (size_t)u.pm * BM + ai * HALF + wr * 64 + m * 16 + fr; const float rs = row_rstd(rss, row);
#pragma unroll
        for (int bj = 0; bj < 2; ++bj) { const int col0 = u.pn * BM + bj * HALF + wc * 32 + 8 * fq;
          const f32x4 gt = acc[ai][bj][m][0] * rs, up = acc[ai][bj][m][1] * rs; float r[4];
#pragma unroll
          for (int e = 0; e < 4; ++e) r[e] = gt[e] * sigmoidf_(gt[e]) * up[e];
          u32x2 w; w.x = cvt_pk_bf16(r[0], r[1]); w.y = cvt_pk_bf16(r[2], r[3]);
          *(u32x2*)(O + row * DFF + (col0 >> 1)) = w; } }
  }
};
}

__device__ __forceinline__ f32x4 mfma16(bf16x8 a, bf16x8 b, f32x4 c) { return __builtin_amdgcn_mfma_f32_16x16x32_bf16(a, b, c, 0, 0, 0); }
__device__ __forceinline__ s16x4 ds_tr(LAS const unsigned char* p) { return __builtin_bit_cast(s16x4, __builtin_amdgcn_ds_read_tr16_b64_v4i16((LAS v4i16_t*)p)); }
__device__ __forceinline__ bf16x8 pack8(const float (&a)[4], const float (&b)[4]) {
  u32x4 w; w.x = cvt_pk_bf16(a[0], a[1]); w.y = cvt_pk_bf16(a[2], a[3]); w.z = cvt_pk_bf16(b[0], b[1]); w.w = cvt_pk_bf16(b[2], b[3]); return __builtin_bit_cast(bf16x8, w);
}
enum { MODE_NONE = 0, MODE_CAUSAL = 1, MODE_WINDOW = 2, MODE_CMP = 3 };
template <int MODE> __device__ __forceinline__ bool mask_ok(int tq, int kp, int W) {
  if (MODE == MODE_CAUSAL) return kp <= tq;
  if (MODE == MODE_WINDOW) return kp <= tq && kp > tq - W;
  if (MODE == MODE_CMP) return 16 * kp + 31 <= tq;
  return true;
}
template <int NT, int NKK, int NDT, int MODE, bool MASK>
__device__ __forceinline__ void attn_chunk(f32x4 (&o)[NT][NDT], float (&m)[NT], float (&l)[NT], const bf16x8 (&qf)[NT][NKK],
                                           LAS const unsigned char* Kl, int KSTR, LAS const unsigned char* Vl, int VSTR, int kpos0, const int (&tq)[NT], float c, int W, int lane) {
  constexpr int JB = 2;
  const int r = lane & 15, lg = lane >> 4, vq = (lane & 15) >> 2, vp = lane & 3;
#pragma unroll 1
  for (int st = 0; st < 2; ++st) {
#pragma unroll
    for (int jh = 0; jh < NT / JB; ++jh) {
      int oz = 0; if (NT > JB) asm volatile("" : "+v"(oz));
      f32x4 s[JB][2];
      __builtin_amdgcn_s_setprio(1);
#pragma unroll
      for (int t = 0; t < 2; ++t)
#pragma unroll
        for (int kk = 0; kk < NKK; ++kk) {
          const bf16x8 kf = *(LAS const bf16x8*)(Kl + oz + (32 * st + 16 * t + r) * KSTR + (32 * kk + 8 * lg) * 2);
#pragma unroll
          for (int jj = 0; jj < JB; ++jj) s[jj][t] = mfma16(kf, qf[jh * JB + jj][kk], kk == 0 ? (f32x4){0.f, 0.f, 0.f, 0.f} : s[jj][t]);
        }
      __builtin_amdgcn_s_setprio(0);
      bf16x8 pf[JB];
      if (NT > JB) __builtin_amdgcn_sched_barrier(0);
#pragma unroll
      for (int jj = 0; jj < JB; ++jj) {
        const int j = jh * JB + jj;
        float mx = -INFINITY;
#pragma unroll
        for (int t = 0; t < 2; ++t)
#pragma unroll
          for (int i = 0; i < 4; ++i) {
            if (MASK) { const int kp = kpos0 + 32 * st + 16 * t + 4 * lg + i; if (!mask_ok<MODE>(tq[j], kp, W)) s[jj][t][i] = -INFINITY; }
            mx = fmaxf(mx, s[jj][t][i]);
          }
        mx = max_x16_x32(mx);
        if (NT > 2 || __any(mx > m[j] + 8.0f / c)) {
          const float mnew = fmaxf(m[j], mx);
          const float ms2 = (mnew == -INFINITY) ? 0.f : mnew;
          const float alpha = ex2((m[j] - ms2) * c);
          m[j] = mnew; l[j] *= alpha;
#pragma unroll
          for (int dt = 0; dt < NDT; ++dt) o[j][dt] *= alpha;
        }
        const float mc = ((m[j] == -INFINITY) ? 0.f : m[j]) * c;
        float p0[4], p1[4], ps = 0.f;
#pragma unroll
        for (int i = 0; i < 4; ++i) { p0[i] = ex2(s[jj][0][i] * c - mc); p1[i] = ex2(s[jj][1][i] * c - mc); ps += p0[i] + p1[i]; }
        l[j] += ps;
        pf[jj] = pack8(p0, p1);
      }
      if (NT > JB) __builtin_amdgcn_sched_barrier(0);
      __builtin_amdgcn_s_setprio(1);
#pragma unroll
      for (int dt = 0; dt < NDT; ++dt) {
        const s16x4 v0 = ds_tr(Vl + oz + (32 * st + 4 * lg + vq) * VSTR + (16 * dt + 4 * vp) * 2);
        const s16x4 v1 = ds_tr(Vl + oz + (32 * st + 16 + 4 * lg + vq) * VSTR + (16 * dt + 4 * vp) * 2);
        const bf16x8 vf = (bf16x8){v0[0], v0[1], v0[2], v0[3], v1[0], v1[1], v1[2], v1[3]};
#pragma unroll
        for (int jj = 0; jj < JB; ++jj) o[jh * JB + jj][dt] = mfma16(vf, pf[jj], o[jh * JB + jj][dt]);
      }
      __builtin_amdgcn_s_setprio(0);
      if (NT > JB) __builtin_amdgcn_sched_barrier(0);
    }
  }
}

template <int NT, int NKK, int NDT, int MODE, bool MASK>
__device__ __forceinline__ void attn_chunk_wide(f32x4 (&o)[NT][NDT], float (&m)[NT], float (&l)[NT], const bf16x8 (&qf)[NT][NKK],
                                                LAS const unsigned char* Kl, int KSTR, LAS const unsigned char* Vl, int VSTR, int kpos0, const int (&tq)[NT], float c, int W, int lane) {
  const int r = lane & 15, lg = lane >> 4, vq = (lane & 15) >> 2, vp = lane & 3;
  f32x4 s[NT][4];
  __builtin_amdgcn_s_setprio(1);
#pragma unroll
  for (int t = 0; t < 4; ++t)
#pragma unroll
    for (int kk = 0; kk < NKK; ++kk) {
      const bf16x8 kf = *(LAS const bf16x8*)(Kl + (16 * t + r) * KSTR + (32 * kk + 8 * lg) * 2);
#pragma unroll
      for (int j = 0; j < NT; ++j) s[j][t] = mfma16(kf, qf[j][kk], kk == 0 ? (f32x4){0.f, 0.f, 0.f, 0.f} : s[j][t]);
    }
  __builtin_amdgcn_s_setprio(0);
  bf16x8 pf[NT][2];
#pragma unroll
  for (int j = 0; j < NT; ++j) {
    float mx = -INFINITY;
#pragma unroll
    for (int t = 0; t < 4; ++t)
#pragma unroll
      for (int i = 0; i < 4; ++i) {
        if (MASK) { const int kp = kpos0 + 16 * t + 4 * lg + i; if (!mask_ok<MODE>(tq[j], kp, W)) s[j][t][i] = -INFINITY; }
        mx = fmaxf(mx, s[j][t][i]);
      }
    mx = max_x16_x32(mx);
    if (__any(mx > m[j] + 8.0f / c)) {
      const float mnew = fmaxf(m[j], mx);
      const float ms2 = (mnew == -INFINITY) ? 0.f : mnew;
      const float alpha = ex2((m[j] - ms2) * c);
      m[j] = mnew; l[j] *= alpha;
#pragma unroll
      for (int dt = 0; dt < NDT; ++dt) o[j][dt] *= alpha;
    }
    const float mc = ((m[j] == -INFINITY) ? 0.f : m[j]) * c;
    float p[4][4], ps = 0.f;
#pragma unroll
    for (int t = 0; t < 4; ++t)
#pragma unroll
      for (int i = 0; i < 4; ++i) { p[t][i] = ex2(s[j][t][i] * c - mc); ps += p[t][i]; }
    l[j] += ps;
    pf[j][0] = pack8(p[0], p[1]); pf[j][1] = pack8(p[2], p[3]);
  }
  __builtin_amdgcn_s_setprio(1);
#pragma unroll
  for (int st = 0; st < 2; ++st)
#pragma unroll
    for (int dt = 0; dt < NDT; ++dt) {
      const s16x4 v0 = ds_tr(Vl + (32 * st + 4 * lg + vq) * VSTR + (16 * dt + 4 * vp) * 2);
      const s16x4 v1 = ds_tr(Vl + (32 * st + 16 + 4 * lg + vq) * VSTR + (16 * dt + 4 * vp) * 2);
      const bf16x8 vf = (bf16x8){v0[0], v0[1], v0[2], v0[3], v1[0], v1[1], v1[2], v1[3]};
#pragma unroll
      for (int j = 0; j < NT; ++j) o[j][dt] = mfma16(vf, pf[j][st], o[j][dt]);
    }
  __builtin_amdgcn_s_setprio(0);
}

template <int NT, int DQK, int DV, int MODE, int PD, class Src>
__device__ __forceinline__ void attn_block_loop(LAS unsigned char* lds, const Src& src, f32x4 (&o)[NT][DV / 16], float (&m)[NT], float (&l)[NT], const bf16x8 (&qf)[NT][DQK / 32],
                                                const int (&tq)[NT], int kc0, int kc1, int kbase, int tq_min, int tq_max, float c, int W) {
  constexpr int KSTR = DQK * 2 + 16, VSTR = DV * 2 + 32, KB = 64 * KSTR, VB = 64 * VSTR, BUF = KB + VB;
  constexpr int KCH = DQK / 8, VCH = DV / 8, NKI = 64 * KCH, NVI = 64 * VCH, NKR = (NKI + 511) / 512, NVR = (NVI + 511) / 512;
  const int tid = otid(), lane = tid & 63;
  u32x4 kreg[PD][NKR], vreg[PD][NVR];
#define ABL_LOAD(u, kc) do { \
    _Pragma("unroll") for (int rr = 0; rr < NKR; ++rr) { const int idx = tid + 512 * rr; if (idx < NKI) { const int row = idx / KCH, ch = idx % KCH; kreg[u][rr] = *(const u32x4*)src.kaddr((kc) * 64 + row, ch); } } \
    _Pragma("unroll") for (int rr = 0; rr < NVR; ++rr) { const int idx = tid + 512 * rr; if (idx < NVI) { const int row = idx / VCH, ch = idx % VCH; vreg[u][rr] = *(const u32x4*)src.vaddr((kc) * 64 + row, ch); } } } while (0)
#pragma unroll
  for (int u = 0; u < PD; ++u) if (kc0 + u < kc1) ABL_LOAD(u, kc0 + u);
  for (int kcb = kc0; kcb < kc1; kcb += PD) {
#pragma unroll
    for (int u = 0; u < PD; ++u) {
      const int kc = kcb + u;
      if (kc < kc1) {
        LAS unsigned char* buf = lds + ((kc - kc0) & 1) * BUF;
#pragma unroll
        for (int rr = 0; rr < NKR; ++rr) { const int idx = tid + 512 * rr; if (idx < NKI) { const int row = idx / KCH, ch = idx % KCH; *(LAS u32x4*)(buf + row * KSTR + ch * 16) = kreg[u][rr]; } }
#pragma unroll
        for (int rr = 0; rr < NVR; ++rr) { const int idx = tid + 512 * rr; if (idx < NVI) { const int row = idx / VCH, ch = idx % VCH; *(LAS u32x4*)(buf + KB + row * VSTR + ch * 16) = vreg[u][rr]; } }
        if (kc + PD < kc1) ABL_LOAD(u, kc + PD);
        LBAR();
        const int lo = kbase + 64 * kc, hi = lo + 63;
        bool rel = true, full = true;
        if (MODE == MODE_CAUSAL) { rel = lo <= tq_max; full = hi <= tq_min; }
        if (MODE == MODE_WINDOW) { rel = (lo <= tq_max) && (hi > tq_min - W); full = (hi <= tq_min) && (lo > tq_max - W); }
        if (MODE == MODE_CMP) { rel = 16 * lo + 31 <= tq_max; full = 16 * hi + 31 <= tq_min; }
        if (rel) {
          if (NT <= 2) {
            if (full) attn_chunk_wide<NT, DQK / 32, DV / 16, MODE, false>(o, m, l, qf, buf, KSTR, buf + KB, VSTR, lo, tq, c, W, lane);
            else attn_chunk_wide<NT, DQK / 32, DV / 16, MODE, true>(o, m, l, qf, buf, KSTR, buf + KB, VSTR, lo, tq, c, W, lane);
          } else {
            if (full) attn_chunk<NT, DQK / 32, DV / 16, MODE, false>(o, m, l, qf, buf, KSTR, buf + KB, VSTR, lo, tq, c, W, lane);
            else attn_chunk<NT, DQK / 32, DV / 16, MODE, true>(o, m, l, qf, buf, KSTR, buf + KB, VSTR, lo, tq, c, W, lane);
          }
        }
      }
    }
  }
#undef ABL_LOAD
  LBAR();
}
__device__ __forceinline__ float lsum4(float l) { l += xor16(l); l += xor32(l); return l; }
__device__ __forceinline__ void store4(bf16_t* p, const f32x4& v, float sc) { u32x2 w; w.x = cvt_pk_bf16(v[0] * sc, v[1] * sc); w.y = cvt_pk_bf16(v[2] * sc, v[3] * sc); *(u32x2*)p = w; }

struct Params {
  const float* in[29]; float* out; unsigned char* ws; float invf64[32]; float invf32[16]; int pad0, pad1;
};
struct Ctx {
  const float* const* in; unsigned char* ws; float* out; int G, blk;
  __device__ __forceinline__ bf16_t* W() const { return (bf16_t*)(ws + WS_W); }
  __device__ __forceinline__ bf16_t* H() const { return (bf16_t*)(ws + WS_H); }
  __device__ __forceinline__ bf16_t* PROJ() const { return (bf16_t*)(ws + WS_PROJ); }
  __device__ __forceinline__ bf16_t* QM() const { return (bf16_t*)(ws + WS_QM); }
  __device__ __forceinline__ bf16_t* KVM() const { return (bf16_t*)(ws + WS_KVM); }
  __device__ __forceinline__ bf16_t* OA() const { return (bf16_t*)(ws + WS_KVM); }
  __device__ __forceinline__ bf16_t* OC() const { return (bf16_t*)(ws + WS_OC); }
  __device__ __forceinline__ bf16_t* QROT() const { return (bf16_t*)(ws + WS_QROT); }
  __device__ __forceinline__ bf16_t* VST() const { return (bf16_t*)(ws + WS_VST); }
  __device__ __forceinline__ bf16_t* KST() const { return (bf16_t*)(ws + WS_KST); }
  __device__ __forceinline__ bf16_t* KCMP() const { return (bf16_t*)(ws + WS_KCMP); }
  __device__ __forceinline__ bf16_t* VCMP() const { return (bf16_t*)(ws + WS_VCMP); }
  __device__ __forceinline__ bf16_t* MEMKV() const { return (bf16_t*)(ws + WS_MEMKV); }
  __device__ __forceinline__ bf16_t* HM() const { return (bf16_t*)(ws + WS_HM); }
  __device__ __forceinline__ float* RSS() const { return (float*)(ws + WS_RSS); }
  __device__ __forceinline__ unsigned char* SELL() const { return ws + WS_SELL; }
  __device__ __forceinline__ bf16_t* OW() const { return (bf16_t*)(ws + WS_QM); }
  __device__ __forceinline__ f32x2* CS64() const { return (f32x2*)(ws + WS_CS64); }
  __device__ __forceinline__ f32x2* CS32() const { return (f32x2*)(ws + WS_CS32); }
};

struct SrcMla { const bf16_t* kvm; const bf16_t* proj; size_t rowbase; int h;
  __device__ __forceinline__ const bf16_t* kaddr(int krow, int ch) const { return ch < 8 ? kvm + (rowbase + krow) * 1024 + 128 * h + 8 * ch : proj + (rowbase + krow) * NPROJ + C_CKR + 8 * (ch - 8); }
  __device__ __forceinline__ const bf16_t* vaddr(int krow, int ch) const { return kvm + (rowbase + krow) * 1024 + 128 * h + 64 + 8 * ch; } };
__device__ __forceinline__ void mla_unit(LAS unsigned char* lds, const Ctx& X, int b, int h, int qb) {
  const int tid = otid(), lane = tid & 63, w = __builtin_amdgcn_readfirstlane(tid >> 6), cq = lane & 15, lg = lane >> 4;
  const size_t rowbase = (size_t)b * S; const int qw = qb * 256 + 32 * w;
  bf16x8 qf[2][3]; int tq[2]; f32x4 o[2][4]; float m[2], l[2];
#pragma unroll
  for (int j = 0; j < 2; ++j) { tq[j] = qw + 16 * j + cq; m[j] = -INFINITY; l[j] = 0.f;
#pragma unroll
    for (int kk = 0; kk < 3; ++kk) qf[j][kk] = *(const bf16x8*)(X.QM() + (rowbase + tq[j]) * 768 + 96 * h + 32 * kk + 8 * lg);
#pragma unroll
    for (int dt = 0; dt < 4; ++dt) o[j][dt] = (f32x4){0.f, 0.f, 0.f, 0.f}; }
  SrcMla src{X.KVM(), X.PROJ(), rowbase, h};
  const float c = 0.10206207261596577f * LOG2E;
  attn_block_loop<2, 96, 64, MODE_CAUSAL, 3, SrcMla>(lds, src, o, m, l, qf, tq, 0, 4 * (qb + 1), 0, qw, qw + 31, c, 0);
#pragma unroll
  for (int j = 0; j < 2; ++j) { const float lt = lsum4(l[j]); const float inv = lt > 0.f ? 1.0f / lt : 0.f;
#pragma unroll
    for (int dt = 0; dt < 4; ++dt) store4(X.OC() + (rowbase + tq[j]) * 512 + 64 * h + 16 * dt + 4 * lg, o[j][dt], inv); }
}
struct SrcX { const bf16_t* kv; size_t rowbase; int h;
  __device__ __forceinline__ const bf16_t* kaddr(int krow, int ch) const { return kv + (rowbase + krow) * 1024 + 128 * h + 8 * ch; }
  __device__ __forceinline__ const bf16_t* vaddr(int krow, int ch) const { return kv + (rowbase + krow) * 1024 + 512 + 128 * h + 8 * ch; } };
__device__ __forceinline__ void xattn_unit(LAS unsigned char* lds, const Ctx& X, const bf16_t* xq, bf16_t* ox, int b, int h, int qb) {
  const int tid = otid(), lane = tid & 63, w = __builtin_amdgcn_readfirstlane(tid >> 6), cq = lane & 15, lg = lane >> 4;
  const size_t rowbase = (size_t)b * S; const int qw = qb * 256 + 32 * w;
  bf16x8 qf[2][4]; int tq[2]; f32x4 o[2][8]; float m[2], l[2];
#pragma unroll
  for (int j = 0; j < 2; ++j) { tq[j] = qw + 16 * j + cq; m[j] = -INFINITY; l[j] = 0.f;
#pragma unroll
    for (int kk = 0; kk < 4; ++kk) qf[j][kk] = *(const bf16x8*)(xq + (rowbase + tq[j]) * 512 + 128 * h + 32 * kk + 8 * lg);
#pragma unroll
    for (int dt = 0; dt < 8; ++dt) o[j][dt] = (f32x4){0.f, 0.f, 0.f, 0.f}; }
  SrcX src{X.MEMKV(), (size_t)b * 256, h};
  const float c = 0.08838834764831845f * LOG2E;
  attn_block_loop<2, 128, 128, MODE_NONE, 2, SrcX>(lds, src, o, m, l, qf, tq, 0, 4, 0, 0, 0, c, 0);
#pragma unroll
  for (int j = 0; j < 2; ++j) { const float lt = lsum4(l[j]); const float inv = lt > 0.f ? 1.0f / lt : 0.f;
#pragma unroll
    for (int dt = 0; dt < 8; ++dt) store4(ox + (rowbase + tq[j]) * 512 + 128 * h + 16 * dt + 4 * lg, o[j][dt], inv); }
}
struct SrcProj { const bf16_t* proj; size_t rowbase; int kcol, vcol;
  __device__ __forceinline__ const bf16_t* kaddr(int krow, int ch) const { return proj + (rowbase + krow) * NPROJ + kcol + 8 * ch; }
  __device__ __forceinline__ const bf16_t* vaddr(int krow, int ch) const { return proj + (rowbase + krow) * NPROJ + vcol + 8 * ch; } };
__device__ __forceinline__ void swa_unit(LAS unsigned char* lds, const Ctx& X, const float* sinks, int b, int kvh, int qb) {
  const int tid = otid(), lane = tid & 63, w = __builtin_amdgcn_readfirstlane(tid >> 6), cq = lane & 15, lg = lane >> 4;
  const size_t rowbase = (size_t)b * S; const int q0 = qb * 128, qw = q0 + 16 * w;
  bf16x8 qf[4][2]; int tq[4]; f32x4 o[4][4]; float m[4], l[4];
#pragma unroll
  for (int j = 0; j < 4; ++j) { tq[j] = qw + cq; m[j] = sinks[4 * kvh + j] * 8.0f; l[j] = (lg == 0) ? 1.0f : 0.f;
#pragma unroll
    for (int kk = 0; kk < 2; ++kk) qf[j][kk] = *(const bf16x8*)(X.PROJ() + (rowbase + tq[j]) * NPROJ + C_AQ + 64 * (4 * kvh + j) + 32 * kk + 8 * lg);
#pragma unroll
    for (int dt = 0; dt < 4; ++dt) o[j][dt] = (f32x4){0.f, 0.f, 0.f, 0.f}; }
  const int kbase = q0 - 128;
  SrcProj src{X.PROJ(), rowbase + kbase, C_AK + 64 * kvh, C_AV + 64 * kvh};
  const float c = 0.125f * LOG2E;
  attn_block_loop<4, 64, 64, MODE_WINDOW, 2, SrcProj>(lds, src, o, m, l, qf, tq, q0 == 0 ? 2 : 0, 4, kbase, qw, qw + 15, c, 128);
#pragma unroll
  for (int j = 0; j < 4; ++j) { const float lt = lsum4(l[j]); const float inv = lt > 0.f ? 1.0f / lt : 0.f;
#pragma unroll
    for (int dt = 0; dt < 4; ++dt) store4(X.OA() + (rowbase + tq[j]) * 512 + 64 * (4 * kvh + j) + 16 * dt + 4 * lg, o[j][dt], inv); }
}

struct SrcCmp { const bf16_t* k; const bf16_t* v;
  __device__ __forceinline__ const bf16_t* kaddr(int krow, int ch) const { return k + (size_t)krow * 64 + 8 * ch; }
  __device__ __forceinline__ const bf16_t* vaddr(int krow, int ch) const { return v + (size_t)krow * 64 + 8 * ch; } };
constexpr int NSA_BUF = 2 * (64 * 144 + 64 * 160);
constexpr int NSA_IMP = 16 * 132 * 4;
static_assert(NSA_BUF + 8 * NSA_IMP <= LDS_BYTES, "nsa lds");

template <bool MASK>
__device__ __forceinline__ void cmp_imp_chunk(const bf16x8 (&qf)[4][2], LAS const unsigned char* Kl, int kpos0, int tq, const float (&mc)[4], const float (&inv)[4], float c,
                                              float& carry_prev, LAS float* imp_row, int lane) {
  const int r = lane & 15, lg = lane >> 4; const int src = (lane + 48) & 63;
#pragma unroll
  for (int st = 0; st < 2; ++st)
#pragma unroll
    for (int t = 0; t < 2; ++t) {
      f32x4 s[4];
#pragma unroll
      for (int kk = 0; kk < 2; ++kk) { const bf16x8 kf = *(LAS const bf16x8*)(Kl + (32 * st + 16 * t + r) * 144 + (32 * kk + 8 * lg) * 2);
#pragma unroll
        for (int j = 0; j < 4; ++j) s[j] = mfma16(kf, qf[j][kk], kk == 0 ? (f32x4){0.f, 0.f, 0.f, 0.f} : s[j]); }
      float ps[4];
#pragma unroll
      for (int i = 0; i < 4; ++i) { const int kp = kpos0 + 32 * st + 16 * t + 4 * lg + i; float a = 0.f;
#pragma unroll
        for (int j = 0; j < 4; ++j) a += ex2(s[j][i] * c - mc[j]) * inv[j];
        ps[i] = (!MASK || (16 * kp + 31 <= tq)) ? a : 0.f; }
      const float own = 2.0f * (ps[0] + ps[1] + ps[2]) + ps[3];
      const float up_same = __shfl(ps[3], src), up_prev = __shfl(carry_prev, src);
      const float cin = lg > 0 ? up_same : up_prev;
      carry_prev = ps[3];
      imp_row[((kpos0 + 32 * st + 16 * t) >> 2) + lg] = own + cin;
    }
}

__device__ __forceinline__ void nsa_unit(LAS unsigned char* lds, const Ctx& X, bf16_t* OB, int b, int g, int qb) {
  const int tid = otid(), lane = tid & 63, w = __builtin_amdgcn_readfirstlane(tid >> 6);
#define cq ((otid() & 63) & 15)
#define lg ((otid() & 63) >> 4)
  const size_t rowbase = (size_t)b * S; const int q0 = qb * 128, qw = q0 + 16 * w;
#define tqc (qw + cq)
#define myrow (rowbase + (size_t)tqc)
  const float c = 0.125f * LOG2E;
  LAS float* impw = (LAS float*)(lds + NSA_BUF + w * NSA_IMP);
  int tq[4];
#pragma unroll
  for (int j = 0; j < 4; ++j) tq[j] = tqc;
  for (int i = lane; i < 16 * 132; i += 64) impw[i] = 0.f;
#ifndef NSA_NO_A
  {
    bf16x8 qf[4][2]; f32x4 o[4][4]; float m[4], l[4];
#pragma unroll
    for (int j = 0; j < 4; ++j) { m[j] = -INFINITY; l[j] = 0.f;
#pragma unroll
      for (int kk = 0; kk < 2; ++kk) qf[j][kk] = *(const bf16x8*)(X.PROJ() + myrow * NPROJ + C_BQ + 64 * (4 * g + j) + 32 * kk + 8 * lg);
#pragma unroll
      for (int dt = 0; dt < 4; ++dt) o[j][dt] = (f32x4){0.f, 0.f, 0.f, 0.f}; }
    SrcCmp src{X.KCMP() + (size_t)(b * 2 + g) * 512 * 64, X.VCMP() + (size_t)(b * 2 + g) * 512 * 64};
    const int ncb = 8 * qb + 7, nch = (ncb + 63) >> 6;
    attn_block_loop<4, 64, 64, MODE_CMP, 1, SrcCmp>(lds, src, o, m, l, qf, tq, 0, nch, 0, qw, qw + 15, c, 0);
    float mc[4], inv[4];
#pragma unroll
    for (int j = 0; j < 4; ++j) { const float lt = lsum4(l[j]); inv[j] = lt > 0.f ? 1.0f / lt : 0.f; mc[j] = ((m[j] == -INFINITY) ? 0.f : m[j]) * c;
      const float g0 = sigmoidf_(bf2f(X.PROJ()[myrow * NPROJ + C_BG + 3 * (4 * g + j) + 0])); const float sc = inv[j] * g0;
#pragma unroll
      for (int dt = 0; dt < 4; ++dt) store4(OB + myrow * 512 + 64 * (4 * g + j) + 16 * dt + 4 * lg, o[j][dt], sc); }
    {
      constexpr int KB = 64 * 144, BUF = KB + 64 * 160;
      float carry = 0.f;
      u32x4 kreg;
      { const int row = tid >> 3, ch = tid & 7; kreg = *(const u32x4*)src.kaddr(row, ch); }
      for (int kc = 0; kc < nch; ++kc) {
        LAS unsigned char* buf = lds + (kc & 1) * BUF;
        { const int row = tid >> 3, ch = tid & 7; *(LAS u32x4*)(buf + row * 144 + ch * 16) = kreg; if (kc + 1 < nch) kreg = *(const u32x4*)src.kaddr((kc + 1) * 64 + row, ch); }
        LBAR();
        const int lo = 64 * kc, hi = lo + 63;
        const bool rel = 16 * lo + 31 <= qw + 15, full = 16 * hi + 31 <= qw;
        if (rel) { if (full) cmp_imp_chunk<false>(qf, buf, lo, tqc, mc, inv, c, carry, impw + cq * 132, lane);
                   else cmp_imp_chunk<true>(qf, buf, lo, tqc, mc, inv, c, carry, impw + cq * 132, lane); }
      }
      LBAR();
    }
  }
#endif
#ifndef NSA_NO_C
  {
    for (int idx = lane; idx < 16 * 128; idx += 64) { const int q = idx >> 7, j = idx & 127; const int t = qw + q, cur = t >> 6;
      const float v = impw[q * 132 + j]; const bool forced = (j == 0) || (j == cur) || (j == cur - 1);
      impw[q * 132 + j] = (j > cur) ? -INFINITY : v + (forced ? 1e4f : 0.f); }
    LWAIT();
    for (int idx = lane; idx < 16 * 128; idx += 64) { const int qq = idx >> 7, j = idx & 127; const unsigned u = __float_as_uint(impw[qq * 132 + j]);
      const unsigned ok = (u & 0x80000000u) ? ~u : (u | 0x80000000u); ((LAS unsigned*)impw)[qq * 132 + j] = (ok & ~127u) | (unsigned)(127 - j); }
    LWAIT();
    const int q = lane >> 2, part = lane & 3;
    unsigned sj[32];
    LAS const unsigned* keyw = (LAS const unsigned*)impw;
#pragma unroll
    for (int jj = 0; jj < 32; ++jj) sj[jj] = keyw[q * 132 + 32 * part + jj];
    unsigned thr = 0u;
#pragma unroll 1
    for (int bit = 31; bit >= 0; --bit) {
      const unsigned cand = thr | (1u << bit); int cn = 0;
#pragma unroll
      for (int jj = 0; jj < 32; ++jj) cn += (sj[jj] >= cand) ? 1 : 0;
      cn += __shfl_xor(cn, 1); cn += __shfl_xor(cn, 2);
      thr = (cn >= 16) ? cand : thr;
    }
    int mine = 0;
#pragma unroll
    for (int jj = 0; jj < 32; ++jj) mine += (sj[jj] >= thr) ? 1 : 0;
    const int c0 = __shfl(mine, (lane & ~3) + 0), c1 = __shfl(mine, (lane & ~3) + 1), c2 = __shfl(mine, (lane & ~3) + 2);
    int slot = (part > 0 ? c0 : 0) + (part > 1 ? c1 : 0) + (part > 2 ? c2 : 0);
    unsigned char* sell = X.SELL() + ((rowbase + qw + q) * 2 + g) * 16;
#pragma unroll
    for (int jj = 0; jj < 32; ++jj) if (sj[jj] >= thr) { sell[slot] = (unsigned char)((32 * part + jj) | (((sj[jj] & ~127u) == 0x007FFF80u) ? 128 : 0)); ++slot; }
    LWAIT();
  }
#endif
#ifndef NSA_NO_E

  {
    bf16x8 qf[4][2]; f32x4 o[4][4]; float m[4], l[4];
#pragma unroll
    for (int j = 0; j < 4; ++j) { m[j] = -INFINITY; l[j] = 0.f;
#pragma unroll
      for (int kk = 0; kk < 2; ++kk) qf[j][kk] = *(const bf16x8*)(X.QROT() + myrow * 512 + 64 * (4 * g + j) + 32 * kk + 8 * lg);
#pragma unroll
      for (int dt = 0; dt < 4; ++dt) o[j][dt] = (f32x4){0.f, 0.f, 0.f, 0.f}; }
    const int kbase = q0 - 512;
    SrcProj src{X.PROJ(), rowbase + kbase, C_BKW + 64 * g, C_BVW + 64 * g};
    const int kc0 = kbase < 0 ? (-kbase) >> 6 : 0;
    attn_block_loop<4, 64, 64, MODE_WINDOW, 1, SrcProj>(lds, src, o, m, l, qf, tq, kc0, 10, kbase, qw, qw + 15, c, 512);
#pragma unroll
    for (int j = 0; j < 4; ++j) { const float lt = lsum4(l[j]); const float inv = lt > 0.f ? 1.0f / lt : 0.f;
      const float g2 = sigmoidf_(bf2f(X.PROJ()[myrow * NPROJ + C_BG + 3 * (4 * g + j) + 2])); const float sc = inv * g2;
#pragma unroll
      for (int dt = 0; dt < 4; ++dt) store4(X.OW() + myrow * 512 + 64 * (4 * g + j) + 16 * dt + 4 * lg, o[j][dt], sc); }
  }
#endif
  LBAR();
}
#undef cq
#undef lg
#undef tqc
#undef myrow

struct SelFrag { u32x4 kf[4]; u32x4 vf[4]; };
__device__ __forceinline__ void sel_load(SelFrag& F, const bf16_t* kst, const bf16_t* vst, int blk, int cq, int lg) {
  const unsigned char* kp = (const unsigned char*)kst + (size_t)blk * 4096 + (cq * 4 + lg) * 16;
  const unsigned char* vp = (const unsigned char*)vst + (size_t)blk * 4096 + (cq * 4 + lg) * 16;
#pragma unroll
  for (int t4 = 0; t4 < 4; ++t4) F.kf[t4] = *(const u32x4*)(kp + t4 * 1024);
#pragma unroll
  for (int dt = 0; dt < 4; ++dt) F.vf[dt] = *(const u32x4*)(vp + dt * 1024);
}
__device__ __forceinline__ void sel_compute(const SelFrag& F, const long (&qs)[2], f32x4 (&os)[4], float& m, float& l, int blk, int cur, int t, int lg, float c) {
  f32x4 s[4];
#pragma unroll
  for (int t4 = 0; t4 < 4; ++t4) { s[t4] = mfma16_fp8(as_long(F.kf[t4].x, F.kf[t4].y), qs[0], (f32x4){0.f, 0.f, 0.f, 0.f}); s[t4] = mfma16_fp8(as_long(F.kf[t4].z, F.kf[t4].w), qs[1], s[t4]); }
  float mx = -INFINITY;
#pragma unroll
  for (int t4 = 0; t4 < 4; ++t4)
#pragma unroll
    for (int i = 0; i < 4; ++i) { if (blk == cur) { const int key = 64 * blk + 16 * t4 + 4 * lg + i; if (key > t) s[t4][i] = -INFINITY; } mx = fmaxf(mx, s[t4][i]); }
  mx = max_x16_x32(mx);
  if (__any(mx > m + 8.0f / c)) {
    const float mnew = fmaxf(m, mx), ms2 = (mnew == -INFINITY) ? 0.f : mnew, alpha = ex2((m - ms2) * c);
    m = mnew; l *= alpha;
#pragma unroll
    for (int dt = 0; dt < 4; ++dt) os[dt] *= alpha;
  }
  const float mcc = ((m == -INFINITY) ? 0.f : m) * c;
  float p[4][4], ps = 0.f;
#pragma unroll
  for (int t4 = 0; t4 < 4; ++t4)
#pragma unroll
    for (int i = 0; i < 4; ++i) { p[t4][i] = ex2(s[t4][i] * c - mcc); ps += p[t4][i]; }
  l += ps;
  const u32x2 pa = pack8_fp8(p[0], p[1]), pb = pack8_fp8(p[2], p[3]);
  const long pf0 = as_long(pa.x, pa.y), pf1 = as_long(pb.x, pb.y);
#pragma unroll
  for (int dt = 0; dt < 4; ++dt) { os[dt] = mfma16_fp8(as_long(F.vf[dt].x, F.vf[dt].y), pf0, os[dt]); os[dt] = mfma16_fp8(as_long(F.vf[dt].z, F.vf[dt].w), pf1, os[dt]); }
}
__device__ __forceinline__ int sel_slot(const u32x4& sl, int slot) {
  const unsigned wsel = slot < 4 ? sl.x : slot < 8 ? sl.y : slot < 12 ? sl.z : sl.w;
  return __builtin_amdgcn_readfirstlane((int)((wsel >> (8 * (slot & 3))) & 127u));
}
__device__ __forceinline__ void nsa_sel_phase(const Ctx& X, bf16_t* OBp) {
  const int tid = otid(), lane = tid & 63, cq = lane & 15, lg = lane >> 4, hcol = lane & 3;
  const int w = __builtin_amdgcn_readfirstlane(tid >> 6);
  const float c = 0.125f * LOG2E;
  const bool xmap = (X.G % 8) == 0;
  const int npw = xmap ? (X.G / 8) * 8 : X.G * 8;
  const int wi = xmap ? (X.blk / 8) * 8 + w : X.blk * 8 + w;
  const int ntask = xmap ? S : T * 2;
#define SEL_DECODE(kk_, b_, g_, t_) do { if (xmap) { const int pr = X.blk & 7; b_ = pr >> 1; g_ = pr & 1; t_ = (kk_); } else { const int rowi = (kk_) >> 1; g_ = (kk_) & 1; b_ = rowi >> 13; t_ = rowi & 8191; } } while (0)
  int k = wi;
  if (k >= ntask) return;
  SelFrag FA, FB;
  u32x4 sl, sln;
  { int b, g, t; SEL_DECODE(k, b, g, t); sl = *(const u32x4*)(X.SELL() + (((size_t)b * S + t) * 2 + g) * 16); sln = sl;
    sel_load(FA, (const bf16_t*)((const unsigned char*)X.KST() + (size_t)(b * 2 + g) * 128 * 4096), (const bf16_t*)((const unsigned char*)X.VST() + (size_t)(b * 2 + g) * 128 * 4096), sel_slot(sl, 0), cq, lg); }
  for (; k < ntask; k += npw) {
    int b, g, t; SEL_DECODE(k, b, g, t);
    const int cur = t >> 6; const int nv = cur + 1 < 16 ? cur + 1 : 16;
    const size_t rowbase = (size_t)b * S, row = rowbase + t;
    const bf16_t* projk = (const bf16_t*)((const unsigned char*)X.KST() + (size_t)(b * 2 + g) * 128 * 4096);
    const bf16_t* vst = (const bf16_t*)((const unsigned char*)X.VST() + (size_t)(b * 2 + g) * 128 * 4096);
    const int kn = k + npw; int bn = b, gn = g, tn = t;
    if (kn < ntask) { SEL_DECODE(kn, bn, gn, tn); sln = *(const u32x4*)(X.SELL() + (((size_t)bn * S + tn) * 2 + gn) * 16); }
    long qs[2];
#pragma unroll
    for (int kk = 0; kk < 2; ++kk) { const u32x4 qw4 = *(const u32x4*)(X.QROT() + row * 512 + 64 * (4 * g + hcol) + 32 * kk + 8 * lg);
      const float a4[4] = {bflo(qw4.x), bfhi(qw4.x), bflo(qw4.y), bfhi(qw4.y)}, b4[4] = {bflo(qw4.z), bfhi(qw4.z), bflo(qw4.w), bfhi(qw4.w)};
      const u32x2 q8 = pack8_fp8(a4, b4); qs[kk] = as_long(q8.x, q8.y); }
    float m = -INFINITY, l = 0.f; f32x4 os[4];
#pragma unroll
    for (int dt = 0; dt < 4; ++dt) os[dt] = (f32x4){0.f, 0.f, 0.f, 0.f};
    int blkA = sel_slot(sl, 0), blkB = 0;
    for (int sidx = 0; sidx < nv; sidx += 2) {
      const bool hasB = sidx + 1 < nv;
      if (hasB) { blkB = sel_slot(sl, sidx + 1); sel_load(FB, projk, vst, blkB, cq, lg); }
      sel_compute(FA, qs, os, m, l, blkA, cur, t, lg, c);
      if (hasB) {
        if (sidx + 2 < nv) { blkA = sel_slot(sl, sidx + 2); sel_load(FA, projk, vst, blkA, cq, lg); }
        sel_compute(FB, qs, os, m, l, blkB, cur, t, lg, c);
      }
    }
    if (kn < ntask) sel_load(FA, (const bf16_t*)((const unsigned char*)X.KST() + (size_t)(bn * 2 + gn) * 128 * 4096), (const bf16_t*)((const unsigned char*)X.VST() + (size_t)(bn * 2 + gn) * 128 * 4096), sel_slot(sln, 0), cq, lg);
    const float lt = lsum4(l); const float inv = lt > 0.f ? 1.0f / lt : 0.f;
    const float g1 = sigmoidf_(bf2f(X.PROJ()[row * NPROJ + C_BG + 3 * (4 * g + hcol) + 1]));
    if (cq < 4) {
      const float sc = inv * g1;
      u32x2 av[4], wv[4];
#pragma unroll
      for (int dt = 0; dt < 4; ++dt) { const size_t off = row * 512 + 64 * (4 * g + cq) + 16 * dt + 4 * lg; av[dt] = *(const u32x2*)(OBp + off); wv[dt] = *(const u32x2*)(X.OW() + off); }
#pragma unroll
      for (int dt = 0; dt < 4; ++dt) { const size_t off = row * 512 + 64 * (4 * g + cq) + 16 * dt + 4 * lg; const u32x2 a = av[dt], w2 = wv[dt];
        f32x4 v = os[dt] * sc; v[0] += bflo(a.x) + bflo(w2.x); v[1] += bfhi(a.x) + bfhi(w2.x); v[2] += bflo(a.y) + bflo(w2.y); v[3] += bfhi(a.y) + bfhi(w2.y);
        store4(OBp + off, v, 1.0f); }
    }
    sl = sln;
  }
#undef SEL_DECODE
}

__device__ __forceinline__ void nsa_compress_task(LAS unsigned char* lds, const Ctx& X, const float* pe_k, const float* pe_v, int task) {
  const int tid = otid(), lane = tid & 63, w = __builtin_amdgcn_readfirstlane(tid >> 6), r = lane & 15, lg = lane >> 4;
  const int kind = task >> 8, rem = task & 255, b = rem >> 6, g = (rem >> 5) & 1, c0 = (rem & 31) * 16;
  const float* pe = kind ? pe_v : pe_k; const bf16_t* w1 = X.W() + (kind ? W_V1 : W_K1); const bf16_t* w2 = X.W() + (kind ? W_V2 : W_K2);
  const int col = (kind ? C_BVC : C_BKC) + 64 * g;
  LAS float* red = (LAS float*)lds;
  LAS bf16_t* h1 = (LAS bf16_t*)(lds + 8 * 16 * 64 * 4);
  f32x4 acc[4];
#pragma unroll
  for (int nt = 0; nt < 4; ++nt) acc[nt] = (f32x4){0.f, 0.f, 0.f, 0.f};
  const int cmy = c0 + r;
#pragma unroll 2
  for (int k8 = 0; k8 < 8; ++k8) { const int kk = 8 * w + k8; const int lt = kk >> 1, d = (kk & 1) * 32 + 8 * lg;
    int tok = 16 * cmy + lt; tok = tok > S - 1 ? S - 1 : tok;
    const u32x4 kv = *(const u32x4*)(X.PROJ() + ((size_t)b * S + tok) * NPROJ + col + d);
    const f32x4 pa = *(const f32x4*)(pe + lt * 64 + d), pb = *(const f32x4*)(pe + lt * 64 + d + 4);
    u32x4 aw; aw.x = cvt_pk_bf16(bflo(kv.x) + pa[0], bfhi(kv.x) + pa[1]); aw.y = cvt_pk_bf16(bflo(kv.y) + pa[2], bfhi(kv.y) + pa[3]);
    aw.z = cvt_pk_bf16(bflo(kv.z) + pb[0], bfhi(kv.z) + pb[1]); aw.w = cvt_pk_bf16(bflo(kv.w) + pb[2], bfhi(kv.w) + pb[3]);
    const bf16x8 af = __builtin_bit_cast(bf16x8, aw);
#pragma unroll
    for (int nt = 0; nt < 4; ++nt) { const bf16x8 bfr = *(const bf16x8*)(w1 + (size_t)(16 * nt + r) * 2048 + 32 * kk + 8 * lg); acc[nt] = mfma16(af, bfr, acc[nt]); }
  }
#pragma unroll
  for (int nt = 0; nt < 4; ++nt)
#pragma unroll
    for (int i = 0; i < 4; ++i) red[(w * 16 + 4 * lg + i) * 64 + 16 * nt + r] = acc[nt][i];
  LBAR();
  for (int e = tid; e < 1024; e += 512) { float sacc = 0.f;
#pragma unroll
    for (int ww = 0; ww < 8; ++ww) sacc += red[ww * 1024 + e];
    const float hval = sacc * sigmoidf_(sacc); h1[(e >> 6) * 72 + (e & 63)] = (bf16_t)(cvt_pk_bf16(hval, 0.f) & 0xffffu); }
  LBAR();
  if (w == 0) {
    f32x4 o2[4];
#pragma unroll
    for (int nt = 0; nt < 4; ++nt) o2[nt] = (f32x4){0.f, 0.f, 0.f, 0.f};
#pragma unroll
    for (int kk = 0; kk < 2; ++kk) { const bf16x8 af = *(LAS const bf16x8*)(h1 + r * 72 + 32 * kk + 8 * lg);
#pragma unroll
      for (int nt = 0; nt < 4; ++nt) { const bf16x8 bfr = *(const bf16x8*)(w2 + (16 * nt + r) * 64 + 32 * kk + 8 * lg); o2[nt] = mfma16(af, bfr, o2[nt]); } }
    bf16_t* dst = (kind ? X.VCMP() : X.KCMP()) + ((size_t)(b * 2 + g) * 512 + c0) * 64;
#pragma unroll
    for (int nt = 0; nt < 4; ++nt)
#pragma unroll
      for (int i = 0; i < 4; ++i) dst[(4 * lg + i) * 64 + 16 * nt + r] = (bf16_t)(cvt_pk_bf16(o2[nt][i], 0.f) & 0xffffu);
  }
  LBAR();
}

__device__ __forceinline__ void rms_row_bf16(const float* xrow, const float* gain, bf16_t* orow, int lane) {
  const f32x4* xr = (const f32x4*)xrow + lane; const f32x4* gr = (const f32x4*)gain + lane;
  f32x4 v[4]; float s = 0.f;
#pragma unroll
  for (int j = 0; j < 4; ++j) { v[j] = xr[64 * j]; s += (v[j].x * v[j].x + v[j].y * v[j].y) + (v[j].z * v[j].z + v[j].w * v[j].w); }
  const float rstd = 1.0f / sqrtf(wave_sum(s) * (1.f / 1024.f) + NORM_EPS);
  u32x2* o8 = (u32x2*)orow + lane;
#pragma unroll
  for (int j = 0; j < 4; ++j) { const f32x4 gg = gr[64 * j]; u32x2 wv; wv.x = cvt_pk_bf16(v[j].x * rstd * gg.x, v[j].y * rstd * gg.y); wv.y = cvt_pk_bf16(v[j].z * rstd * gg.z, v[j].w * rstd * gg.w); o8[64 * j] = wv; }
}
__device__ __forceinline__ void rms_phase(const Ctx& X, const float* src, const float* gain, bf16_t* dst, int rows) {
  const int tid_ = otid(); const int lane = tid_ & 63, gw = X.blk * 8 + (tid_ >> 6), NGW = X.G * 8;
  for (int mrow = gw; mrow < rows; mrow += NGW) rms_row_bf16(src + (size_t)mrow * 1024, gain, dst + (size_t)mrow * 1024, lane);
}
__device__ __forceinline__ void xb_prepass(const Ctx& X, const float* src) {
  const int tid_ = otid(); const int lane = tid_ & 63, gw = X.blk * 8 + (tid_ >> 6), NGW = X.G * 8;
  for (int mrow = gw; mrow < T; mrow += NGW) {
    const f32x4* xr = (const f32x4*)(src + (size_t)mrow * 1024) + lane; u32x2* o8 = (u32x2*)(X.H() + (size_t)mrow * 1024) + lane; float sacc = 0.f;
    f32x4 vv[4];
#pragma unroll
    for (int j = 0; j < 4; ++j) vv[j] = xr[64 * j];
#pragma unroll
    for (int j = 0; j < 4; ++j) { const f32x4 v = vv[j]; sacc += (v.x * v.x + v.y * v.y) + (v.z * v.z + v.w * v.w); u32x2 wv; wv.x = cvt_pk_bf16(v.x, v.y); wv.y = cvt_pk_bf16(v.z, v.w); o8[64 * j] = wv; }
    sacc = wave_sum(sacc);
    if (lane == 0) *(f32x4*)(X.RSS() + (size_t)mrow * 4) = (f32x4){sacc, 0.f, 0.f, 0.f};
  }
}
__device__ __forceinline__ void final_norm_phase(const Ctx& X, const float* gain) {
  const int tid_ = otid(); const int lane = tid_ & 63, gw = X.blk * 8 + (tid_ >> 6), NGW = X.G * 8;
  for (int mrow = gw; mrow < T; mrow += NGW) {
    f32x4* xr = (f32x4*)(X.out + (size_t)mrow * 1024) + lane; const f32x4* gr = (const f32x4*)gain + lane;
    f32x4 v[4]; float s = 0.f;
#pragma unroll
    for (int j = 0; j < 4; ++j) { v[j] = xr[64 * j]; s += (v[j].x * v[j].x + v[j].y * v[j].y) + (v[j].z * v[j].z + v[j].w * v[j].w); }
    const float rstd = 1.0f / sqrtf(wave_sum(s) * (1.f / 1024.f) + NORM_EPS);
#pragma unroll
    for (int j = 0; j < 4; ++j) { const f32x4 gg = gr[64 * j]; xr[64 * j] = (f32x4){v[j].x * rstd * gg.x, v[j].y * rstd * gg.y, v[j].z * rstd * gg.z, v[j].w * rstd * gg.w}; }
  }
}
__device__ __forceinline__ void mla_norm_phase(const Ctx& X, const float* qg, const float* kvg) {
  const int tid_ = otid(); const int lane = tid_ & 63, gw = X.blk * 8 + (tid_ >> 6), NGW = X.G * 8;
  for (int mrow = gw; mrow < T; mrow += NGW) {
    bf16_t* pr = X.PROJ() + (size_t)mrow * NPROJ;
    u32x4 a = (u32x4){0, 0, 0, 0}, bq = (u32x4){0, 0, 0, 0};
    if (lane < 48) a = *(const u32x4*)(pr + C_CQA + 8 * lane);
    if (lane < 32) bq = *(const u32x4*)(pr + C_CKV + 8 * lane);
    float fa[8] = {bflo(a.x), bfhi(a.x), bflo(a.y), bfhi(a.y), bflo(a.z), bfhi(a.z), bflo(a.w), bfhi(a.w)};
    float fb[8] = {bflo(bq.x), bfhi(bq.x), bflo(bq.y), bfhi(bq.y), bflo(bq.z), bfhi(bq.z), bflo(bq.w), bfhi(bq.w)};
    float sa = 0.f, sb = 0.f;
#pragma unroll
    for (int e = 0; e < 8; ++e) { sa += fa[e] * fa[e]; sb += fb[e] * fb[e]; }
    const float ra = 1.0f / sqrtf(wave_sum(sa) * (1.f / 384.f) + NORM_EPS), rb = 1.0f / sqrtf(wave_sum(sb) * (1.f / 256.f) + NORM_EPS);
    if (lane < 48) { const f32x4 g0 = *(const f32x4*)(qg + 8 * lane), g1 = *(const f32x4*)(qg + 8 * lane + 4); u32x4 wv;
      wv.x = cvt_pk_bf16(fa[0] * ra * g0[0], fa[1] * ra * g0[1]); wv.y = cvt_pk_bf16(fa[2] * ra * g0[2], fa[3] * ra * g0[3]);
      wv.z = cvt_pk_bf16(fa[4] * ra * g1[0], fa[5] * ra * g1[1]); wv.w = cvt_pk_bf16(fa[6] * ra * g1[2], fa[7] * ra * g1[3]); *(u32x4*)(pr + C_CQA + 8 * lane) = wv; }
    if (lane < 32) { const f32x4 g0 = *(const f32x4*)(kvg + 8 * lane), g1 = *(const f32x4*)(kvg + 8 * lane + 4); u32x4 wv;
      wv.x = cvt_pk_bf16(fb[0] * rb * g0[0], fb[1] * rb * g0[1]); wv.y = cvt_pk_bf16(fb[2] * rb * g0[2], fb[3] * rb * g0[3]);
      wv.z = cvt_pk_bf16(fb[4] * rb * g1[0], fb[5] * rb * g1[1]); wv.w = cvt_pk_bf16(fb[6] * rb * g1[2], fb[7] * rb * g1[3]); *(u32x4*)(pr + C_CKV + 8 * lane) = wv; }
  }
}

__device__ __forceinline__ void sincos_precise(float a, float& cs, float& sn) {
  const double x = (double)a; const double k = rint(x * 0.63661977236758134308);
  double rr = fma(-k, 1.57079632679489655800e+00, x); rr = fma(-k, 6.12323399573676603587e-17, rr);
  const double r2 = rr * rr;
  double sp = -1.0 / 1307674368000.0; sp = sp * r2 + 1.0 / 6227020800.0; sp = sp * r2 - 1.0 / 39916800.0; sp = sp * r2 + 1.0 / 362880.0; sp = sp * r2 - 1.0 / 5040.0; sp = sp * r2 + 1.0 / 120.0; sp = sp * r2 - 1.0 / 6.0; sp = sp * r2 + 1.0;
  const double sv = sp * rr;
  double cp = 1.0 / 87178291200.0; cp = cp * r2 - 1.0 / 479001600.0; cp = cp * r2 + 1.0 / 3628800.0; cp = cp * r2 - 1.0 / 40320.0; cp = cp * r2 + 1.0 / 720.0; cp = cp * r2 - 1.0 / 24.0; cp = cp * r2 + 0.5; const double cv = 1.0 - cp * r2;
  const int q = ((int)(long long)k) & 3;
  const double c2 = (q == 0) ? cv : (q == 1) ? -sv : (q == 2) ? -cv : sv;
  const double s2 = (q == 0) ? sv : (q == 1) ? cv : (q == 2) ? -sv : -cv;
  cs = (float)c2; sn = (float)s2;
}
__device__ __forceinline__ void tables_phase(const Ctx& X, const Params& P) {
  const int* pos = (const int*)X.in[2];
  const int gt = X.blk * 512 + otid(), NG = X.G * 512;
  for (int idx = gt; idx < T * 48; idx += NG) {
    const int row = idx / 48, i = idx % 48; const float pf = (float)pos[row];
    float cs, sn;
    if (i < 32) { sincos_precise(pf * P.invf64[i], cs, sn); X.CS64()[(size_t)row * 32 + i] = (f32x2){cs, sn}; }
    else { sincos_precise(pf * P.invf32[i - 32], cs, sn); X.CS32()[(size_t)row * 16 + (i - 32)] = (f32x2){cs, sn}; }
  }
}

enum { CM_ID = 0, CM_INPROJ = 1, CM_QB = 2, CM_GU = 3, CM_IL64 = 4 };
__device__ __forceinline__ int colmap(int kind, int n, int off) {
  if (kind == CM_ID) return off + n;
  if (kind == CM_INPROJ) {
    if (n < 2048) { const int sg = n >> 7; const bool il = (sg <= 4) || (sg >= 6 && sg <= 9) || sg == 12 || sg == 14;
      if (!il) return n; const int hb = n & ~63, o = n & 63; return hb + (o >> 1) + 32 * (o & 1); }
    if (n < 2432) return 2072 + (n - 2048);
    if (n < 2688) return 2456 + (n - 2432);
    if (n < 2720) { const int o = n - 2688; return 2712 + (o >> 1) + 16 * (o & 1); }
    if (n < 2744) return 2048 + (n - 2720);
    return -1;
  }
  if (kind == CM_QB) { const int h = n / 96, o = n % 96; if (o < 64) return n; const int oo = o - 64; return 96 * h + 64 + (oo >> 1) + 16 * (oo & 1); }
  if (kind == CM_GU) { const int j = n >> 3, e = n & 7; return e < 4 ? 4 * j + e : DFF + 4 * j + (e - 4); }
    { const int o = n & 63; return (n & ~63) + (o >> 1) + 32 * (o & 1); }
}
struct WDesc { const float* src; int K, pitch, N, kind, off; size_t dst; };
__device__ __forceinline__ void wconv_tile(LAS float* tl, const WDesc& d, bf16_t* Wb, int tile, const float* gain) {
  const int tid = otid(); const int nb = d.N >> 6; const int kb = tile / nb, nbi = tile % nb; const int k0 = kb * 64, n0 = nbi * 64;
  { const int nn = tid & 63; const int sc = colmap(d.kind, n0 + nn, d.off);
#pragma unroll
    for (int rr = 0; rr < 8; ++rr) { const int kk = (tid >> 6) + 8 * rr; tl[kk * 65 + nn] = sc >= 0 ? d.src[(size_t)(k0 + kk) * d.pitch + sc] * (gain ? gain[k0 + kk] : 1.0f) : 0.f; } }
  LBAR();
  { const int kp = tid & 31;
#pragma unroll
    for (int rr = 0; rr < 4; ++rr) { const int nn = (tid >> 5) + 16 * rr; const unsigned wv = cvt_pk_bf16(tl[(2 * kp) * 65 + nn], tl[(2 * kp + 1) * 65 + nn]);
      *(unsigned*)(Wb + d.dst + (size_t)(n0 + nn) * d.K + k0 + 2 * kp) = wv; } }
  LBAR();
}
__device__ __forceinline__ WDesc wdesc(const float* const* in, size_t L, int i) {
  switch (i) {
    case 0: return WDesc{in[4] + L * 1024 * DIN, 1024, DIN, NPROJ, CM_INPROJ, 0, W_IN};
    case 1: return WDesc{in[4] + L * 1024 * DIN, 1024, DIN, NGATE, CM_ID, 2744, W_G};
    case 2: return WDesc{in[13] + L * 384 * 768, 384, 768, 768, CM_QB, 0, W_QB};
    case 3: return WDesc{in[15] + L * 256 * 1024, 256, 1024, 1024, CM_ID, 0, W_KVB};
    case 4: return WDesc{in[16] + L * 512 * 1024, 512, 1024, 1024, CM_ID, 0, W_BR};
    case 5: return WDesc{in[17] + L * 512 * 1024, 512, 1024, 1024, CM_ID, 0, W_BR + 1024 * 512};
    case 6: return WDesc{in[18] + L * 512 * 1024, 512, 1024, 1024, CM_ID, 0, W_BR + 2 * 1024 * 512};
    case 7: return WDesc{in[19] + L * 1024 * 1024, 1024, 1024, 1024, CM_ID, 0, W_OUT};
    case 8: return WDesc{in[22] + L * 1024 * 512, 1024, 512, 512, CM_ID, 0, W_XQ};
    case 9: return WDesc{in[23] + L * 1024 * 1024, 1024, 1024, 1024, CM_ID, 0, W_XKV};
    case 10: return WDesc{in[24] + L * 512 * 1024, 512, 1024, 1024, CM_ID, 0, W_XO};
    case 11: return WDesc{in[26] + L * 1024 * NGU, 1024, NGU, NGU, CM_GU, 0, W_GU};
    case 12: return WDesc{in[27] + L * DFF * 1024, DFF, 1024, 1024, CM_ID, 0, W_DOWN};
    case 13: return WDesc{in[8] + L * 2048 * 64, 2048, 64, 64, CM_ID, 0, W_K1};
    case 14: return WDesc{in[10] + L * 2048 * 64, 2048, 64, 64, CM_ID, 0, W_V1};
    case 15: return WDesc{in[9] + L * 64 * 64, 64, 64, 64, CM_IL64, 0, W_K2};
    default: return WDesc{in[11] + L * 64 * 64, 64, 64, 64, CM_ID, 0, W_V2};
  }
}
__device__ __forceinline__ int wtiles(int i) {
  constexpr int tl[17] = {16 * 44, 16 * 48, 6 * 12, 4 * 16, 8 * 16, 8 * 16, 8 * 16, 16 * 16, 16 * 8, 16 * 16, 8 * 16, 16 * 88, 44 * 16, 32, 32, 1, 1};
  int r = 0;
#pragma unroll
  for (int k = 0; k < 17; ++k) r = (i == k) ? tl[k] : r;
  return r;
}
__device__ __forceinline__ void wconv_phase(LAS unsigned char* lds, const Ctx& X, int layer) {
  constexpr int TOTAL = 16 * 44 + 16 * 48 + 6 * 12 + 4 * 16 + 3 * 8 * 16 + 16 * 16 + 16 * 8 + 16 * 16 + 8 * 16 + 16 * 88 + 44 * 16 + 32 + 32 + 1 + 1;
  for (int t = X.blk; t < TOTAL; t += X.G) {
    int rem = t, mi = 0;
#pragma unroll 1
    for (; mi < 16; ++mi) { const int n = wtiles(mi); if (rem < n) break; rem -= n; }
    const WDesc d = wdesc(X.in, (size_t)layer, mi);
    const int gi = (mi <= 1) ? 3 : (mi == 8) ? 20 : (mi == 11) ? 25 : -1;
    const float* gain = gi >= 0 ? X.in[gi] + (size_t)layer * 1024 : nullptr;
    wconv_tile((LAS float*)lds, d, X.W(), rem, gain);
  }
}

#define RLX_AGENT __ATOMIC_RELAXED, __HIP_MEMORY_SCOPE_AGENT
#define XB_TMO      128
#define XB_XCNT(j)  (256  + 64 * (j))
#define XB_XSUB(j)  (1280 + 64 * (j))
#define XB_XGEN(j)  (2304 + 64 * (j))
#define XB_TOP      3328
#define XB_TOPGEN   3392
#define XCD_BAR_WORDS 3456
#define XB_SPIN_CAP (1u << 18)

__device__ __forceinline__ unsigned xb_ld(unsigned* p)              { return __hip_atomic_load(p, __ATOMIC_RELAXED, __HIP_MEMORY_SCOPE_AGENT); }
__device__ __forceinline__ unsigned xb_add(unsigned* p, unsigned v) { return __hip_atomic_fetch_add(p, v, __ATOMIC_RELAXED, __HIP_MEMORY_SCOPE_AGENT); }
__device__ __forceinline__ unsigned xb_xcc_id() { return (unsigned)__builtin_amdgcn_s_getreg((3 << 11) | 20) & 0xFu; }
#define XB_SPIN(cond, bar) do { unsigned _sp = 0; while (cond) { __builtin_amdgcn_s_sleep(1); \
    if ((++_sp & 255u) == 0u) { if (xb_ld(&(bar)[XB_TMO])) break; if (_sp > XB_SPIN_CAP) { atomicAdd(&(bar)[XB_TMO], 1u); break; } } } } while (0)

struct XcdBarrier {
    unsigned* bar; unsigned x;
    volatile LAS unsigned* st;
};

__device__ __forceinline__ XcdBarrier xcd_barrier_post(unsigned* bar, volatile LAS unsigned* st) {
    XcdBarrier b; b.bar = bar; b.x = xb_xcc_id(); b.st = st;
    if (threadIdx.x == 0) (void)xb_add(&bar[XB_XCNT(b.x)], 1u);
    return b;
}
__device__ __forceinline__ void xcd_barrier_complete(unsigned* bar, unsigned x, unsigned& nloc, unsigned& nx) {
    const unsigned G = gridDim.x * gridDim.y * gridDim.z;
    unsigned sum, cnt, mine, sp = 0u;
    for (;;) {
        sum = 0u; cnt = 0u; mine = 0u;
#pragma unroll
        for (unsigned j = 0; j < 16; ++j) { const unsigned c = xb_ld(&bar[XB_XCNT(j)]); sum += c; cnt += (c > 0u) ? 1u : 0u; mine = (j == x) ? c : mine; }
        if (sum == G) break;
        __builtin_amdgcn_s_sleep(1);
        if ((++sp & 255u) == 0u) { if (xb_ld(&bar[XB_TMO])) break; if (sp > XB_SPIN_CAP) { atomicAdd(&bar[XB_TMO], 1u); break; } }
    }
    nloc = mine > 0u ? mine : 1u; nx = cnt > 0u ? cnt : 1u;
}

__device__ __forceinline__ void xcd_barrier(const XcdBarrier& b) {
    asm volatile("s_waitcnt vmcnt(0)" ::: "memory");
    __syncthreads();
    if (threadIdx.x == 0) {
        unsigned* bar = b.bar;
        __builtin_amdgcn_s_waitcnt(0);
        unsigned nloc = b.st[0], nx = b.st[1];
        if (nloc == 0u) { xcd_barrier_complete(bar, b.x, nloc, nx); b.st[0] = nloc; b.st[1] = nx; }
        const unsigned old = xb_add(&bar[XB_XSUB(b.x)], 1u);
        const unsigned gen = old / nloc;
        if (old + 1u == (gen + 1u) * nloc) {
            __builtin_amdgcn_fence(__ATOMIC_RELEASE, "agent");
            asm volatile("s_waitcnt vmcnt(0)" ::: "memory");
            const unsigned og = xb_add(&bar[XB_TOP], 1u);
            const unsigned tg = og / nx;
            if (og + 1u == (tg + 1u) * nx) xb_add(&bar[XB_TOPGEN], 1u);
            else XB_SPIN(xb_ld(&bar[XB_TOPGEN]) == tg, bar);
            __builtin_amdgcn_fence(__ATOMIC_ACQUIRE, "agent");
            xb_add(&bar[XB_XGEN(b.x)], 1u);
            asm volatile("s_waitcnt vmcnt(0)" ::: "memory");
        } else {
            XB_SPIN(xb_ld(&bar[XB_XGEN(b.x)]) == gen, bar);
            __builtin_amdgcn_fence(__ATOMIC_ACQUIRE, "agent");
            asm volatile("s_waitcnt vmcnt(0)" ::: "memory");
        }
    }
    __syncthreads();
}


__global__ void __launch_bounds__(512, 2) mega(Params P) {
  extern __shared__ __attribute__((aligned(16))) unsigned char lds_raw[];
  LAS unsigned char* lds = (LAS unsigned char*)lds_raw;
  cg::grid_group grid = cg::this_grid();
  if (threadIdx.x < 16) ((LAS unsigned*)(lds + (LDS_BYTES - 64)))[threadIdx.x] = 0u;
  __syncthreads();
  (void)xcd_barrier_post((unsigned*)(P.ws + WS_BAR), (volatile LAS unsigned*)(lds + (LDS_BYTES - 64)));
#define FRESH() Ctx X; { size_t z_ = 0; asm volatile("" : "+s"(z_)); X.ws = P.ws + z_; X.out = (float*)((unsigned char*)P.out + z_); X.in = P.in; X.G = gridDim.x; X.blk = blockIdx.x; }
#define GSYNC() do { XcdBarrier b_; unsigned zo_ = 0; asm volatile("" : "+s"(zo_)); b_.bar = (unsigned*)(P.ws + WS_BAR) + zo_;     b_.x = xb_xcc_id(); b_.st = (volatile LAS unsigned*)(lds + (LDS_BYTES - 64)); xcd_barrier(b_); } while (0)
#define OB (X.OA() + (size_t)T * 512)
#define GATES X.PROJ()
#define MERGED X.H()
#define XQ X.PROJ()
#define OX (X.PROJ() + (size_t)T * 512)
#define FFH X.PROJ()
#define PIN(k) P.in[oidx(k)]

#ifndef SKIP_TABLES
  { FRESH(); tables_phase(X, P); }
#endif
  if (P.pad0 != 0) grid.sync();
#pragma unroll 1
  for (int layer = 0; layer < DEPTH; ++layer) {
    const size_t L = (size_t)layer;
#define xin ((layer == 0) ? PIN(0) : (const float*)X.out)
    { FRESH();
#ifndef SKIP_WCONV
    wconv_phase(lds, X, layer);
#endif
#ifndef SKIP_RMS1
    if (layer == 0) xb_prepass(X, PIN(0));
    rms_phase(X, PIN(1), PIN(21) + L * 1024, X.HM(), NB * 256);
#endif
    }
    GSYNC();
    { FRESH();
#ifndef SKIP_INPROJ
    { pg8::Gemm g{X.H(), X.W() + W_IN, T, NPROJ, 1024, 1024, 1024}; pg8::StaticOrder So; So.init(T, NPROJ, X.G, X.blk);
      pg8::EpiInproj E{X.PROJ(), X.QROT(), X.VST(), X.KST(), X.CS64(), X.CS32(), X.RSS()}; pg8::gemm_phase(lds, g, So, E); }
#endif
#ifndef SKIP_MEMKV
    { pg8::Gemm g{X.HM(), X.W() + W_XKV, 1024, 1024, 1024, 1024, 1024}; pg8::StaticOrder So; So.init(1024, 1024, X.G, (X.blk + X.G / 2) % X.G);
      pg8::EpiPlain E{X.MEMKV(), 1024, nullptr}; pg8::gemm_phase(lds, g, So, E); }
#endif
    }
    GSYNC();
    { FRESH();
#ifndef SKIP_P3
    mla_norm_phase(X, PIN(12) + L * 384, PIN(14) + L * 256);
    for (int t = X.blk; t < 512; t += X.G) nsa_compress_task(lds, X, PIN(6) + L * 2048, PIN(7) + L * 2048, t);
#endif
    }
    GSYNC();
    { FRESH();
#ifndef SKIP_MLAQ
    { pg8::Gemm g{X.PROJ() + C_CQA, X.W() + W_QB, T, 768, 384, NPROJ, 384}; pg8::StaticOrder So; So.init(T, 768, X.G, X.blk);
      pg8::EpiMlaQ E{X.QM(), X.CS32()}; pg8::gemm_phase(lds, g, So, E); }
#endif
#ifndef SKIP_KVUP
    { pg8::Gemm g{X.PROJ() + C_CKV, X.W() + W_KVB, T, 1024, 256, NPROJ, 256}; pg8::StaticOrder So; So.init(T, 1024, X.G, X.blk);
      pg8::EpiPlain E{X.KVM(), 1024, nullptr}; pg8::gemm_phase(lds, g, So, E); }
#endif
    }
    GSYNC();
    { FRESH();
#ifndef SKIP_MLA
    if (X.G == 256) { const int vcu = (X.blk % 8) * 32 + X.blk / 8; const int bh = vcu >> 3, s = vcu & 7;
      for (int i = 0; i < 4; ++i) { const int qb = (i == 0) ? s : (i == 1) ? 15 - s : (i == 2) ? 16 + s : 31 - s; mla_unit(lds, X, bh >> 3, bh & 7, qb); } }
    else { for (int u = X.blk; u < 1024; u += X.G) mla_unit(lds, X, (u >> 5) >> 3, (u >> 5) & 7, 31 - (u & 31)); }
#endif
    }
    GSYNC();
    { FRESH();
#ifndef SKIP_SWA
    for (int u = X.blk; u < 512; u += X.G) swa_unit(lds, X, PIN(5) + L * 8, u >> 7, (u >> 6) & 1, u & 63);
#endif
#ifndef SKIP_NSA
    for (int u = X.blk; u < 512; u += X.G) { const int uu = u & 255; const int qb = (u < 256) ? 63 - (uu >> 3) : (uu >> 3), bg = uu & 7; nsa_unit(lds, X, OB, bg >> 1, bg & 1, qb); }
#endif
    }
    GSYNC();
    { FRESH();
#ifndef SKIP_NSA
    nsa_sel_phase(X, OB);
#endif
    }
    GSYNC();
    { FRESH();
#ifndef SKIP_GATES
    { pg8::Gemm g{X.H(), X.W() + W_G, T, NGATE, 1024, 1024, 1024}; pg8::StaticOrder So; So.init(T, NGATE, X.G, X.blk);
      pg8::EpiGates E{GATES, X.RSS()}; pg8::gemm_phase(lds, g, So, E); }
#endif
    }
    GSYNC();
    { FRESH();
#ifndef SKIP_MERGE
    { pg8::Gemm g{X.OA(), X.W() + W_BR, 3 * T, 3 * 1024, 512, 512, 512}; pg8::MergeOrder So{X.G, X.blk};
      pg8::EpiMerge E{GATES, MERGED}; pg8::gemm_phase(lds, g, So, E); }
#endif
    }
    GSYNC();
    { FRESH();
#ifndef SKIP_RESID
    { pg8::Gemm g{MERGED, X.W() + W_OUT, T, 1024, 1024, 1024, 1024}; pg8::StaticOrder So; So.init(T, 1024, X.G, X.blk);
      pg8::EpiResid E{xin, X.out, X.KVM(), X.RSS(), (LAS float*)(lds + 131072)}; pg8::gemm_phase(lds, g, So, E); }
#endif
    }
    GSYNC();
    { FRESH();
#ifndef SKIP_XQ
    { pg8::Gemm g{X.KVM(), X.W() + W_XQ, T, 512, 1024, 1024, 1024}; pg8::StaticOrder So; So.init(T, 512, X.G, X.blk);
      pg8::EpiPlain E{XQ, 512, X.RSS()}; pg8::gemm_phase(lds, g, So, E); }
#endif
    }
    GSYNC();
    { FRESH();
#ifndef SKIP_XATT
    for (int u = X.blk; u < 512; u += X.G) xattn_unit(lds, X, XQ, OX, u >> 7, (u >> 5) & 3, u & 31);
#endif
    }
    GSYNC();
    { FRESH();
#ifndef SKIP_XO
    { pg8::Gemm g{OX, X.W() + W_XO, T, 1024, 512, 512, 512}; pg8::StaticOrder So; So.init(T, 1024, X.G, X.blk);
      pg8::EpiResid E{X.out, X.out, X.H(), X.RSS(), (LAS float*)(lds + 131072)}; pg8::gemm_phase(lds, g, So, E); }
#endif
    }
    GSYNC();
    { FRESH();
#ifndef SKIP_SWIGLU
    { pg8::Gemm g{X.H(), X.W() + W_GU, T, NGU, 1024, 1024, 1024}; pg8::StaticOrder So; So.init(T, NGU, X.G, X.blk);
      pg8::EpiSwiglu E{FFH, X.RSS()}; pg8::gemm_phase(lds, g, So, E); }
#endif
    }
    GSYNC();
    { FRESH();
#ifndef SKIP_DOWN
    { pg8::Gemm g{FFH, X.W() + W_DOWN, T, 1024, DFF, DFF, DFF}; pg8::StaticOrder So; So.init(T, 1024, X.G, X.blk);
      pg8::EpiResid E{X.out, X.out, X.H(), X.RSS(), (LAS float*)(lds + 131072)}; pg8::gemm_phase(lds, g, So, E); }
#endif
    }
    GSYNC();
  }
#ifndef SKIP_FINAL
  { FRESH(); final_norm_phase(X, PIN(28)); }
#endif
}

extern "C" void kernel_launch(void* const* d_in, const int* in_sizes, int n_in, void* d_out, int out_size, void* d_ws, size_t ws_size, hipStream_t stream) {
  static int grid_blocks = 0;
  if (!grid_blocks) {
    int dev = 0, cus = 0, per_cu = 0;
    (void)hipGetDevice(&dev);
    (void)hipDeviceGetAttribute(&cus, hipDeviceAttributeMultiprocessorCount, dev);
    (void)hipFuncSetAttribute((const void*)mega, hipFuncAttributeMaxDynamicSharedMemorySize, LDS_BYTES);
    (void)hipOccupancyMaxActiveBlocksPerMultiprocessor(&per_cu, (const void*)mega, 512, LDS_BYTES);
    if (per_cu < 1) per_cu = 1;
    if (per_cu > 1) per_cu = 1;
    grid_blocks = cus * per_cu;
    if (ws_size < WS_END || n_in != 29 || out_size != T * DM) fprintf(stderr, "kernel_launch: unexpected sizes: ws %zu (need %zu) n_in %d out %d\n", ws_size, (size_t)WS_END, n_in, out_size);
  }
  Params p;
  memset(&p, 0, sizeof(p));
  for (int i = 0; i < 29; ++i) p.in[i] = (const float*)d_in[i];
  p.out = (float*)d_out; p.ws = (unsigned char*)d_ws;
  for (int i = 0; i < 32; ++i) p.invf64[i] = (float)pow(10000.0, -(double)i / 32.0);
  for (int i = 0; i < 16; ++i) p.invf32[i] = (float)pow(10000.0, -(double)i / 16.0);
  (void)hipMemsetAsync((char*)d_ws + WS_BAR, 0, BAR_BYTES, stream);
  void* args[] = {&p};
  hipError_t e = hipLaunchCooperativeKernel((const void*)mega, dim3(grid_blocks), dim3(512), args, LDS_BYTES, stream);
  if (e != hipSuccess) fprintf(stderr, "cooperative launch failed: %s (grid %d)\n", hipGetErrorString(e), grid_blocks);
}
```
